# Optimizing an MI355X kernel written in HIP

```python
import math
import jax, jax.numpy as jnp
from jax import lax
import numpy as np

D_MODEL = 1024
BATCH = 4
SEQ = 8192
DEPTH = 2

GRID_W = 64
CTX_LEN = 256
EPS = 1e-6
ROPE_THETA = 10000.0
Q_BLOCK = 128
HEAD_DIM = 64
A_HEADS = 6
A_KV_HEADS = 2
A_GROUP = A_HEADS // A_KV_HEADS
A_Q = A_HEADS * HEAD_DIM
A_KV = A_KV_HEADS * HEAD_DIM
B_HEADS = 6
B_SUB = 32
B_VDIM = 2 * B_SUB
B_QK = B_HEADS * 2 * B_SUB
B_V = B_HEADS * B_VDIM
C_GROUPS = 16
C_GROUP_CH = 16
C_WIDTH = C_GROUPS * C_GROUP_CH
C_STATE = 64
IN_WIDTH = A_Q + 2 * A_KV + 2 * B_QK + B_V + C_WIDTH
MIX_WIDTH = A_Q + B_V + C_WIDTH
PEER_HEADS = 8
N_KEYS = 128
N_EXPERTS = N_KEYS * N_KEYS
PEER_TOPK = 16
PEER_HALF = 128
TOKEN_CHUNK = 128

kernel_name = 'hybrid_gqa_diffattn_s5_peer_dit'


def _rms(x, g):
    xf = x.astype(jnp.float32)
    y = xf * lax.rsqrt(jnp.mean(xf * xf, axis=-1, keepdims=True) + EPS)
    return (y * g.astype(jnp.float32)).astype(x.dtype)


def _modulate(h, shift, scale):
    return h * (1 + scale) + shift


def _rope_2d(x, row, col):
    d = x.shape[-1]
    half = d // 2
    inv = 1.0 / (ROPE_THETA ** (jnp.arange(0, half, 2, dtype=jnp.float32) / half))
    ang = jnp.concatenate([row.astype(jnp.float32)[:, None] * inv[None, :],
                           col.astype(jnp.float32)[:, None] * inv[None, :]], axis=-1)
    cos = jnp.cos(ang)[None, :, None, :]
    sin = jnp.sin(ang)[None, :, None, :]
    xr = x.astype(jnp.float32).reshape(x.shape[:-1] + (half, 2))
    x0, x1 = xr[..., 0], xr[..., 1]
    out = jnp.stack([x0 * cos - x1 * sin, x0 * sin + x1 * cos], axis=-1)
    return out.reshape(x.shape).astype(x.dtype)


def _gqa_block(q, k, v):
    s = jnp.einsum('bqkgd,bskd->bkgqs', q, k).astype(jnp.float32) * (HEAD_DIM ** -0.5)
    p = jax.nn.softmax(s, axis=-1).astype(v.dtype)
    return jnp.einsum('bkgqs,bskd->bqkgd', p, v)


def _diff_block(q, k, v, lam):
    s = jnp.einsum('bqhtd,bshtd->bthqs', q, k).astype(jnp.float32) * (B_SUB ** -0.5)
    p = jax.nn.softmax(s, axis=-1)
    a = (p[:, 0] - lam * p[:, 1]).astype(v.dtype)
    return jnp.einsum('bhqs,bshd->bqhd', a, v)


def _sweep(block_fn, qs, *kv):
    B, L = qs[0].shape[:2]
    nb = L // Q_BLOCK
    qb = tuple(jnp.moveaxis(q.reshape((B, nb, Q_BLOCK) + q.shape[2:]), 1, 0) for q in qs)
    out = lax.map(lambda xs: block_fn(*xs, *kv), qb)
    return jnp.moveaxis(out, 0, 1).reshape((B, L) + out.shape[3:])


def _scan_combine(e1, e2):
    a1, b1 = e1
    a2, b2 = e2
    return a2 * a1, a2 * b1 + b2


def _lin_scan(bu, abar, reverse):
    if reverse:
        bu = jnp.flip(bu, axis=1)
    a = jnp.broadcast_to(abar, (1, bu.shape[1]) + abar.shape)
    _, h = lax.associative_scan(_scan_combine, (a, bu), axis=1)
    return jnp.flip(h, axis=1) if reverse else h


def _s5_mixer(u, uc, a_re, a_im, log_dt, b_re, b_im, c_re, c_im, d_skip, w_glu, with_ctx):
    f32 = jnp.float32
    B, L, _ = u.shape
    Lc = uc.shape[1]
    ug = u.astype(f32).reshape(B, L, C_GROUPS, C_GROUP_CH).astype(jnp.complex64)
    ucg = uc.astype(f32).reshape(B, Lc, C_GROUPS, C_GROUP_CH).astype(jnp.complex64)
    ys, ycs = [], []
    for dirn in range(2):
        rev = dirn == 1
        A = lax.complex(a_re[dirn].astype(f32), a_im[dirn].astype(f32))
        adt = A * jnp.exp(log_dt[dirn].astype(f32))[:, None]
        abar = jnp.exp(adt)
        bbar = ((abar - 1) / A)[..., None] * lax.complex(b_re[dirn].astype(f32), b_im[dirn].astype(f32))
        cmat = lax.complex(c_re[dirn].astype(f32), c_im[dirn].astype(f32))
        hc = _lin_scan(jnp.einsum('blgp,gnp->blgn', ucg, bbar), abar, rev)
        h0 = hc[:, 0] if rev else hc[:, -1]
        steps = (L - jnp.arange(L)) if rev else (jnp.arange(L) + 1)
        decay = jnp.exp(adt[None] * steps.astype(f32)[:, None, None])
        h = _lin_scan(jnp.einsum('blgp,gnp->blgn', ug, bbar), abar, rev) + decay[None] * h0[:, None]
        ys.append(jnp.einsum('blgn,gpn->blgp', h, cmat).real)
        if with_ctx:
            ycs.append(jnp.einsum('blgn,gpn->blgp', hc, cmat).real)

    def _out(y_dirs, inp, n):
        y = (y_dirs[0] + y_dirs[1]).reshape(B, n, C_WIDTH) + d_skip.astype(f32) * inp.astype(f32)
        g = jax.nn.gelu(y)
        return (g * jax.nn.sigmoid(g @ w_glu.astype(f32))).astype(inp.dtype)

    y_lat = _out(ys, u, L)
    y_ctx = _out(ycs, uc, Lc) if with_ctx else None
    return y_lat, y_ctx


def _token_mixers(h, hc, row, col, layer_idx, w_in, qn_a, kn_a, qn_b, kn_b,
                  lam_q1, lam_k1, lam_q2, lam_k2, subln_g,
                  a_re, a_im, log_dt, b_re, b_im, c_re, c_im, d_skip, w_glu, with_ctx):
    B, L, _ = h.shape
    Lc = hc.shape[1]
    cuts = [A_Q, A_Q + A_KV, A_Q + 2 * A_KV, A_Q + 2 * A_KV + B_QK,
            A_Q + 2 * A_KV + 2 * B_QK, A_Q + 2 * A_KV + 2 * B_QK + B_V]
    qa, ka, va, qb, kb, vb, us = jnp.split(h @ w_in, cuts, axis=-1)
    qac, kac, vac, qbc, kbc, vbc, usc = jnp.split(hc @ w_in, cuts, axis=-1)

    qa = _rope_2d(_rms(qa.reshape(B, L, A_HEADS, HEAD_DIM), qn_a), row, col)
    qa = qa.reshape(B, L, A_KV_HEADS, A_GROUP, HEAD_DIM)
    ka = _rope_2d(_rms(ka.reshape(B, L, A_KV_HEADS, HEAD_DIM), kn_a), row, col)
    va = va.reshape(B, L, A_KV_HEADS, HEAD_DIM)
    kac = _rms(kac.reshape(B, Lc, A_KV_HEADS, HEAD_DIM), kn_a)
    vac = vac.reshape(B, Lc, A_KV_HEADS, HEAD_DIM)
    ka_all = jnp.concatenate([kac, ka], axis=1)
    va_all = jnp.concatenate([vac, va], axis=1)
    o_a = _sweep(_gqa_block, (qa,), ka_all, va_all).reshape(B, L, A_Q)

    lambda_init = 0.8 - 0.6 * math.exp(-0.3 * layer_idx)
    lam = (jnp.exp(jnp.sum(lam_q1.astype(jnp.float32) * lam_k1.astype(jnp.float32)))
           - jnp.exp(jnp.sum(lam_q2.astype(jnp.float32) * lam_k2.astype(jnp.float32))) + lambda_init)
    qb = _rope_2d(_rms(qb.reshape(B, L, 2 * B_HEADS, B_SUB), qn_b), row, col).reshape(B, L, B_HEADS, 2, B_SUB)
    kb = _rope_2d(_rms(kb.reshape(B, L, 2 * B_HEADS, B_SUB), kn_b), row, col).reshape(B, L, B_HEADS, 2, B_SUB)
    vb = vb.reshape(B, L, B_HEADS, B_VDIM)
    kbc = _rms(kbc.reshape(B, Lc, 2 * B_HEADS, B_SUB), kn_b).reshape(B, Lc, B_HEADS, 2, B_SUB)
    vbc = vbc.reshape(B, Lc, B_HEADS, B_VDIM)
    kb_all = jnp.concatenate([kbc, kb], axis=1)
    vb_all = jnp.concatenate([vbc, vb], axis=1)
    o_b = _sweep(_diff_block, (qb,), kb_all, vb_all, lam)
    o_b = (_rms(o_b, subln_g) * (1 - lambda_init)).reshape(B, L, B_V)

    o_c, o_cc = _s5_mixer(us, usc, a_re, a_im, log_dt, b_re, b_im, c_re, c_im, d_skip, w_glu, with_ctx)

    mix = jnp.concatenate([o_a, o_b, o_c], axis=-1)
    if not with_ctx:
        return mix, None
    qac = _rms(qac.reshape(B, Lc, A_HEADS, HEAD_DIM), qn_a).reshape(B, Lc, A_KV_HEADS, A_GROUP, HEAD_DIM)
    o_ac = _gqa_block(qac, kac, vac).reshape(B, Lc, A_Q)
    qbc = _rms(qbc.reshape(B, Lc, 2 * B_HEADS, B_SUB), qn_b).reshape(B, Lc, B_HEADS, 2, B_SUB)
    o_bc = _diff_block(qbc, kbc, vbc, lam)
    o_bc = (_rms(o_bc, subln_g) * (1 - lambda_init)).reshape(B, Lc, B_V)
    mixc = jnp.concatenate([o_ac, o_bc, o_cc], axis=-1)
    return mix, mixc


def _peer(h, w_q, sub_keys, u_emb, v_emb):
    T, D = h.shape

    def chunk(hc):
        q = (hc @ w_q).reshape(TOKEN_CHUNK, PEER_HEADS, 2, PEER_HALF)
        s = jnp.einsum('chtd,htnd->chtn', q, sub_keys).astype(jnp.float32)
        s1, i1 = lax.top_k(s[:, :, 0], PEER_TOPK)
        s2, i2 = lax.top_k(s[:, :, 1], PEER_TOPK)
        cand = (s1[..., :, None] + s2[..., None, :]).reshape(TOKEN_CHUNK, PEER_HEADS, PEER_TOPK * PEER_TOPK)
        sc, ci = lax.top_k(cand, PEER_TOPK)
        idx = (jnp.take_along_axis(i1, ci // PEER_TOPK, axis=-1) * N_KEYS
               + jnp.take_along_axis(i2, ci % PEER_TOPK, axis=-1))
        g = jax.nn.softmax(sc, axis=-1)
        u = jnp.take(u_emb, idx, axis=0)
        act = jax.nn.gelu(jnp.einsum('chkd,cd->chk', u, hc).astype(jnp.float32))
        w = (g * act).astype(hc.dtype)
        return jnp.einsum('chk,chkd->cd', w, jnp.take(v_emb, idx, axis=0))

    out = lax.map(chunk, h.reshape(T // TOKEN_CHUNK, TOKEN_CHUNK, D))
    return out.reshape(T, D)


def setup_inputs(seed: int = 0) -> dict:
    key = jax.random.key(seed)
    ks = iter(jax.random.split(key, 40))
    f32 = jnp.float32

    def nrm(shape, s):
        return jax.random.normal(next(ks), shape, f32) * s

    D = D_MODEL
    x = nrm((BATCH, SEQ, D), 1.0)
    c = nrm((BATCH, D), 1.0)
    ctx = nrm((BATCH, CTX_LEN, D), 1.0)
    c_ctx = nrm((D,), 1.0)
    w_ada = nrm((DEPTH, D, 6 * D), D ** -0.5)
    b_ada = nrm((DEPTH, 6 * D), 0.01)
    norm1_g = 1.0 + nrm((DEPTH, D), 0.02)
    norm2_g = 1.0 + nrm((DEPTH, D), 0.02)
    w_in = nrm((DEPTH, D, IN_WIDTH), D ** -0.5)
    w_out = nrm((DEPTH, MIX_WIDTH, D), MIX_WIDTH ** -0.5)
    qn_a = 1.0 + nrm((DEPTH, HEAD_DIM), 0.02)
    kn_a = 1.0 + nrm((DEPTH, HEAD_DIM), 0.02)
    qn_b = 1.0 + nrm((DEPTH, B_SUB), 0.02)
    kn_b = 1.0 + nrm((DEPTH, B_SUB), 0.02)
    lam_q1 = nrm((DEPTH, B_SUB), 0.1)
    lam_k1 = nrm((DEPTH, B_SUB), 0.1)
    lam_q2 = nrm((DEPTH, B_SUB), 0.1)
    lam_k2 = nrm((DEPTH, B_SUB), 0.1)
    subln_g = 1.0 + nrm((DEPTH, B_VDIM), 0.02)
    n_idx = jnp.arange(C_STATE, dtype=f32)
    s5_a_re = -0.5 + nrm((DEPTH, 2, C_GROUPS, C_STATE), 0.01)
    s5_a_im = math.pi * n_idx + nrm((DEPTH, 2, C_GROUPS, C_STATE), 0.01)
    s5_log_dt = jax.random.uniform(next(ks), (DEPTH, 2, C_GROUPS), f32, math.log(1e-3), math.log(1e-1))
    s5_b_re = nrm((DEPTH, 2, C_GROUPS, C_STATE, C_GROUP_CH), (2 * C_GROUP_CH) ** -0.5)
    s5_b_im = nrm((DEPTH, 2, C_GROUPS, C_STATE, C_GROUP_CH), (2 * C_GROUP_CH) ** -0.5)
    s5_c_re = nrm((DEPTH, 2, C_GROUPS, C_GROUP_CH, C_STATE), C_STATE ** -0.5)
    s5_c_im = nrm((DEPTH, 2, C_GROUPS, C_GROUP_CH, C_STATE), C_STATE ** -0.5)
    s5_d = nrm((DEPTH, C_WIDTH), 1.0)
    s5_w_glu = nrm((DEPTH, C_WIDTH, C_WIDTH), C_WIDTH ** -0.5)
    peer_wq = nrm((DEPTH, D, PEER_HEADS * 2 * PEER_HALF), D ** -0.5)
    peer_keys = nrm((DEPTH, PEER_HEADS, 2, N_KEYS, PEER_HALF), PEER_HALF ** -0.5)
    peer_u = nrm((DEPTH, N_EXPERTS, D), D ** -0.5)
    peer_v = nrm((DEPTH, N_EXPERTS, D), 0.5)
    return {'x': x, 'c': c, 'ctx': ctx, 'c_ctx': c_ctx, 'w_ada': w_ada, 'b_ada': b_ada,
            'norm1_g': norm1_g, 'norm2_g': norm2_g, 'w_in': w_in, 'w_out': w_out,
            'qn_a': qn_a, 'kn_a': kn_a, 'qn_b': qn_b, 'kn_b': kn_b,
            'lam_q1': lam_q1, 'lam_k1': lam_k1, 'lam_q2': lam_q2, 'lam_k2': lam_k2, 'subln_g': subln_g,
            's5_a_re': s5_a_re, 's5_a_im': s5_a_im, 's5_log_dt': s5_log_dt,
            's5_b_re': s5_b_re, 's5_b_im': s5_b_im, 's5_c_re': s5_c_re, 's5_c_im': s5_c_im,
            's5_d': s5_d, 's5_w_glu': s5_w_glu,
            'peer_wq': peer_wq, 'peer_keys': peer_keys, 'peer_u': peer_u, 'peer_v': peer_v}


def reference(x, c, ctx, c_ctx, w_ada, b_ada, norm1_g, norm2_g, w_in, w_out,
              qn_a, kn_a, qn_b, kn_b, lam_q1, lam_k1, lam_q2, lam_k2, subln_g,
              s5_a_re, s5_a_im, s5_log_dt, s5_b_re, s5_b_im, s5_c_re, s5_c_im,
              s5_d, s5_w_glu, peer_wq, peer_keys, peer_u, peer_v):
    B, L, D = x.shape
    Lc = ctx.shape[1]
    ROWS = L // GRID_W
    row = jnp.repeat(jnp.arange(ROWS, dtype=jnp.int32), GRID_W)
    col = jnp.tile(jnp.arange(GRID_W, dtype=jnp.int32), ROWS)
    s_c = jax.nn.silu(c)
    s_cc = jax.nn.silu(c_ctx)
    for l in range(DEPTH):
        with_ctx = l < DEPTH - 1
        sh1, sc1, g1, sh2, sc2, g2 = jnp.split((s_c @ w_ada[l] + b_ada[l])[:, None, :], 6, axis=-1)
        csh1, csc1, cg1, csh2, csc2, cg2 = jnp.split(s_cc @ w_ada[l] + b_ada[l], 6, axis=-1)

        h = _modulate(_rms(x, norm1_g[l]), sh1, sc1)
        hc = _modulate(_rms(ctx, norm1_g[l]), csh1, csc1)
        mix, mixc = _token_mixers(h, hc, row, col, l, w_in[l], qn_a[l], kn_a[l], qn_b[l], kn_b[l],
                                  lam_q1[l], lam_k1[l], lam_q2[l], lam_k2[l], subln_g[l],
                                  s5_a_re[l], s5_a_im[l], s5_log_dt[l], s5_b_re[l], s5_b_im[l],
                                  s5_c_re[l], s5_c_im[l], s5_d[l], s5_w_glu[l], with_ctx)
        x = x + g1 * (mix @ w_out[l])

        h2 = _modulate(_rms(x, norm2_g[l]), sh2, sc2)
        x = x + g2 * _peer(h2.reshape(B * L, D), peer_wq[l], peer_keys[l], peer_u[l], peer_v[l]).reshape(B, L, D)

        if with_ctx:
            ctx = ctx + cg1 * (mixc @ w_out[l])
            h2c = _modulate(_rms(ctx, norm2_g[l]), csh2, csc2)
            ctx = ctx + cg2 * _peer(h2c.reshape(B * Lc, D), peer_wq[l], peer_keys[l], peer_u[l], peer_v[l]).reshape(B, Lc, D)
    return x
```

```cpp
#include <hip/hip_runtime.h>
#include <stdint.h>
#include <cstdio>

#ifndef MK_ONE_LAUNCH
#define MK_ONE_LAUNCH 1
#endif

#define GAS __attribute__((address_space(1)))
#define LAS __attribute__((address_space(3)))
typedef unsigned short bf16_t;
typedef float f32x4 __attribute__((ext_vector_type(4)));
typedef unsigned u32x4 __attribute__((ext_vector_type(4)));
typedef unsigned u32x2 __attribute__((ext_vector_type(2)));
typedef float f32x2 __attribute__((ext_vector_type(2)));
typedef short bf16x8_t __attribute__((ext_vector_type(8)));
typedef float f32x16_t __attribute__((ext_vector_type(16)));

constexpr int D = 1024, NB = 4, L = 8192, LC = 256, RPB = L + LC, ROWS = NB * RPB;
constexpr int INW = 2048;
constexpr int C_QA = 0, C_KA = 384, C_VA = 512, C_QB = 640, C_KB = 1024, C_VB = 1408, C_US = 1792;
constexpr int NCH = ROWS / 32, CPB = RPB / 32;
constexpr float EPS = 1e-6f;
constexpr float LOG2E = 1.4426950408889634f;
constexpr int NTHR = 512, NWAVE = 8;
constexpr int LDS_BYTES = 163840;

constexpr size_t MiB = 1u << 20;
constexpr size_t WS_CTL = 0, CTL_ZERO_BYTES = 65536;
constexpr size_t WS_MODP = 1 * MiB;
constexpr size_t WS_MOD = 3 * MiB;
constexpr size_t WS_TABA = 3 * MiB + 512 * 1024;
constexpr size_t WS_TABB = WS_TABA + 32768;
constexpr size_t WS_SCAL = WS_TABB + 32768;
constexpr size_t WS_BBAR = 4 * MiB;
constexpr size_t WS_APOW = 4 * MiB + 512 * 1024;
constexpr size_t WS_B2CAT = 6 * MiB;
constexpr size_t WS_KT = 14 * MiB;
constexpr size_t WS_WGLU_T = 15 * MiB;
constexpr size_t WS_G2CAT = 501 * MiB;
constexpr size_t WS_S5S = 148 * MiB;
constexpr size_t WS_HCAT = 165 * MiB;
constexpr size_t WS_G = 174 * MiB;
constexpr size_t WS_X = 16 * MiB;
constexpr size_t WS_H = 148 * MiB;
constexpr size_t WS_P = 214 * MiB;
constexpr size_t WS_MIX = 346 * MiB;
constexpr size_t WS_WIN_T = 412 * MiB;
constexpr size_t WS_WOUT_T = 420 * MiB;
constexpr size_t WS_WQ_T = 424 * MiB;
constexpr size_t WS_OB = 432 * MiB;
constexpr size_t WS_KEYS16 = 482 * MiB;
constexpr size_t WS_SEL = 484 * MiB;
constexpr size_t WS_U8 = WS_MIX;
constexpr size_t WS_V8 = WS_MIX + 16 * MiB;
constexpr size_t WS_END = 509 * MiB;

struct Params { const float* in[32]; float* out; unsigned char* ws; int ph_lo, ph_hi; };

__device__ __forceinline__ int otid() { int t = threadIdx.x; asm volatile("" : "+v"(t)); return t; }
__device__ __forceinline__ int obid() { int b = blockIdx.x; asm volatile("" : "+s"(b)); return b; }
__device__ __forceinline__ float bf2f(unsigned u) { return __uint_as_float(u << 16); }
__device__ __forceinline__ unsigned f2bf(float f) { unsigned u = __float_as_uint(f); return (u + 0x7fffu + ((u >> 16) & 1u)) >> 16; }
__device__ __forceinline__ unsigned pk2(float lo, float hi) { return f2bf(lo) | (f2bf(hi) << 16); }
__device__ __forceinline__ float gelu_tanh(float x) { const float u = 0.7978845608028654f * (x + 0.044715f * x * x * x); return 0.5f * x * (1.f + tanhf(u)); }
__device__ __forceinline__ float wave_sum(float v) {
#pragma unroll
    for (int o = 1; o < 64; o <<= 1) v += __shfl_xor(v, o);
    return v;
}
__device__ __forceinline__ void sincos_d(double x, double& s, double& c) {
    const double TWO_PI = 6.283185307179586476925286766559;
    const double k = rint(x / TWO_PI);
    const double r = x - k * TWO_PI;
    const double r2 = r * r;
    double ts = r, tc = 1.0, ss = r, cc = 1.0;
#pragma unroll
    for (int n = 1; n <= 16; ++n) {
        tc = -tc * r2 * (1.0 / (double)((2 * n - 1) * (2 * n)));
        ts = -ts * r2 * (1.0 / (double)((2 * n) * (2 * n + 1)));
        cc += tc; ss += ts;
    }
    s = ss; c = cc;
}
__device__ __forceinline__ const float* src_row(const Params& p, int layer, int r) {
    if (layer == 0) { const int b = r / RPB, j = r - b * RPB; return j < LC ? p.in[2] + ((size_t)b * LC + j) * D : p.in[0] + ((size_t)b * L + (j - LC)) * D; }
    return (const float*)(p.ws + WS_X) + (size_t)r * D;
}

#define XB_TMO      128
#define XB_XCNT(j)  (256  + 64 * (j))
#define XB_XSUB(j)  (1280 + 64 * (j))
#define XB_XGEN(j)  (2304 + 64 * (j))
#define XB_TOP      3328
#define XB_TOPGEN   3392
#define XCD_BAR_WORDS 3456
#define XB_SPIN_CAP (1u << 22)
__device__ __forceinline__ unsigned xb_ld(unsigned* p)              { return __hip_atomic_load(p, __ATOMIC_RELAXED, __HIP_MEMORY_SCOPE_AGENT); }
__device__ __forceinline__ unsigned xb_add(unsigned* p, unsigned v) { return __hip_atomic_fetch_add(p, v, __ATOMIC_RELAXED, __HIP_MEMORY_SCOPE_AGENT); }
__device__ __forceinline__ unsigned xb_xcc_id() { return (unsigned)__builtin_amdgcn_s_getreg((3 << 11) | 20) & 0xFu; }
#define XB_SPIN(cond, bar) do { unsigned _sp = 0; while (cond) { __builtin_amdgcn_s_sleep(1); \
    if ((++_sp & 255u) == 0u) { if (xb_ld(&(bar)[XB_TMO])) break; if (_sp > XB_SPIN_CAP) { atomicAdd(&(bar)[XB_TMO], 1u); break; } } } } while (0)
struct XcdBarrier { unsigned* bar; unsigned x; volatile LAS unsigned* st; };
__device__ __forceinline__ XcdBarrier xcd_barrier_post(unsigned* bar, volatile LAS unsigned* st) {
    XcdBarrier b; b.bar = bar; b.x = xb_xcc_id(); b.st = st;
    if (threadIdx.x == 0) (void)xb_add(&bar[XB_XCNT(b.x)], 1u);
    return b;
}
__device__ __forceinline__ void xcd_barrier_complete(unsigned* bar, unsigned x, unsigned& nloc, unsigned& nx) {
    const unsigned G = gridDim.x * gridDim.y * gridDim.z;
    unsigned sum, cnt, mine, sp = 0u;
    for (;;) {
        sum = 0u; cnt = 0u; mine = 0u;
#pragma unroll
        for (unsigned j = 0; j < 16; ++j) { const unsigned c = xb_ld(&bar[XB_XCNT(j)]); sum += c; cnt += (c > 0u) ? 1u : 0u; mine = (j == x) ? c : mine; }
        if (sum == G) break;
        __builtin_amdgcn_s_sleep(1);
        if ((++sp & 255u) == 0u) { if (xb_ld(&bar[XB_TMO])) break; if (sp > XB_SPIN_CAP) { atomicAdd(&bar[XB_TMO], 1u); break; } }
    }
    nloc = mine > 0u ? mine : 1u; nx = cnt > 0u ? cnt : 1u;
}
__device__ __forceinline__ void xcd_barrier(const XcdBarrier& b) {
    asm volatile("s_waitcnt vmcnt(0)" ::: "memory");
    __syncthreads();
    if (threadIdx.x == 0) {
        unsigned* bar = b.bar;
        __builtin_amdgcn_s_waitcnt(0);
        unsigned nloc = b.st[0], nx = b.st[1];
        if (nloc == 0u) { xcd_barrier_complete(bar, b.x, nloc, nx); b.st[0] = nloc; b.st[1] = nx; }
        const unsigned old = xb_add(&bar[XB_XSUB(b.x)], 1u);
        const unsigned gen = old / nloc;
        if (old + 1u == (gen + 1u) * nloc) {
            __builtin_amdgcn_fence(__ATOMIC_RELEASE, "agent");
            asm volatile("s_waitcnt vmcnt(0)" ::: "memory");
            const unsigned og = xb_add(&bar[XB_TOP], 1u);
            const unsigned tg = og / nx;
            if (og + 1u == (tg + 1u) * nx) xb_add(&bar[XB_TOPGEN], 1u);
            else XB_SPIN(xb_ld(&bar[XB_TOPGEN]) == tg, bar);
            __builtin_amdgcn_fence(__ATOMIC_ACQUIRE, "agent");
            xb_add(&bar[XB_XGEN(b.x)], 1u);
            asm volatile("s_waitcnt vmcnt(0)" ::: "memory");
        } else {
            XB_SPIN(xb_ld(&bar[XB_XGEN(b.x)]) == gen, bar);
            __builtin_amdgcn_fence(__ATOMIC_ACQUIRE, "agent");
            asm volatile("s_waitcnt vmcnt(0)" ::: "memory");
        }
    }
    __syncthreads();
}

namespace pg8 {
#define PG8_LAS __attribute__((address_space(3)))
typedef unsigned short bf16_t;
typedef short bf16x8 __attribute__((ext_vector_type(8)));
typedef float f32x4 __attribute__((ext_vector_type(4)));
typedef unsigned u32x4 __attribute__((ext_vector_type(4)));
constexpr int BM = 256, BK = 64, HALF = 128, HTB = HALF * BK * 2  , STAGE_BYTES = 8 * HTB, NXCD = 8, WGM = 8;

__host__ __device__ __forceinline__ int lds_byte(int r, int c) { const int st = (r >> 4) * 2 + (c >> 5), rr = r & 15, cc = c & 31, ob = rr * 64 + cc * 2; return st * 1024 + (ob ^ (((ob >> 9) & 1) << 5)); }
__host__ __device__ __forceinline__ void stage_rc(int b, int& R, int& C) { const int st = b / 1024, sb = b % 1024, swz = sb ^ (((sb >> 9) & 1) << 5); R = (st >> 1) * 16 + swz / 64; C = (st & 1) * 32 + (swz % 64) / 2; }
__host__ __device__ __forceinline__ int perm32(int rho) { const int n = rho >> 4, i = rho & 15; return 8 * (i >> 2) + 4 * n + (i & 3); }

struct Unit { int pm, pn; };
struct Gemm { const bf16_t* A; const bf16_t* Bt; int M, N, K; };
__device__ __forceinline__ unsigned cvt_pk_bf16(float lo, float hi) { unsigned r; asm volatile("v_cvt_pk_bf16_f32 %0, %1, %2" : "=v"(r) : "v"(lo), "v"(hi)); return r; }
template <class Epi, class Sched, bool ALIGN_EPI = false, bool SP2 = false>
__device__ __forceinline__ void gemm_phase(PG8_LAS unsigned char* lds, const Gemm g, const Sched& S, const Epi& E) {
    const int tid = threadIdx.x, wid = __builtin_amdgcn_readfirstlane(tid >> 6), lane = tid & 63, wr = wid >> 2, wc = wid & 3, fr = lane & 15, fq = lane >> 4;
    const int K = g.K, nt = K / BK;
    unsigned voffA[2], voffB[2];
#pragma unroll
    for (int i = 0; i < 2; ++i) { int R, C; stage_rc(tid * 16 + i * 8192, R, C); const int Rb = Epi::PERM ? ((R & ~31) + perm32(R & 31)) : R;
        voffA[i] = (unsigned)(R * K + C) * 2u; voffB[i] = (unsigned)(Rb * K + C) * 2u; }
    const size_t kstep = (size_t)(BK * 2);
    const size_t hstep = (size_t)HALF * K * 2;
    const size_t tstep = 2 * hstep;
    const unsigned ldsw = (unsigned)wid * 1024u;
    const int aoff = lds_byte(wr * 64 + fr, fq * 8), boff = lds_byte(wc * 32 + fr, fq * 8);
#define PG8_SA(b, h) (((b) * 2 + (h)) * HTB)
#define PG8_SB(b, h) ((4 + (b) * 2 + (h)) * HTB)
#define PG8_STAGE(bufoff, gbase, voff) do { _Pragma("unroll") for (int _i = 0; _i < 2; ++_i) \
        __builtin_amdgcn_global_load_lds((const unsigned*)((const char*)(gbase) + (voff)[_i]), (PG8_LAS unsigned*)(lds + (bufoff) + ldsw + _i * 8192), 16, 0, 0); } while (0)
#define PG8_LDA(dst, b, h) do { _Pragma("unroll") for (int m = 0; m < 4; ++m) _Pragma("unroll") for (int k = 0; k < 2; ++k) dst[m][k] = *(const PG8_LAS bf16x8*)(lds + PG8_SA(b, h) + aoff + m * 2048 + k * 1024); } while (0)
#define PG8_LDB(dst, b, h) do { _Pragma("unroll") for (int n = 0; n < 2; ++n) _Pragma("unroll") for (int k = 0; k < 2; ++k) dst[n][k] = *(const PG8_LAS bf16x8*)(lds + PG8_SB(b, h) + boff + n * 2048 + k * 1024); } while (0)
#define PG8_MMA(ai, bj, At, Bt) do { __builtin_amdgcn_s_setprio(1); _Pragma("unroll") for (int m = 0; m < 4; ++m) _Pragma("unroll") for (int n = 0; n < 2; ++n) _Pragma("unroll") for (int k = 0; k < 2; ++k) \
        acc[ai][bj][m][n] = __builtin_amdgcn_mfma_f32_16x16x32_bf16(Bt[n][k], At[m][k], acc[ai][bj][m][n], 0, 0, 0); __builtin_amdgcn_s_setprio(0); } while (0)
#define PG8_WAIT_V(n) asm volatile("s_waitcnt vmcnt(" #n ")" ::: "memory")
#define PG8_WAIT_L(n) asm volatile("s_waitcnt lgkmcnt(" #n ")" ::: "memory")
#define PG8_BAR __builtin_amdgcn_s_barrier()
#define PG8_SCHED __builtin_amdgcn_sched_barrier(0)
    Unit cur, nxt; int ui = 0;
    if (!S.next(0, cur)) return;
    f32x4 acc[2][2][4][2];
#pragma unroll
    for (int a = 0; a < 2; ++a)
#pragma unroll
        for (int b = 0; b < 2; ++b)
#pragma unroll
            for (int m = 0; m < 4; ++m)
#pragma unroll
                for (int n = 0; n < 2; ++n) acc[a][b][m][n] = (f32x4){0.f, 0.f, 0.f, 0.f};
    bf16x8 At[4][2], B0[2][2], B1[2][2];
    const char* cA = (const char*)g.A + (size_t)cur.pm * tstep; const char* cB = (const char*)g.Bt + (size_t)cur.pn * tstep;
    S.a_ready(cur);
    if constexpr (SP2) {
        PG8_STAGE(PG8_SB(0, 0), cB, voffB); PG8_STAGE(PG8_SB(0, 1), cB + hstep, voffB); PG8_STAGE(PG8_SA(0, 0), cA, voffA); PG8_STAGE(PG8_SA(0, 1), cA + hstep, voffA);
        if (wr == 1) PG8_BAR;
        PG8_WAIT_V(2); PG8_BAR;
        PG8_STAGE(PG8_SB(1, 0), cB + kstep, voffB); PG8_STAGE(PG8_SA(1, 0), cA + kstep, voffA); PG8_STAGE(PG8_SB(1, 1), cB + hstep + kstep, voffB);
        PG8_WAIT_V(6); PG8_BAR;
    } else {
        PG8_STAGE(PG8_SB(0, 0), cB, voffB); PG8_STAGE(PG8_SA(0, 0), cA, voffA); PG8_STAGE(PG8_SB(0, 1), cB + hstep, voffB); PG8_STAGE(PG8_SA(0, 1), cA + hstep, voffA);
        if (wr == 1) PG8_BAR;
        PG8_WAIT_V(4); PG8_BAR;
        PG8_STAGE(PG8_SB(1, 0), cB + kstep, voffB); PG8_STAGE(PG8_SA(1, 0), cA + kstep, voffA); PG8_STAGE(PG8_SB(1, 1), cB + hstep + kstep, voffB);
        PG8_WAIT_V(6); PG8_BAR;
    }
    for (;;) {
        const bool has_next = S.next(ui + 1, nxt);
        const char* nA = has_next ? (const char*)g.A + (size_t)nxt.pm * tstep : cA; const char* nB = has_next ? (const char*)g.Bt + (size_t)nxt.pn * tstep : cB;
        for (int t = 0; t < nt; t += 2) {
            const bool last = (t == nt - 2);
            const char* a1 = cA + (size_t)(t + 1) * kstep;
            const char* a2 = last ? nA : cA + (size_t)(t + 2) * kstep; const char* b2 = last ? nB : cB + (size_t)(t + 2) * kstep;
            const char* a3 = a2 + kstep; const char* b3 = b2 + kstep;
            if (last && has_next) S.a_ready(nxt);
            if constexpr (SP2) {
            PG8_LDB(B0, 0, 0); PG8_LDB(B1, 0, 1); PG8_SCHED; PG8_LDA(At, 0, 0); PG8_STAGE(PG8_SA(1, 1), a1 + hstep, voffA);
            PG8_WAIT_V(8); PG8_WAIT_L(0); PG8_BAR; PG8_MMA(0, 0, At, B0); PG8_MMA(0, 1, At, B1); PG8_BAR; PG8_SCHED;
            PG8_LDA(At, 0, 1); PG8_STAGE(PG8_SB(0, 0), b2, voffB); PG8_STAGE(PG8_SB(0, 1), b2 + hstep, voffB); PG8_STAGE(PG8_SA(0, 0), a2, voffA);
            PG8_WAIT_V(8); PG8_WAIT_L(0); PG8_BAR; PG8_MMA(1, 0, At, B0); PG8_MMA(1, 1, At, B1); PG8_BAR; PG8_SCHED;
            PG8_LDB(B0, 1, 0); PG8_LDB(B1, 1, 1); PG8_SCHED; PG8_LDA(At, 1, 0); PG8_STAGE(PG8_SA(0, 1), a2 + hstep, voffA);
            PG8_WAIT_V(8); PG8_WAIT_L(0); PG8_BAR; PG8_MMA(0, 0, At, B0); PG8_MMA(0, 1, At, B1); PG8_BAR; PG8_SCHED;
            PG8_LDA(At, 1, 1); PG8_STAGE(PG8_SB(1, 0), b3, voffB); PG8_STAGE(PG8_SB(1, 1), b3 + hstep, voffB); PG8_STAGE(PG8_SA(1, 0), a3, voffA);
            PG8_WAIT_V(8); PG8_WAIT_L(0); PG8_BAR; PG8_MMA(1, 0, At, B0); PG8_MMA(1, 1, At, B1); PG8_BAR; PG8_SCHED;
            } else {
            PG8_LDB(B0, 0, 0); PG8_SCHED; PG8_LDA(At, 0, 0); PG8_STAGE(PG8_SA(1, 1), a1 + hstep, voffA);
            PG8_WAIT_L(8); PG8_BAR; PG8_WAIT_L(0); PG8_MMA(0, 0, At, B0); PG8_BAR; PG8_SCHED;
            PG8_LDB(B1, 0, 1); PG8_STAGE(PG8_SB(0, 0), b2, voffB);
            PG8_BAR; PG8_WAIT_L(0); PG8_MMA(0, 1, At, B1); PG8_BAR;
            PG8_LDA(At, 0, 1); PG8_STAGE(PG8_SA(0, 0), a2, voffA);
            PG8_BAR; PG8_WAIT_L(0); PG8_MMA(1, 0, At, B0); PG8_BAR; PG8_SCHED;
            PG8_STAGE(PG8_SB(0, 1), b2 + hstep, voffB);
            PG8_WAIT_V(6); PG8_BAR; PG8_MMA(1, 1, At, B1); PG8_BAR;
            PG8_LDB(B0, 1, 0); PG8_SCHED; PG8_LDA(At, 1, 0); PG8_STAGE(PG8_SA(0, 1), a2 + hstep, voffA);
            PG8_WAIT_L(8); PG8_BAR; PG8_WAIT_L(0); PG8_MMA(0, 0, At, B0); PG8_BAR; PG8_SCHED;
            PG8_LDB(B1, 1, 1); PG8_STAGE(PG8_SB(1, 0), b3, voffB);
            PG8_BAR; PG8_WAIT_L(0); PG8_MMA(0, 1, At, B1); PG8_BAR;
            PG8_LDA(At, 1, 1); PG8_STAGE(PG8_SA(1, 0), a3, voffA);
            PG8_BAR; PG8_WAIT_L(0); PG8_MMA(1, 0, At, B0); PG8_BAR; PG8_SCHED;
            PG8_STAGE(PG8_SB(1, 1), b3 + hstep, voffB);
            PG8_WAIT_V(6); PG8_BAR; PG8_MMA(1, 1, At, B1); PG8_BAR;
            }
        }
        if constexpr (ALIGN_EPI) { if (wr == 0) PG8_BAR; }
        if constexpr (!Epi::AFTER_DRAIN) { E(acc, cur, wr, wc, fr, fq); S.done(cur); }
        if (!has_next) break;
#pragma unroll
        for (int a = 0; a < 2; ++a)
#pragma unroll
            for (int b = 0; b < 2; ++b)
#pragma unroll
                for (int m = 0; m < 4; ++m)
#pragma unroll
                    for (int n = 0; n < 2; ++n) acc[a][b][m][n] = (f32x4){0.f, 0.f, 0.f, 0.f};
        cur = nxt; cA = nA; cB = nB; ++ui;
        if constexpr (ALIGN_EPI) { if (wr == 1) PG8_BAR; }
    }
    PG8_WAIT_V(0);
    if constexpr (!ALIGN_EPI) { if (wr == 0) PG8_BAR; }
    PG8_BAR;
    if constexpr (Epi::AFTER_DRAIN) { E.fused(acc, cur, wr, wc, fr, fq, lds, wid, lane); S.done(cur); }
#undef PG8_SA
#undef PG8_SB
#undef PG8_STAGE
#undef PG8_LDA
#undef PG8_LDB
#undef PG8_MMA
#undef PG8_WAIT_V
#undef PG8_WAIT_L
#undef PG8_BAR
#undef PG8_SCHED
}
}

struct RowOrder {
    int nM, nN, nwg, G, c; bool lat_only;
    __device__ __forceinline__ void init(int nM_, int nN_, int G_, int c_, bool lat) { nM = nM_; nN = nN_; nwg = nM * nN; G = G_; c = c_; lat_only = lat; }
    __device__ __forceinline__ bool next(int i, pg8::Unit& u) const {
        const long Lx = (long)i * G + c; if (Lx >= nwg) return false;
        int wgid = (int)Lx; { const int q = nwg / pg8::NXCD, r = nwg % pg8::NXCD, xcd = wgid % pg8::NXCD, off = wgid / pg8::NXCD; wgid = (xcd < r ? xcd * (q + 1) : r * (q + 1) + (xcd - r) * q) + off; }
        const int nig = pg8::WGM * nN, gid = wgid / nig, fm = gid * pg8::WGM, gsz = (nM - fm) < pg8::WGM ? (nM - fm) : pg8::WGM;
        const int pm = fm + ((wgid % nig) % gsz); u.pn = (wgid % nig) / gsz;
        u.pm = lat_only ? (pm / 32) * 33 + 1 + (pm % 32) : pm; return true;
    }
    __device__ __forceinline__ void a_ready(const pg8::Unit&) const {}
    __device__ __forceinline__ void done(const pg8::Unit&) const {}
};
struct EpiBf {
    static constexpr bool PERM = true, AFTER_DRAIN = false;
    bf16_t* O; int ldc;
    __device__ __forceinline__ void operator()(const pg8::f32x4 (&acc)[2][2][4][2], const pg8::Unit& u, int wr, int wc, int fr, int fq) const {
        const int row0 = u.pm * 256 + wr * 64 + fr, col0 = u.pn * 256 + wc * 32 + 8 * fq;
#pragma unroll
        for (int ai = 0; ai < 2; ++ai)
#pragma unroll
            for (int m = 0; m < 4; ++m) { bf16_t* rowp = O + (size_t)(row0 + ai * 128 + m * 16) * ldc + col0;
#pragma unroll
                for (int bj = 0; bj < 2; ++bj) { const pg8::f32x4 v0 = acc[ai][bj][m][0], v1 = acc[ai][bj][m][1];
                    u32x4 w; w.x = pg8::cvt_pk_bf16(v0[0], v0[1]); w.y = pg8::cvt_pk_bf16(v0[2], v0[3]); w.z = pg8::cvt_pk_bf16(v1[0], v1[1]); w.w = pg8::cvt_pk_bf16(v1[2], v1[3]);
                    *(u32x4*)(rowp + bj * 128) = w; } }
    }
};
struct EpiRes {
    static constexpr bool PERM = true, AFTER_DRAIN = false;
    const float* x_in; const float* ctx_in; float* X; const float* mod; int layer; int gate_chunk;
    __device__ __forceinline__ void operator()(const pg8::f32x4 (&acc)[2][2][4][2], const pg8::Unit& u, int wr, int wc, int fr, int fq) const {
        const int b = u.pm / 33, jt = u.pm - b * 33;
        const float* src = layer == 0 ? (jt == 0 ? ctx_in + (size_t)b * LC * D : x_in + ((size_t)b * L + (size_t)(jt - 1) * 256) * D) : X + (size_t)u.pm * 256 * D;
        float* dst = X + (size_t)u.pm * 256 * D;
        const float* g = mod + (size_t)(jt == 0 ? 4 : b) * 6144 + gate_chunk * D;
        const int rl0 = wr * 64 + fr, col0 = u.pn * 256 + wc * 32 + 8 * fq;
        pg8::f32x4 gv[2][2];
#pragma unroll
        for (int bj = 0; bj < 2; ++bj)
#pragma unroll
            for (int n = 0; n < 2; ++n) gv[bj][n] = *(const pg8::f32x4*)(g + col0 + bj * 128 + 4 * n);
#pragma unroll
        for (int ai = 0; ai < 2; ++ai)
#pragma unroll
            for (int m = 0; m < 4; ++m) { const size_t ro = (size_t)(rl0 + ai * 128 + m * 16) * D + col0;
#pragma unroll
                for (int bj = 0; bj < 2; ++bj)
#pragma unroll
                    for (int n = 0; n < 2; ++n) { const size_t off = ro + bj * 128 + 4 * n; const pg8::f32x4 xi = *(const pg8::f32x4*)(src + off);
                        *(pg8::f32x4*)(dst + off) = xi + gv[bj][n] * acc[ai][bj][m][n]; } }
    }
};
struct TrItem { const float* W; bf16_t* WT; int K, N, k0, n0; };
__device__ __forceinline__ TrItem transpose_decode(const Params& p, int it) {
    constexpr int I_IN = 16 * 64, I_OUT = 16 * 32, I_Q = 16 * 64, I_G = 4 * 8, PER_L = I_IN + I_OUT + I_Q + I_G;
    const int l = it / PER_L; int r = it - l * PER_L; TrItem t;
    if (r < I_IN) { t.W = p.in[8] + (size_t)l * 1024 * 2048; t.K = 1024; t.N = 2048; t.WT = (bf16_t*)(p.ws + WS_WIN_T) + (size_t)l * 2048 * 1024; }
    else if ((r -= I_IN) < I_OUT) { t.W = p.in[9] + (size_t)l * 1024 * 1024; t.K = 1024; t.N = 1024; t.WT = (bf16_t*)(p.ws + WS_WOUT_T) + (size_t)l * 1024 * 1024; }
    else if ((r -= I_OUT) < I_G) { t.W = p.in[27] + (size_t)l * 256 * 256; t.K = 256; t.N = 256; t.WT = (bf16_t*)(p.ws + WS_WGLU_T) + (size_t)l * 256 * 256; }
    else { r -= I_G; t.W = p.in[28] + (size_t)l * 1024 * 2048; t.K = 1024; t.N = 2048; t.WT = (bf16_t*)(p.ws + WS_WQ_T) + (size_t)l * 2048 * 1024; }
    const int nblk = t.N / 32; t.k0 = 64 * (r / nblk); t.n0 = 32 * (r % nblk); return t;
}
__device__ __forceinline__ void phase_pro_w(const Params& p, LAS unsigned char* lds) {
    const int tid = otid(), wave = tid >> 6, lane = tid & 63;
    LAS float* scr = (LAS float*)lds + wave * (64 * 33);
    constexpr int PER_L = 16 * 64 + 16 * 32 + 16 * 64 + 4 * 8, NIT = 2 * PER_L;
    const int step = gridDim.x * NWAVE;
    for (int it0 = obid() * NWAVE + wave; it0 < NIT; it0 += 3 * step) {
        f32x4 wv[3][8];
#pragma unroll
        for (int u = 0; u < 3; ++u) { const int it = it0 + u * step; const TrItem t = transpose_decode(p, it < NIT ? it : it0);
#pragma unroll
            for (int i = 0; i < 8; ++i) wv[u][i] = *(const f32x4*)(t.W + (size_t)(t.k0 + 8 * i + (lane >> 3)) * t.N + t.n0 + 4 * (lane & 7)); }
#pragma unroll
        for (int u = 0; u < 3; ++u) { const int it = it0 + u * step; if (it >= NIT) continue; const TrItem t = transpose_decode(p, it);
#pragma unroll
            for (int i = 0; i < 8; ++i) { LAS float* sp = scr + (8 * i + (lane >> 3)) * 33 + 4 * (lane & 7); sp[0] = wv[u][i].x; sp[1] = wv[u][i].y; sp[2] = wv[u][i].z; sp[3] = wv[u][i].w; }
            asm volatile("s_waitcnt lgkmcnt(0)" ::: "memory");
            const int c = lane & 7;
#pragma unroll
            for (int j = 0; j < 4; ++j) { const int n = (lane >> 3) + 8 * j; const LAS float* sp = scr + (8 * c) * 33 + n;
                u32x4 o; o.x = pk2(sp[0 * 33], sp[1 * 33]); o.y = pk2(sp[2 * 33], sp[3 * 33]); o.z = pk2(sp[4 * 33], sp[5 * 33]); o.w = pk2(sp[6 * 33], sp[7 * 33]);
                *(u32x4*)(t.WT + (size_t)(t.n0 + n) * t.K + t.k0 + 8 * c) = o; }
            asm volatile("s_waitcnt lgkmcnt(0)" ::: "memory"); }
    }
}
template <int MODE>
__device__ __forceinline__ void phase_gemm(const Params& p, int layer, LAS unsigned char* lds) {
    const bool lat_only = (MODE != 0) && (layer == 1);
    RowOrder S; S.init(lat_only ? 128 : 132, MODE == 1 ? 4 : 8, (int)gridDim.x, obid(), lat_only);
    if (MODE == 1) {
        pg8::Gemm g{(const bf16_t*)(p.ws + WS_MIX), (const bf16_t*)(p.ws + WS_WOUT_T) + (size_t)layer * 1024 * 1024, ROWS, 1024, 1024};
        EpiRes E{p.in[0], p.in[2], (float*)(p.ws + WS_X), (const float*)(p.ws + WS_MOD) + (size_t)layer * 5 * 6144, layer, 2};
        pg8::gemm_phase<EpiRes, RowOrder, true, true>(lds, g, S, E);
    } else {
        pg8::Gemm g{(const bf16_t*)(p.ws + WS_H), (const bf16_t*)(p.ws + (MODE == 0 ? WS_WIN_T : WS_WQ_T)) + (size_t)layer * 2048 * 1024, ROWS, 2048, 1024};
        EpiBf E{(bf16_t*)(p.ws + WS_P), INW};
        pg8::gemm_phase<EpiBf, RowOrder, true, true>(lds, g, S, E);
    }
}
#include <hip/hip_bf16.h>
namespace attn_body {
using bf16=__hip_bfloat16;
using bf16x8=__attribute__((ext_vector_type(8)))short;
using s16x4=__attribute__((ext_vector_type(4)))short;
using f32x16=__attribute__((ext_vector_type(16)))float;
using u32x4=__attribute__((ext_vector_type(4)))unsigned;
constexpr int D=64,PQ=2048;
constexpr int NW=8,QBLK=32,QB=QBLK*NW,KVBLK=64;
__device__ __forceinline__ int crow(int r,int hi){return (r&3)+8*(r>>2)+4*hi;}
#define SBAR() __builtin_amdgcn_sched_barrier(0)
__device__ __forceinline__ void cmask(f32x16&p0,f32x16&p1,int jb,int qrel,int hi){
  const float NEG=-INFINITY; int kb=64*jb+4*hi;
  #pragma unroll
  for(int r=0;r<16;++r){int kv=kb+(r&3)+8*(r>>2); if(kv>qrel)p0[r]=NEG; if(kv+32>qrel)p1[r]=NEG;}
}

constexpr int NSLOT=3, SLOTB=8192;
constexpr int LDS_K=0, LDS_V=NSLOT*SLOTB, LDS_WS=2*NSLOT*SLOTB, LDS_OST=LDS_WS+NW*64*4, LDS_BYTES=LDS_OST+NW*4096;
constexpr float C2=0.125f*1.4426950408889634f;
__device__ __forceinline__ void glds16(const void*gsrc,unsigned lds_dst){unsigned keep;
  asm volatile("s_mov_b32 %0, m0\n\ts_mov_b32 m0, %2\n\ts_nop 0\n\tglobal_load_lds_dwordx4 %1, off\n\ts_mov_b32 m0, %0":"=&s"(keep):"v"(gsrc),"s"(lds_dst):"memory");}
__device__ __forceinline__ float max3f(float a,float b,float c){float r;asm("v_max3_f32 %0, %1, %2, %3":"=v"(r):"v"(a),"v"(b),"v"(c));return r;}
__device__ __forceinline__ float max2f(float a,float b){float r;asm("v_max_f32_e32 %0, %1, %2":"=v"(r):"v"(a),"v"(b));return r;}
__device__ __forceinline__ float fadd_s(float a,float b){float r;asm("v_add_f32_e32 %0, %1, %2":"=v"(r):"v"(a),"v"(b));return r;}
__device__ __forceinline__ float fsub_s(float a,float b){float r;asm("v_sub_f32_e32 %0, %1, %2":"=v"(r):"v"(a),"v"(b));return r;}
typedef float f32x2_t __attribute__((ext_vector_type(2))); typedef __bf16 bf16x2_t __attribute__((ext_vector_type(2)));
__device__ __forceinline__ unsigned cvtpk_s(float lo,float hi){f32x2_t v={lo,hi};bf16x2_t b=__builtin_convertvector(v,bf16x2_t);return __builtin_bit_cast(unsigned,b);}
#define WAIT_BAR(N) asm volatile("s_waitcnt vmcnt(" #N ") lgkmcnt(0)\n\ts_barrier":::"memory")

template<int DQK> __device__ __forceinline__ void qkt(f32x16&p0,f32x16&p1,const char*Kslot,const bf16x8*qr,const f32x16&negm,int r32,int hi){
  const char*kb=Kslot+hi*1024+r32*16;
  #pragma unroll
  for(int d0=0;d0<DQK/16;++d0){
    const bf16x8 b0=*reinterpret_cast<const bf16x8*>(kb+d0*2048);
    const bf16x8 b1=*reinterpret_cast<const bf16x8*>(kb+d0*2048+512);
    if(d0==0){p0=__builtin_amdgcn_mfma_f32_32x32x16_bf16(b0,qr[0],negm,0,0,0);p1=__builtin_amdgcn_mfma_f32_32x32x16_bf16(b1,qr[0],negm,0,0,0);}
    else{p0=__builtin_amdgcn_mfma_f32_32x32x16_bf16(b0,qr[d0],p0,0,0,0);p1=__builtin_amdgcn_mfma_f32_32x32x16_bf16(b1,qr[d0],p1,0,0,0);}}
}
typedef __attribute__((address_space(3))) const char* lds_cptr;
typedef short v4i16_t __attribute__((ext_vector_type(4)));
template<int DQK> __device__ __forceinline__ void kload8(bf16x8*kf,lds_cptr kp){
  kf[0]=*(const __attribute__((address_space(3))) bf16x8*)(kp);      kf[1]=*(const __attribute__((address_space(3))) bf16x8*)(kp+512);
  kf[2]=*(const __attribute__((address_space(3))) bf16x8*)(kp+2048); kf[3]=*(const __attribute__((address_space(3))) bf16x8*)(kp+2560);
  if constexpr(DQK==64){
  kf[4]=*(const __attribute__((address_space(3))) bf16x8*)(kp+4096); kf[5]=*(const __attribute__((address_space(3))) bf16x8*)(kp+4608);
  kf[6]=*(const __attribute__((address_space(3))) bf16x8*)(kp+6144); kf[7]=*(const __attribute__((address_space(3))) bf16x8*)(kp+6656);}
}
__device__ __forceinline__ void kload2(bf16x8*kf,lds_cptr kp,int j){ kf[2*j]=*(const __attribute__((address_space(3))) bf16x8*)(kp+j*2048); kf[2*j+1]=*(const __attribute__((address_space(3))) bf16x8*)(kp+j*2048+512); }
__device__ __forceinline__ s16x4 vtr(lds_cptr p){ return __builtin_bit_cast(s16x4,__builtin_amdgcn_ds_read_tr16_b64_v4i16((__attribute__((address_space(3))) v4i16_t*)p)); }
__device__ __forceinline__ float rowmax(const f32x16&p0,const f32x16&p1){
  float a=max3f(p0[0],p0[1],p1[0]),b=max3f(p0[2],p0[3],p1[1]);a=max3f(a,p1[2],p1[3]);
  #pragma unroll
  for(int r=4;r<16;r+=4){a=max3f(a,p0[r],p0[r+1]);b=max3f(b,p0[r+2],p0[r+3]);a=max3f(a,p1[r],p1[r+1]);b=max3f(b,p1[r+2],p1[r+3]);}
  const float m=max2f(a,b);
  auto rr=__builtin_amdgcn_permlane32_swap(__float_as_uint(m),__float_as_uint(m),false,false);
  return max2f(__uint_as_float(rr[0]),__uint_as_float(rr[1]));
}
__device__ __forceinline__ void pv(f32x16*o,int vb,bf16x8 pa0,bf16x8 pa1,bf16x8 pa2,bf16x8 pa3){
  #pragma unroll
  for(int d0=0;d0<2;++d0){s16x4 lo[4],hi[4];
    #pragma unroll
    for(int ks=0;ks<4;++ks){
      asm volatile("ds_read_b64_tr_b16 %0,%1 offset:%c2":"=&v"(lo[ks]):"v"(vb),"i"(d0*4096+ks*1024):"memory");
      asm volatile("ds_read_b64_tr_b16 %0,%1 offset:%c2":"=&v"(hi[ks]):"v"(vb),"i"(d0*4096+ks*1024+512):"memory");}
    asm volatile("s_waitcnt lgkmcnt(0)":::"memory");SBAR();
    #define PK(k) (bf16x8){lo[k][0],lo[k][1],lo[k][2],lo[k][3],hi[k][0],hi[k][1],hi[k][2],hi[k][3]}
    o[d0]=__builtin_amdgcn_mfma_f32_32x32x16_bf16(pa0,PK(0),o[d0],0,0,0);
    o[d0]=__builtin_amdgcn_mfma_f32_32x32x16_bf16(pa1,PK(1),o[d0],0,0,0);
    o[d0]=__builtin_amdgcn_mfma_f32_32x32x16_bf16(pa2,PK(2),o[d0],0,0,0);
    o[d0]=__builtin_amdgcn_mfma_f32_32x32x16_bf16(pa3,PK(3),o[d0],0,0,0);
    #undef PK
  }
}

#ifndef ATTN_STORE16
#define ATTN_STORE16(p,v) (*(u32x4*)(p)=(v))
#endif
template<int THRL,int DQK,bool FIXM> __device__ __forceinline__ void attn_unit(const bf16*Qu,const bf16*__restrict__ Kh,const bf16*__restrict__ Vh,bf16*Ou,const int po,const int NT,const float Mfix,char*shm){
  const int tid=threadIdx.x,lane=tid&63,r32=lane&31,hi=lane>>5; const int wid=__builtin_amdgcn_readfirstlane(tid>>6);
  const bf16*Qw=Qu+(long)(wid*QBLK)*PQ;
  const unsigned lds0=(unsigned)(uintptr_t)shm;
  float*wsf=(float*)(shm+LDS_WS)+wid*64;
  const int kch=(DQK==64)?wid:(wid&3);
  const bf16*ksrc=Kh+(long)lane*PQ+kch*8;
  const bf16*vsrc=Vh+(long)(16*(wid&3)+(lane>>2))*PQ+(wid>>2)*32+(lane&3)*8;
  const unsigned kdst=lds0+LDS_K+kch*1024, vdst=lds0+LDS_V+wid*1024;
  #define DMA_K(t,slot) glds16(ksrc+(long)(t)*KVBLK*PQ,(unsigned)__builtin_amdgcn_readfirstlane(kdst+(slot)))
  #define DMA_V(t,slot) glds16(vsrc+(long)(t)*KVBLK*PQ,(unsigned)__builtin_amdgcn_readfirstlane(vdst+(slot)))
  const int vb0=(int)(lds0+LDS_V)+((lane>>4)&1)*32+(lane&3)*8+(4*hi+((lane&15)>>2))*64;
  const char*Kbase=shm+LDS_K; bf16x8 kf[8];
  const lds_cptr shm3=(lds_cptr)shm; const lds_cptr kp0=shm3+LDS_K+hi*1024+r32*16; const lds_cptr vp0=shm3+LDS_V+((lane>>4)&1)*32+(lane&3)*8+(4*hi+((lane&15)>>2))*64;
  DMA_K(0,0);DMA_V(0,0);DMA_K(1,SLOTB);
  bf16x8 qr[4];
  #pragma unroll
  for(int d0=0;d0<DQK/16;++d0)qr[d0]=*reinterpret_cast<const bf16x8*>(&Qw[(long)r32*PQ+d0*16+hi*8]);
  float mhat=0.f,l_reg=0.f;f32x16 o[2];o[0]=f32x16{};o[1]=f32x16{};f32x16 negm=f32x16{};asm volatile("":"+v"(negm));
  #define CMASK(P0,P1,t) do{}while(0)
  bool resc=false;
  #define START(P0,P1) do{ const float rm=FIXM?Mfix:rowmax(P0,P1); resc=false; \
    { const float dl=rm; mhat=fadd_s(mhat,dl); \
      _Pragma("unroll") for(int r=0;r<16;++r){P0[r]=fsub_s(P0[r],dl);P1[r]=fsub_s(P1[r],dl);} \
      _Pragma("unroll") for(int r=0;r<16;++r)negm[r]=-mhat; asm volatile("":"+v"(negm)); } \
    _Pragma("unroll") for(int r=0;r<16;++r)P0[r]=__builtin_amdgcn_exp2f(P0[r]); }while(0)
  #define RESC() do{ if(resc){ asm volatile("s_waitcnt lgkmcnt(0)":::"memory"); \
      _Pragma("unroll") for(int d_=0;d_<2;++d_) _Pragma("unroll") for(int r=0;r<16;++r)o[d_][r]*=wsf[crow(r,hi)]; } }while(0)
  f32x16 pA0,pA1,pB0,pB1;
  int sl_prev=0,sl_cur=0,sl_next=SLOTB;
  #define ROT() do{sl_prev=sl_cur;sl_cur=sl_next;sl_next=(sl_next==(NSLOT-1)*SLOTB)?0:sl_next+SLOTB;}while(0)
  DMA_K(2,2*SLOTB);
  WAIT_BAR(3);
  qkt<DQK>(pA0,pA1,Kbase,qr,negm,r32,hi);asm volatile("s_nop 15\n\ts_nop 7":"+v"(pA0),"+v"(pA1));CMASK(pA0,pA1,0);
  START(pA0,pA1);
  _Pragma("unroll") for(int r=0;r<16;++r)pA1[r]=__builtin_amdgcn_exp2f(pA1[r]);
  WAIT_BAR(0);
  DMA_K(3,0);DMA_V(1,SLOTB);
  ROT();
  kload8<DQK>(kf,kp0+sl_cur);
  WAIT_BAR(2);
  s16x4 vlo[8],vhi[8]; u32x4 pw0,pw1,pw2,pw3;
  #define PKW(P,B) cvtpk_s(P[B],P[B+1])
  #define PAF(k) __builtin_bit_cast(bf16x8,pw##k)
  #define VFR(i) (bf16x8){vlo[i][0],vlo[i][1],vlo[i][2],vlo[i][3],vhi[i][0],vhi[i][1],vhi[i][2],vhi[i][3]}
  #define PIN(x) asm volatile("":"+v"(x))
  #define MX3(a,b,c) __builtin_fmaxf(__builtin_fmaxf((a),(b)),(c))
  #define GAPA(MF,A0,A1,A2,A3,W0,W1,PW) do{ MF; sacc+=A0; sacc+=A1; sacc+=A2; sacc+=A3; PIN(sacc); W0; W1; PIN(PW); SBAR(); }while(0)
  #define EX(v) __builtin_amdgcn_exp2f(v)
  #define GAPB(MF,X,B) do{ MF; X[B]=EX(X[B]); X[B+1]=EX(X[B+1]); X[B+2]=EX(X[B+2]); X[B+3]=EX(X[B+3]); PIN(X); SBAR(); }while(0)
  #define VRD(i) do{ vlo[i]=vtr(vp_+(((i)>>2)*4096+((i)&3)*1024)); vhi[i]=vtr(vp_+(((i)>>2)*4096+((i)&3)*1024+512)); }while(0)
  #define KRD(G,j) do{ if((G)&&(DQK==64||(j)<2)){ kload2(kf,kp0+sl_next,j); SBAR(); } }while(0)
  #define STEP(C0,C1,P0,P1,t,GK,GV,GL) do{ SBAR(); \
    const lds_cptr vp_=vp0+sl_prev; \
    VRD(0); SBAR(); float sacc=(P0[0]+P0[1]); \
    GAPA(C0=__builtin_amdgcn_mfma_f32_32x32x16_bf16(kf[0],qr[0],negm,0,0,0), P0[2],P0[3],P0[4],P0[5],     pw0[0]=PKW(P0,0), pw0[1]=PKW(P0,2), pw0); \
    VRD(4); SBAR(); GAPA(C1=__builtin_amdgcn_mfma_f32_32x32x16_bf16(kf[1],qr[0],negm,0,0,0), P0[6],P0[7],P0[8],P0[9],     pw0[2]=PKW(P0,4), pw0[3]=PKW(P0,6), pw0); \
    VRD(1); SBAR(); GAPA(C0=__builtin_amdgcn_mfma_f32_32x32x16_bf16(kf[2],qr[1],C0,0,0,0),   P0[10],P0[11],P0[12],P0[13], pw1[0]=PKW(P0,8), pw1[1]=PKW(P0,10), pw1); \
    VRD(5); SBAR(); GAPA(C1=__builtin_amdgcn_mfma_f32_32x32x16_bf16(kf[3],qr[1],C1,0,0,0),   P0[14],P0[15],P1[0],P1[1],   pw1[2]=PKW(P0,12),pw1[3]=PKW(P0,14), pw1); \
    VRD(2); SBAR(); GAPA(if constexpr(DQK==64){C0=__builtin_amdgcn_mfma_f32_32x32x16_bf16(kf[4],qr[2],C0,0,0,0);},   P1[2],P1[3],P1[4],P1[5],     pw2[0]=PKW(P1,0), pw2[1]=PKW(P1,2), pw2); \
    VRD(6); SBAR(); GAPA(if constexpr(DQK==64){C1=__builtin_amdgcn_mfma_f32_32x32x16_bf16(kf[5],qr[2],C1,0,0,0);},   P1[6],P1[7],P1[8],P1[9],     pw2[2]=PKW(P1,4), pw2[3]=PKW(P1,6), pw2); \
    VRD(3); SBAR(); GAPA(if constexpr(DQK==64){C0=__builtin_amdgcn_mfma_f32_32x32x16_bf16(kf[6],qr[3],C0,0,0,0);},   P1[10],P1[11],P1[12],P1[13], pw3[0]=PKW(P1,8), pw3[1]=PKW(P1,10), pw3); \
    VRD(7); SBAR(); GAPA(if constexpr(DQK==64){C1=__builtin_amdgcn_mfma_f32_32x32x16_bf16(kf[7],qr[3],C1,0,0,0);},   P1[14],P1[15],0.f,0.f,       pw3[2]=PKW(P1,12),pw3[3]=PKW(P1,14), pw3); \
    l_reg+=sacc; \
    if(GK){DMA_K((t)+3,sl_cur);} if(GV){DMA_V((t)+1,sl_next);} \
    CMASK(C0,C1,t); \
    if constexpr(!FIXM){ float a=MX3(C0[0],C0[1],C1[0]),b=MX3(C0[2],C0[3],C1[1]); a=MX3(a,C1[2],C1[3]); \
      _Pragma("unroll") for(int r=4;r<16;r+=4){a=MX3(a,C0[r],C0[r+1]);b=MX3(b,C0[r+2],C0[r+3]);a=MX3(a,C1[r],C1[r+1]);b=MX3(b,C1[r+2],C1[r+3]);} \
      float rm=__builtin_fmaxf(a,b); { auto rr=__builtin_amdgcn_permlane32_swap(__float_as_uint(rm),__float_as_uint(rm),false,false); rm=__builtin_fmaxf(__uint_as_float(rr[0]),__uint_as_float(rr[1])); } \
      resc=false; \
      if(__builtin_expect(__any(rm>(float)THRL),0)){ const float dl=__builtin_fmaxf(rm,0.f); mhat+=dl; \
        _Pragma("unroll") for(int r=0;r<16;++r){C0[r]-=dl;C1[r]-=dl;} \
        _Pragma("unroll") for(int r=0;r<16;++r)negm[r]=-mhat; asm volatile("":"+v"(negm)); \
        const float f=__builtin_amdgcn_exp2f(-dl); l_reg*=f; if(hi==0)wsf[r32]=f; resc=true; } } \
    SBAR(); \
    GAPB(o[0]=__builtin_amdgcn_mfma_f32_32x32x16_bf16(PAF(0),VFR(0),o[0],0,0,0), C0,0); \
    GAPB(o[1]=__builtin_amdgcn_mfma_f32_32x32x16_bf16(PAF(0),VFR(4),o[1],0,0,0), C0,4); \
    KRD(GL,0); GAPB(o[0]=__builtin_amdgcn_mfma_f32_32x32x16_bf16(PAF(1),VFR(1),o[0],0,0,0), C0,8); \
    KRD(GL,1); GAPB(o[1]=__builtin_amdgcn_mfma_f32_32x32x16_bf16(PAF(1),VFR(5),o[1],0,0,0), C0,12); \
    KRD(GL,2); GAPB(o[0]=__builtin_amdgcn_mfma_f32_32x32x16_bf16(PAF(2),VFR(2),o[0],0,0,0), C1,0); \
    KRD(GL,3); GAPB(o[1]=__builtin_amdgcn_mfma_f32_32x32x16_bf16(PAF(2),VFR(6),o[1],0,0,0), C1,4); \
    GAPB(o[0]=__builtin_amdgcn_mfma_f32_32x32x16_bf16(PAF(3),VFR(3),o[0],0,0,0), C1,8); \
    GAPB(o[1]=__builtin_amdgcn_mfma_f32_32x32x16_bf16(PAF(3),VFR(7),o[1],0,0,0), C1,12); \
    }while(0)
  int t=1;
  #undef CMASK
  #define CMASK(P0,P1,t) do{}while(0)
  for(;t+5<NT;t+=2){
    STEP(pB0,pB1,pA0,pA1,t,true,true,true);     WAIT_BAR(2); RESC(); ROT();
    STEP(pA0,pA1,pB0,pB1,t+1,true,true,true);   WAIT_BAR(2); RESC(); ROT();
  }
  #undef CMASK
  #define CMASK(P0,P1,t) do{}while(0)
  #define ENDW(tt) do{ if((tt)+3<NT){WAIT_BAR(2);} else if((tt)+2<NT){WAIT_BAR(1);} else {WAIT_BAR(0);} }while(0)
  for(;t+1<NT;t+=2){
    STEP(pB0,pB1,pA0,pA1,t,(t+3<NT),(t+1<NT),(t+1<NT));       ENDW(t);   RESC(); ROT();
    STEP(pA0,pA1,pB0,pB1,t+1,(t+4<NT),(t+2<NT),(t+2<NT));     ENDW(t+1); RESC(); ROT();
  }
  STEP(pB0,pB1,pA0,pA1,NT-1,false,false,false); RESC();
  { float sacc=pB0[0]+pB0[1]; _Pragma("unroll") for(int r=2;r<16;++r)sacc+=pB0[r]; _Pragma("unroll") for(int r=0;r<16;++r)sacc+=pB1[r]; l_reg+=sacc;
    pw0=(u32x4){PKW(pB0,0),PKW(pB0,2),PKW(pB0,4),PKW(pB0,6)};pw1=(u32x4){PKW(pB0,8),PKW(pB0,10),PKW(pB0,12),PKW(pB0,14)};pw2=(u32x4){PKW(pB1,0),PKW(pB1,2),PKW(pB1,4),PKW(pB1,6)};pw3=(u32x4){PKW(pB1,8),PKW(pB1,10),PKW(pB1,12),PKW(pB1,14)};
    SBAR(); pv(o,vb0+sl_cur,PAF(0),PAF(1),PAF(2),PAF(3)); }
  #undef PKW
  #undef PAF
  #undef VFR
  #undef PIN
  #undef MX3
  #undef GAPA
  #undef GAPB
  #undef EX
  #undef VRD
  #undef KRD
  #undef STEP
  #undef ENDW
  {auto rr=__builtin_amdgcn_permlane32_swap(__float_as_uint(l_reg),__float_as_uint(l_reg),false,false);l_reg=__uint_as_float(rr[0])+__uint_as_float(rr[1]);}
  if(hi==0)wsf[32+r32]=l_reg;asm volatile("s_waitcnt lgkmcnt(0)":::"memory");
  float rli[16];
  #pragma unroll
  for(int r=0;r<16;++r)rli[r]=__builtin_amdgcn_rcpf(wsf[32+crow(r,hi)]);
  bf16*Ow=Ou+(long)(wid*QBLK)*po;
  { bf16*stg=(bf16*)(shm+LDS_OST)+wid*2048;
    #pragma unroll
    for(int r=0;r<16;++r){const int orow=crow(r,hi);
      #pragma unroll
      for(int d0=0;d0<2;++d0)stg[orow*64+d0*32+r32]=__float2bfloat16(o[d0][r]*rli[r]);}
    asm volatile("s_waitcnt lgkmcnt(0)":::"memory");
    #pragma unroll
    for(int i=0;i<4;++i){const int row=i*8+(lane>>3),ch=lane&7; const u32x4 v=*(const u32x4*)(stg+row*64+ch*8); ATTN_STORE16(Ow+(long)row*po+ch*8,v);} }
  asm volatile("s_waitcnt lgkmcnt(0)\n\ts_barrier":::"memory");
  #undef DMA_K
  #undef DMA_V
  #undef CMASK
  #undef START
  #undef RESC
  #undef ROT
}
constexpr int ATTN_LDS_BYTES=LDS_BYTES;
#undef SBAR
#undef WAIT_BAR
}

__device__ __forceinline__ void phase_pro_a(const Params& p, LAS unsigned char* lds) {
    const int gtid = obid() * NTHR + otid(), GT = gridDim.x * NTHR;
    {
        LAS float* sl = (LAS float*)lds; const int tid = otid();
        for (int bi = obid(); bi < 2 * 8 * 16; bi += gridDim.x) {
            const int l = bi >> 7, kq = (bi >> 4) & 7, n = (bi & 15) * 384 + tid;
            __syncthreads();
            for (int e = tid; e < 5 * 128; e += NTHR) { const int v = e >> 7, k = kq * 128 + (e & 127); const float cv = v < 4 ? p.in[1][v * D + k] : p.in[3][k]; sl[e] = cv / (1.f + expf(-cv)); }
            __syncthreads();
            if (tid < 384) {
                const float* W = p.in[4] + (size_t)l * D * 6144 + (size_t)(kq * 128) * 6144 + n;
                float acc[5] = {0.f, 0.f, 0.f, 0.f, 0.f};
#pragma unroll 32
                for (int k = 0; k < 128; ++k) { const float w = W[(size_t)k * 6144];
#pragma unroll
                    for (int v = 0; v < 5; ++v) acc[v] += sl[v * 128 + k] * w; }
                float* modp = (float*)(p.ws + WS_MODP);
#pragma unroll
                for (int v = 0; v < 5; ++v) modp[((size_t)(kq * 2 + l) * 5 + v) * 6144 + n] = acc[v];
            }
        }
        __syncthreads();
    }
    constexpr int N_A = 0, N_B = 192 * 16, N_C = 192 * 8, N_D = 2 * 2 * 16 * 64 * 34, N_E = 2, N_K = 2 * 16 * 128 * 128 / 2;
    float2* tabA = (float2*)(p.ws + WS_TABA); float2* tabB = (float2*)(p.ws + WS_TABB);
    float* scal = (float*)(p.ws + WS_SCAL);
    float2* apow = (float2*)(p.ws + WS_APOW); float2* bbar = (float2*)(p.ws + WS_BBAR);
    for (int it = gtid; it < N_A + N_B + N_C + N_D + N_E + N_K; it += GT) {
        int r = it;
        if (r >= N_A + N_B + N_C + N_D + N_E) { r -= N_A + N_B + N_C + N_D + N_E; ((unsigned*)(p.ws + WS_KEYS16))[r] = pk2(p.in[29][2 * r], p.in[29][2 * r + 1]); continue; }
        r -= N_A;
        if (r < N_B) {
            const int e = r / 16, j = r % 16; const int pos = e < 128 ? e : e - 128;
            const float inv = (float)exp(-((double)(2 * j) / 32.0) * 9.210340371976184);
            const float ang = (float)pos * inv; double s, c; sincos_d((double)ang, s, c);
            tabA[r] = make_float2((float)c, (float)s); continue;
        }
        r -= N_B;
        if (r < N_C) {
            const int e = r / 8, j = r % 8; const int pos = e < 128 ? e : e - 128;
            const float inv = (float)exp(-((double)(2 * j) / 16.0) * 9.210340371976184);
            const float ang = (float)pos * inv; double s, c; sincos_d((double)ang, s, c);
            tabB[r] = make_float2((float)c, (float)s); continue;
        }
        r -= N_C;
        if (r < N_D) {
            const int m = r % 34; r /= 34;
            const int ldg = r / 64;
            const double are = p.in[19][r], aim = p.in[20][r], dt = exp((double)p.in[21][ldg]);
            if (m <= 32) { const double em = exp(are * dt * (double)m); double sm, cm; sincos_d(aim * dt * (double)m, sm, cm); apow[(size_t)r * 33 + m] = make_float2((float)(em * cm), (float)(em * sm)); continue; }
            const double er = exp(are * dt); double sn, cs; sincos_d(aim * dt, sn, cs);
            const double abr = er * cs, abi = er * sn;
            const double nr = abr - 1.0, ni = abi, den = are * are + aim * aim;
            const double cr = (nr * are + ni * aim) / den, ci = (ni * are - nr * aim) / den;
#pragma unroll 1
            for (int q = 0; q < 16; ++q) { const double br = p.in[22][(size_t)r * 16 + q], bi = p.in[23][(size_t)r * 16 + q];
                bbar[(size_t)r * 16 + q] = make_float2((float)(cr * br - ci * bi), (float)(cr * bi + ci * br)); }
            continue;
        }
        r -= N_D;
        {
            const int l = r; float s1 = 0.f, s2 = 0.f;
            for (int i = 0; i < 32; ++i) { s1 += p.in[14][l * 32 + i] * p.in[15][l * 32 + i]; s2 += p.in[16][l * 32 + i] * p.in[17][l * 32 + i]; }
            const float lam_init = 0.8f - 0.6f * expf(-0.3f * (float)l);
            scal[l] = expf(s1) - expf(s2) + lam_init;
            float mqa = 0.f, mka = 0.f, mqb = 0.f, mkb = 0.f;
            for (int i = 0; i < 64; ++i) { mqa = fmaxf(mqa, fabsf(p.in[10][l * 64 + i])); mka = fmaxf(mka, fabsf(p.in[11][l * 64 + i])); }
            for (int i = 0; i < 32; ++i) { mqb = fmaxf(mqb, fabsf(p.in[12][l * 32 + i])); mkb = fmaxf(mkb, fabsf(p.in[13][l * 32 + i])); }
            scal[2 + l] = fminf(LOG2E * 8.f * mqa * mka * 1.02f, 60.f);
            scal[4 + l] = fminf(LOG2E * 5.656854249f * mqb * mkb * 1.02f, 60.f);
        }
    }
}
__device__ __forceinline__ void phase_pro_b(const Params& p) {
    const int gtid = obid() * NTHR + otid(), GT = gridDim.x * NTHR;
    const float* modp = (const float*)(p.ws + WS_MODP); float* mod = (float*)(p.ws + WS_MOD);
    for (int it = gtid; it < 2 * 5 * 6144; it += GT) {
        const int l = it / (5 * 6144), v = (it / 6144) % 5, n = it % 6144;
        float a = p.in[5][l * 6144 + n];
        for (int kq = 0; kq < 8; ++kq) a += modp[((size_t)(kq * 2 + l) * 5 + v) * 6144 + n];
        mod[it] = a;
    }
    const float2* apow = (const float2*)(p.ws + WS_APOW); const float2* bbar = (const float2*)(p.ws + WS_BBAR);
    bf16_t* KT = (bf16_t*)(p.ws + WS_KT); bf16_t* B2 = (bf16_t*)(p.ws + WS_B2CAT); bf16_t* G2 = (bf16_t*)(p.ws + WS_G2CAT);
    for (int it4 = gtid; it4 < 2 * 16 * 63 * 16 * 4; it4 += GT) {
        const int it = it4 >> 2, nq = it4 & 3;
        const int pp = it & 15, idx = (it >> 4) % 63, g = ((it >> 4) / 63) & 15, l = (it >> 4) / (63 * 16);
        const int lam = idx - 31; float val[16];
#pragma unroll
        for (int q = 0; q < 16; ++q) val[q] = 0.f;
#pragma unroll 1
        for (int dir = 0; dir < 2; ++dir) {
            if (dir == 0 ? lam < 0 : lam > 0) continue;
            const int m = lam < 0 ? -lam : lam; const int pb = (l * 2 + dir) * 16 + g;
            const float* cre = p.in[24] + (size_t)(pb * 16 + pp) * 64; const float* cim = p.in[25] + (size_t)(pb * 16 + pp) * 64;
#pragma unroll 4
            for (int jn = 0; jn < 16; ++jn) { const int n = 4 * jn + nq; const float2 A = apow[(size_t)(pb * 64 + n) * 33 + m]; const float cr = cre[n], ci = cim[n];
                const float zr = cr * A.x - ci * A.y, zi = cr * A.y + ci * A.x;
                const f32x4* bq = (const f32x4*)(bbar + (size_t)(pb * 64 + n) * 16);
#pragma unroll
                for (int q2 = 0; q2 < 8; ++q2) { const f32x4 bb = bq[q2]; val[2 * q2] += zr * bb.x - zi * bb.y; val[2 * q2 + 1] += zr * bb.z - zi * bb.w; } }
        }
#pragma unroll
        for (int q = 0; q < 16; ++q) { val[q] += __shfl_xor(val[q], 1); val[q] += __shfl_xor(val[q], 2); }
        if (lam == 0) {
#pragma unroll
            for (int q = 0; q < 16; ++q) if (q == pp) val[q] += p.in[26][l * 256 + g * 16 + pp];
        }
        if (nq == 0) {
            u32x4 o0, o1;
            o0.x = pk2(val[0], val[1]); o0.y = pk2(val[2], val[3]); o0.z = pk2(val[4], val[5]); o0.w = pk2(val[6], val[7]);
            o1.x = pk2(val[8], val[9]); o1.y = pk2(val[10], val[11]); o1.z = pk2(val[12], val[13]); o1.w = pk2(val[14], val[15]);
            *(u32x4*)(KT + (size_t)it * 16) = o0; *(u32x4*)(KT + (size_t)it * 16 + 8) = o1;
        }
    }
    for (int it = gtid; it < 2 * 16 * 256 * 64; it += GT) {
        const int col8 = it & 63, k = (it >> 6) & 255, g = (it >> 14) & 15, l = it >> 18;
        const int dir = k >> 7, part = (k >> 6) & 1, n = k & 63, i = col8 >> 1, q0 = (col8 & 1) * 8; const int e = dir == 0 ? 31 - i : i;
        const int pb = (l * 2 + dir) * 16 + g;
        const float2 A = apow[(size_t)(pb * 64 + n) * 33 + e]; const f32x4* bq = (const f32x4*)(bbar + (size_t)(pb * 64 + n) * 16 + q0);
        float v[8];
#pragma unroll
        for (int q2 = 0; q2 < 4; ++q2) { const f32x4 bb = bq[q2];
            v[2 * q2] = part == 0 ? A.x * bb.x - A.y * bb.y : A.x * bb.y + A.y * bb.x; v[2 * q2 + 1] = part == 0 ? A.x * bb.z - A.y * bb.w : A.x * bb.w + A.y * bb.z; }
        u32x4 o; o.x = pk2(v[0], v[1]); o.y = pk2(v[2], v[3]); o.z = pk2(v[4], v[5]); o.w = pk2(v[6], v[7]);
        *(u32x4*)(B2 + (size_t)it * 8) = o;
    }
    for (int it0 = gtid; it0 < 2 * 16 * 512 * 32; it0 += 4 * GT) {
        float2 A[4][8]; f32x4 crv[4][2], civ[4][2];
#pragma unroll
        for (int u = 0; u < 4; ++u) { const int it = it0 + u * GT; const int itc = it < 2 * 16 * 512 * 32 ? it : it0;
            const int k8 = itc & 31, row = (itc >> 5) & 511, g = (itc >> 14) & 15, l = itc >> 18;
            const int k = k8 * 8, dir = k >> 7, n0 = k & 63, i = row >> 4, pp = row & 15; const int e = dir == 0 ? i + 1 : 32 - i;
            const int pb = (l * 2 + dir) * 16 + g;
            const float* cre = p.in[24] + (size_t)(pb * 16 + pp) * 64 + n0; const float* cim = p.in[25] + (size_t)(pb * 16 + pp) * 64 + n0;
            crv[u][0] = *(const f32x4*)cre; crv[u][1] = *(const f32x4*)(cre + 4); civ[u][0] = *(const f32x4*)cim; civ[u][1] = *(const f32x4*)(cim + 4);
#pragma unroll
            for (int jn = 0; jn < 8; ++jn) A[u][jn] = apow[(size_t)(pb * 64 + n0 + jn) * 33 + e]; }
#pragma unroll
        for (int u = 0; u < 4; ++u) { const int it = it0 + u * GT; if (it >= 2 * 16 * 512 * 32) continue;
            const int part = (((it & 31) * 8) >> 6) & 1;
            const float cr[8] = {crv[u][0].x, crv[u][0].y, crv[u][0].z, crv[u][0].w, crv[u][1].x, crv[u][1].y, crv[u][1].z, crv[u][1].w};
            const float ci[8] = {civ[u][0].x, civ[u][0].y, civ[u][0].z, civ[u][0].w, civ[u][1].x, civ[u][1].y, civ[u][1].z, civ[u][1].w};
            float v[8];
#pragma unroll
            for (int jn = 0; jn < 8; ++jn) v[jn] = part == 0 ? cr[jn] * A[u][jn].x - ci[jn] * A[u][jn].y : -(cr[jn] * A[u][jn].y + ci[jn] * A[u][jn].x);
            u32x4 o; o.x = pk2(v[0], v[1]); o.y = pk2(v[2], v[3]); o.z = pk2(v[4], v[5]); o.w = pk2(v[6], v[7]);
            *(u32x4*)(G2 + (size_t)it * 8) = o; }
    }
}
__device__ __forceinline__ void phase_norm(const Params& p, int layer, int which) {
    const int wave = otid() >> 6, lane = otid() & 63;
    const float* mod = (const float*)(p.ws + WS_MOD) + (size_t)layer * 5 * 6144;
    const float* gain = (which ? p.in[7] : p.in[6]) + layer * D;
    bf16_t* H = (bf16_t*)(p.ws + WS_H);
    const bool xin_ws = (which == 1) || (layer == 1);
    const bool lat = (which == 1 && layer == 1);
    const int nrows = lat ? NB * L : ROWS, rstart = (obid() * NWAVE + wave) * 4, rstep = gridDim.x * NWAVE * 4;
    f32x4 gs[4], shv[4]; int mcur = -1;
#pragma unroll
    for (int q = 0; q < 4; ++q) { gs[q] = (f32x4){0.f, 0.f, 0.f, 0.f}; shv[q] = gs[q]; }
    for (int li = rstart; li < nrows; li += rstep) {
        const int r0 = lat ? (li >> 13) * RPB + LC + (li & 8191) : li; const int b = r0 / RPB, j = r0 - b * RPB;
        const float* xr = xin_ws ? (const float*)(p.ws + WS_X) + (size_t)r0 * D : src_row(p, 0, r0);
        f32x4 v[16];
#pragma unroll
        for (int q = 0; q < 16; ++q) v[q] = *(const f32x4*)(xr + (size_t)(q >> 2) * D + 4 * lane + 256 * (q & 3));
        const int mrow = j < LC ? 4 : b;
        if (mrow != mcur) { mcur = mrow; const float* mv = mod + (size_t)mrow * 6144;
#pragma unroll
            for (int q = 0; q < 4; ++q) { const int c = 4 * lane + 256 * q;
                const f32x4 g = *(const f32x4*)(gain + c); const f32x4 sc = *(const f32x4*)(mv + (which ? 4 : 1) * D + c);
                shv[q] = *(const f32x4*)(mv + (which ? 3 : 0) * D + c);
                gs[q].x = g.x * (1.f + sc.x); gs[q].y = g.y * (1.f + sc.y); gs[q].z = g.z * (1.f + sc.z); gs[q].w = g.w * (1.f + sc.w); } }
        float ss[4];
#pragma unroll
        for (int k = 0; k < 4; ++k) { ss[k] = 0.f;
#pragma unroll
            for (int q = 0; q < 4; ++q) { const f32x4 t = v[4 * k + q]; ss[k] += t.x * t.x + t.y * t.y + t.z * t.z + t.w * t.w; } }
#pragma unroll
        for (int o = 1; o < 64; o <<= 1) {
#pragma unroll
            for (int k = 0; k < 4; ++k) ss[k] += __shfl_xor(ss[k], o); }
#pragma unroll
        for (int k = 0; k < 4; ++k) {
            const float rinv = 1.f / sqrtf(ss[k] * (1.f / D) + EPS);
#pragma unroll
            for (int q = 0; q < 4; ++q) { const int c = 4 * lane + 256 * q; const f32x4 t = v[4 * k + q];
                const float y0 = t.x * rinv * gs[q].x + shv[q].x, y1 = t.y * rinv * gs[q].y + shv[q].y;
                const float y2 = t.z * rinv * gs[q].z + shv[q].z, y3 = t.w * rinv * gs[q].w + shv[q].w;
                u32x2 o; o.x = pk2(y0, y1); o.y = pk2(y2, y3);
                *(u32x2*)(H + (size_t)(r0 + k) * D + c) = o; }
        }
    }
}
template <int GL>
__device__ __forceinline__ void norm_rope_pass(bf16_t* prow, int colbase, const float* gain, const float2* tab, int tok, float scale, int lane) {
    const int pi = lane & (GL - 1), hsel = lane / GL;
    bf16_t* ptr = prow + colbase + hsel * (2 * GL) + 2 * pi;
    const unsigned raw = *(const unsigned*)ptr;
    const float x0 = bf2f(raw & 0xffffu), x1 = bf2f(raw >> 16);
    float ss = x0 * x0 + x1 * x1;
#pragma unroll
    for (int o = 1; o < GL; o <<= 1) ss += __shfl_xor(ss, o);
    const float rinv = 1.f / sqrtf(ss * (1.f / (2 * GL)) + EPS);
    float y0 = x0 * rinv * gain[2 * pi], y1 = x1 * rinv * gain[2 * pi + 1];
    if (tok >= 0) {
        constexpr int Q = GL / 2;
        const int e = pi < Q ? (tok >> 6) : 128 + (tok & 63);
        const float2 cs = tab[e * Q + (pi & (Q - 1))];
        const float o0 = y0 * cs.x - y1 * cs.y, o1 = y0 * cs.y + y1 * cs.x; y0 = o0; y1 = o1;
    }
    *(unsigned*)ptr = pk2(y0 * scale, y1 * scale);
}
__device__ __forceinline__ void phase_qkrope_s5a(const Params& p, int layer, LAS unsigned char* lds) {
    const int wave = otid() >> 6, lane = otid() & 63;
    bf16_t* P = (bf16_t*)(p.ws + WS_P);
    const float2* tabA = (const float2*)(p.ws + WS_TABA); const float2* tabB = (const float2*)(p.ws + WS_TABB);
    const float* qna = p.in[10] + layer * 64; const float* kna = p.in[11] + layer * 64;
    const float* qnb = p.in[12] + layer * 32; const float* knb = p.in[13] + layer * 32;
    const float scA = 0.125f * LOG2E, scB = 0.17677669529663687f * LOG2E;
    float gA[8], gB[8], gBk[8];
    {   const int hA = lane >> 3, dA = (lane & 7) * 8, dB = (lane & 3) * 8;
#pragma unroll
        for (int i = 0; i < 8; ++i) { gA[i] = (hA < 6 ? qna : kna)[dA + i] * (hA < 6 ? scA : 1.f); gB[i] = lane < 48 ? qnb[dB + i] * scB : knb[dB + i]; gBk[i] = knb[dB + i]; } }
#define QKR_PASS(colbase, NL, gsel, LSEL, DOST, WIN, T0, T1) do { \
        bf16_t* ptr_ = prow + (colbase) + (LSEL) * 8; const u32x4 w_ = (WIN); const unsigned ww_[4] = {w_.x, w_.y, w_.z, w_.w}; \
        float x_[8]; float ss_ = 0.f; \
        _Pragma("unroll") for (int q_ = 0; q_ < 4; ++q_) { x_[2 * q_] = bf2f(ww_[q_] & 0xffffu); x_[2 * q_ + 1] = bf2f(ww_[q_] >> 16); ss_ += x_[2 * q_] * x_[2 * q_] + x_[2 * q_ + 1] * x_[2 * q_ + 1]; } \
        ss_ += __int_as_float(__builtin_amdgcn_update_dpp(0, __float_as_int(ss_), 0xB1, 0xf, 0xf, true)); \
        ss_ += __int_as_float(__builtin_amdgcn_update_dpp(0, __float_as_int(ss_), 0x4E, 0xf, 0xf, true)); \
        if ((NL) == 8) { const float t7_ = __int_as_float(__builtin_amdgcn_update_dpp(0, __float_as_int(ss_), 0x141, 0xf, 0xf, true)); ss_ += __int_as_float(__builtin_amdgcn_update_dpp(0, __float_as_int(t7_), 0x1B, 0xf, 0xf, true)); } \
        const float rinv_ = 1.f / sqrtf(ss_ * (1.f / ((NL) * 8)) + EPS); \
        const f32x4 t0_ = (T0), t1_ = (T1); const float cs_[8] = {t0_.x, t0_.y, t0_.z, t0_.w, t1_.x, t1_.y, t1_.z, t1_.w}; \
        unsigned o_[4]; \
        _Pragma("unroll") for (int q_ = 0; q_ < 4; ++q_) { const float y0_ = x_[2 * q_] * rinv_ * gsel[2 * q_], y1_ = x_[2 * q_ + 1] * rinv_ * gsel[2 * q_ + 1]; \
            o_[q_] = pk2(y0_ * cs_[2 * q_] - y1_ * cs_[2 * q_ + 1], y0_ * cs_[2 * q_ + 1] + y1_ * cs_[2 * q_]); } \
        u32x4 ov_; ov_.x = o_[0]; ov_.y = o_[1]; ov_.z = o_[2]; ov_.w = o_[3]; if (DOST) *(u32x4*)ptr_ = ov_; } while (0)
#define QKR_LOAD(S, rr) do { const int r_ = (rr); const int b_ = r_ / RPB, j_ = r_ - b_ * RPB; const int tk_ = j_ < LC ? 0 : j_ - LC; const bf16_t* pr_ = P + (size_t)r_ * INW; \
        S##d0 = *(const u32x4*)(pr_ + lane * 8); S##d1 = *(const u32x4*)(pr_ + C_QB + lane * 8); S##d2 = *(const u32x4*)(pr_ + C_QB + 512 + (lane & 31) * 8); \
        {   const int pl_ = lane & 7; const int e_ = pl_ < 4 ? (tk_ >> 6) : 128 + (tk_ & 63); const float* tp_ = (const float*)tabA + ((size_t)e_ * 16 + (pl_ & 3) * 4) * 2; S##a0 = *(const f32x4*)tp_; S##a1 = *(const f32x4*)(tp_ + 4); } \
        {   const int pl_ = lane & 3; const int e_ = pl_ < 2 ? (tk_ >> 6) : 128 + (tk_ & 63); const float* tp_ = (const float*)tabB + ((size_t)e_ * 8 + (pl_ & 1) * 4) * 2; S##b0 = *(const f32x4*)tp_; S##b1 = *(const f32x4*)(tp_ + 4); } } while (0)
#define QKR_ROW(S, rr) do { bf16_t* prow = P + (size_t)(rr) * INW; \
        QKR_PASS(0, 8, gA, lane, true, S##d0, S##a0, S##a1);                          \
        QKR_PASS(C_QB, 4, gB, lane, true, S##d1, S##b0, S##b1);                       \
        QKR_PASS(C_QB + 512, 4, gBk, (lane & 31), lane < 32, S##d2, S##b0, S##b1);    } while (0)
    {   const int pstart = obid() * NWAVE + wave, pstep = gridDim.x * NWAVE, npair = ROWS / 2;
        const u32x4 z4 = {0u, 0u, 0u, 0u}; const f32x4 zf = {0.f, 0.f, 0.f, 0.f};
        u32x4 Ad0 = z4, Ad1 = z4, Ad2 = z4, Bd0 = z4, Bd1 = z4, Bd2 = z4; f32x4 Aa0 = zf, Aa1 = zf, Ab0 = zf, Ab1 = zf, Ba0 = zf, Ba1 = zf, Bb0 = zf, Bb1 = zf;
        if (pstart < npair) { QKR_LOAD(A, 2 * pstart); QKR_LOAD(B, 2 * pstart + 1); }
        for (int pi = pstart; pi < npair; pi += pstep) {
            const u32x4 Cd0 = Ad0, Cd1 = Ad1, Cd2 = Ad2, Ed0 = Bd0, Ed1 = Bd1, Ed2 = Bd2; const f32x4 Ca0 = Aa0, Ca1 = Aa1, Cb0 = Ab0, Cb1 = Ab1, Ea0 = Ba0, Ea1 = Ba1, Eb0 = Bb0, Eb1 = Bb1;
            if (pi + pstep < npair) { QKR_LOAD(A, 2 * (pi + pstep)); QKR_LOAD(B, 2 * (pi + pstep) + 1); }
            QKR_ROW(C, 2 * pi);
            QKR_ROW(E, 2 * pi + 1);
        }
    }
#undef QKR_PASS
#undef QKR_LOAD
#undef QKR_ROW
    {
        const int tid = otid(), r32 = lane & 31, hi = lane >> 5;
        const bf16_t* B2 = (const bf16_t*)(p.ws + WS_B2CAT) + (size_t)layer * 16 * 256 * 512;
        float* S = (float*)(p.ws + WS_S5S);
        const int NBC = (int)gridDim.x >= 32 ? (int)gridDim.x / 32 : 1;
        for (int combo = obid() / NBC; combo < 32; combo += (int)gridDim.x / NBC) {
            const int g = combo >> 1, mh = combo & 1, sb = obid() % NBC;
            __syncthreads();
            {   const bf16_t* bsrc = B2 + (size_t)(g * 256 + 128 * mh) * 512;
#pragma unroll 1
                for (int q0 = 0; q0 < 16; q0 += 8) { u32x4 t[8];
#pragma unroll
                    for (int q = 0; q < 8; ++q) { const int e = tid + (q0 + q) * NTHR; t[q] = *(const u32x4*)(bsrc + (size_t)(e >> 6) * 512 + (e & 63) * 8); }
#pragma unroll
                    for (int q = 0; q < 8; ++q) { const int e = tid + (q0 + q) * NTHR; *(LAS u32x4*)(lds + (e >> 6) * 1040 + (e & 63) * 16) = t[q]; } } }
            __syncthreads();
            for (int ct = sb * NWAVE + wave; ct < 33; ct += NBC * NWAVE) {
                f32x16_t acc[4];
#pragma unroll
                for (int mt = 0; mt < 4; ++mt) acc[mt] = (f32x16_t){0.f,0.f,0.f,0.f,0.f,0.f,0.f,0.f,0.f,0.f,0.f,0.f,0.f,0.f,0.f,0.f};
                const bf16_t* up = P + (size_t)((ct * 32 + r32) * 32) * INW + C_US + g * 16 + 8 * hi;
                const LAS unsigned char* al = lds + r32 * 1040 + 16 * hi;
#define S_LOAD(buf, k0) do { _Pragma("unroll") for (int i_ = 0; i_ < 8; ++i_) buf[i_] = *(const bf16x8_t*)(up + (size_t)((k0) + i_) * INW); } while (0)
#define S_COMP(buf, k0) do { _Pragma("unroll") for (int i_ = 0; i_ < 8; ++i_) { \
            _Pragma("unroll") for (int mt = 0; mt < 4; ++mt) { const bf16x8_t av = *(const LAS bf16x8_t*)(al + mt * (32 * 1040) + ((k0) + i_) * 32); acc[mt] = __builtin_amdgcn_mfma_f32_32x32x16_bf16(av, buf[i_], acc[mt], 0, 0, 0); } \
            __builtin_amdgcn_sched_barrier(0); } } while (0)
                bf16x8_t ua[8], ub[8];
                S_LOAD(ua, 0); S_LOAD(ub, 8);
                S_COMP(ua, 0); S_LOAD(ua, 16);
                S_COMP(ub, 8); S_LOAD(ub, 24);
                S_COMP(ua, 16); S_COMP(ub, 24);
#undef S_LOAD
#undef S_COMP
                float* sp = S + ((size_t)(ct * 32 + r32) * 16 + g) * 256 + 128 * mh + 4 * hi;
#pragma unroll
                for (int mt = 0; mt < 4; ++mt)
#pragma unroll
                    for (int rq = 0; rq < 4; ++rq) { f32x4 v; v.x = acc[mt][4 * rq]; v.y = acc[mt][4 * rq + 1]; v.z = acc[mt][4 * rq + 2]; v.w = acc[mt][4 * rq + 3]; *(f32x4*)(sp + 32 * mt + 8 * rq) = v; }
            }
        }
    }
}
__device__ __forceinline__ void s5_scan_items(const Params& p, int layer) {
    const int gtid = obid() * NTHR + otid(), GT = gridDim.x * NTHR;
    const float* __restrict__ S = (const float*)(p.ws + WS_S5S); bf16_t* __restrict__ HC = (bf16_t*)(p.ws + WS_HCAT);
    const float2* apow = (const float2*)(p.ws + WS_APOW);
    for (int it = gtid; it < NB * 16 * 128; it += GT) {
        const int kk = it & 127, g = (it >> 7) & 15, b = it >> 11; const int dir = kk >> 6, n = kk & 63;
        const float2 a32 = apow[(size_t)(((layer * 2 + dir) * 16 + g) * 64 + n) * 33 + 32];
        float hr = 0.f, hi = 0.f;
        for (int s0 = 0; s0 < CPB; s0 += 24) {
            float sr[24], si[24]; size_t ov[24];
#pragma unroll
            for (int k = 0; k < 24; ++k) { const int sidx = s0 + k;
                const int cr = dir == 0 ? sidx : (sidx < 8 ? 7 - sidx : (CPB + 7) - sidx);
                ov[k] = ((size_t)(b * CPB + cr) * 16 + g) * 256 + dir * 128 + n;
                sr[k] = S[ov[k]]; si[k] = S[ov[k] + 64]; }
#pragma unroll
            for (int k = 0; k < 24; ++k) {
                HC[ov[k]] = (bf16_t)f2bf(hr); HC[ov[k] + 64] = (bf16_t)f2bf(hi);
                const float nr = a32.x * hr - a32.y * hi + sr[k], ni = a32.x * hi + a32.y * hr + si[k]; hr = nr; hi = ni; }
        }
    }
}
__device__ __forceinline__ void phase_attn_s5b(const Params& p, int layer, LAS unsigned char* lds) {
    const int G = gridDim.x, bid = obid();
    const int vcu = (G % 8 == 0) ? (bid % 8) * (G / 8) + bid / 8 : bid;
    const int NCTX = (layer == 0) ? NB * 6 : 0;
    const float MA = ((const float*)(p.ws + WS_SCAL))[2 + layer], MB = ((const float*)(p.ws + WS_SCAL))[4 + layer];
    s5_scan_items(p, layer);
    {
        typedef attn_body::bf16 abf;
        const abf* P = (const abf*)(p.ws + WS_P); abf* MIX = (abf*)(p.ws + WS_MIX);
        for (int s = vcu; s < 256 + NCTX; s += G) {
            const int nk = s < 256 ? 3 : 1;
            for (int k = 0; k < nk; ++k) {
                int b, h, kvh, NT; size_t qrow;
                if (s < 256) { const int x = s >> 5; b = x >> 1; kvh = x & 1; h = 3 * kvh + k; qrow = (size_t)b * RPB + LC + (size_t)(s & 31) * 256; NT = RPB / 64; }
                else { const int f = s - 256; b = f / 6; h = f % 6; kvh = h / 3; qrow = (size_t)b * RPB; NT = LC / 64; }
                const size_t krow = (size_t)b * RPB;
                attn_body::attn_unit<8, 64, true>(P + qrow * INW + C_QA + h * 64, P + krow * INW + C_KA + kvh * 64, P + krow * INW + C_VA + kvh * 64, MIX + qrow * D + h * 64, D, NT, MA, (char*)lds);
            }
        }
    }
    {
        typedef attn_body::bf16 abf;
        const abf* P = (const abf*)(p.ws + WS_P); abf* OB = (abf*)(p.ws + WS_OB);
        const int NCTXB = (layer == 0) ? NB * 12 : 0;
        for (int s = vcu; s < 256 + NCTXB; s += G) {
            const int nk = s < 256 ? 6 : 1;
            for (int k = 0; k < nk; ++k) {
                int b, sh, NT; size_t qrow;
                if (s < 256) { const int combo = 3 * (s >> 5) + (k >> 1); b = combo / 6; sh = 2 * (combo % 6) + (k & 1); qrow = (size_t)b * RPB + LC + (size_t)(s & 31) * 256; NT = RPB / 64; }
                else { const int f = s - 256; b = f / 12; sh = f % 12; qrow = (size_t)b * RPB; NT = LC / 64; }
                const size_t krow = (size_t)b * RPB;
                attn_body::attn_unit<8, 32, true>(P + qrow * INW + C_QB + sh * 32, P + krow * INW + C_KB + sh * 32, P + krow * INW + C_VB + (sh >> 1) * 64, OB + qrow * 768 + sh * 64, 768, NT, MB, (char*)lds);
            }
        }
    }
}
__device__ __forceinline__ void phase_s5c(const Params& p, int layer, LAS unsigned char* lds) {
    const int tid = otid(), wave = tid >> 6, lane = tid & 63;
    const bf16_t* P = (const bf16_t*)(p.ws + WS_P); bf16_t* MIX = (bf16_t*)(p.ws + WS_MIX);
    {
        const int r32 = lane & 31, hi = lane >> 5;
        const bf16_t* KT = (const bf16_t*)(p.ws + WS_KT) + (size_t)layer * 16 * 63 * 256;
        const bf16_t* G2 = (const bf16_t*)(p.ws + WS_G2CAT) + (size_t)layer * 16 * 512 * 256;
        const bf16_t* HC = (const bf16_t*)(p.ws + WS_HCAT); bf16_t* Gb = (bf16_t*)(p.ws + WS_G);
        const int NBC = (int)gridDim.x >= 64 ? (int)gridDim.x / 64 : 1;
        for (int combo = obid() / NBC; combo < 64; combo += (int)gridDim.x / NBC) {
            const int g = combo >> 2, mq = combo & 3, sb = obid() % NBC;
            __syncthreads();
            {   const u32x4* ksrc = (const u32x4*)(KT + (size_t)(g * 63) * 256); u32x4 t[4];
#pragma unroll
                for (int q = 0; q < 4; ++q) { const int e = tid + q * NTHR; t[q] = e < 2016 ? ksrc[e] : (u32x4){0u, 0u, 0u, 0u}; }
#pragma unroll
                for (int q = 0; q < 4; ++q) { const int e = tid + q * NTHR; if (e < 2016) *(LAS u32x4*)(lds + e * 16) = t[q]; }
                const bf16_t* gsrc = G2 + (size_t)(g * 512 + mq * 128) * 256; u32x4 u[8];
#pragma unroll
                for (int q = 0; q < 8; ++q) { const int e = tid + q * NTHR; u[q] = *(const u32x4*)(gsrc + (size_t)(e >> 5) * 256 + (e & 31) * 8); }
#pragma unroll
                for (int q = 0; q < 8; ++q) { const int e = tid + q * NTHR; *(LAS u32x4*)(lds + 32768 + (e >> 5) * 528 + (e & 31) * 16) = u[q]; } }
            __syncthreads();
            for (int ct = sb * NWAVE + wave; ct < 33; ct += NBC * NWAVE) {
                const int gc = ct * 32 + r32, tok0 = 8 * mq + (r32 >> 4);
                f32x16_t acc[4];
#pragma unroll
                for (int mt = 0; mt < 4; ++mt) acc[mt] = (f32x16_t){0.f,0.f,0.f,0.f,0.f,0.f,0.f,0.f,0.f,0.f,0.f,0.f,0.f,0.f,0.f,0.f};
                const bf16_t* up = P + (size_t)(gc * 32) * INW + C_US + g * 16 + 8 * hi;
                const bf16_t* hp = HC + ((size_t)gc * 16 + g) * 256 + 8 * hi;
                const LAS unsigned char* ktl = lds + (tok0 + 31) * 512 + (r32 & 15) * 32 + 16 * hi;
                const LAS unsigned char* g2l = lds + 32768 + r32 * 528 + 16 * hi;
#define Y_LOAD(buf, k0) do { _Pragma("unroll") for (int i_ = 0; i_ < 12; ++i_) { constexpr int kk_ = (k0); const int k_ = kk_ + i_; \
            buf[i_] = k_ < 32 ? *(const bf16x8_t*)(up + (size_t)k_ * INW) : *(const bf16x8_t*)(hp + (k_ - 32) * 16); } } while (0)
#define Y_COMP(buf, k0) do { _Pragma("unroll") for (int i_ = 0; i_ < 12; ++i_) { constexpr int kk_ = (k0); const int k_ = kk_ + i_; \
            _Pragma("unroll") for (int mt = 0; mt < 4; ++mt) { const bf16x8_t av = k_ < 32 ? *(const LAS bf16x8_t*)(ktl + (2 * mt - k_) * 512) : *(const LAS bf16x8_t*)(g2l + mt * (32 * 528) + (k_ - 32) * 32); \
                acc[mt] = __builtin_amdgcn_mfma_f32_32x32x16_bf16(av, buf[i_], acc[mt], 0, 0, 0); } \
            __builtin_amdgcn_sched_barrier(0); } } while (0)
                bf16x8_t ua[12], ub[12];
                Y_LOAD(ua, 0); Y_LOAD(ub, 12);
                Y_COMP(ua, 0); Y_LOAD(ua, 24);
                Y_COMP(ub, 12); Y_LOAD(ub, 36);
                Y_COMP(ua, 24); Y_COMP(ub, 36);
#undef Y_LOAD
#undef Y_COMP
#pragma unroll
                for (int mt = 0; mt < 4; ++mt)
#pragma unroll
                    for (int io = 0; io < 2; ++io) {
                        bf16_t* gd = Gb + (size_t)(gc * 32 + 8 * mq + 2 * mt + io) * 256 + g * 16 + 4 * hi;
                        u32x2 w0, w1;
                        w0.x = pk2(gelu_tanh(acc[mt][8 * io + 0]), gelu_tanh(acc[mt][8 * io + 1])); w0.y = pk2(gelu_tanh(acc[mt][8 * io + 2]), gelu_tanh(acc[mt][8 * io + 3]));
                        w1.x = pk2(gelu_tanh(acc[mt][8 * io + 4]), gelu_tanh(acc[mt][8 * io + 5])); w1.y = pk2(gelu_tanh(acc[mt][8 * io + 6]), gelu_tanh(acc[mt][8 * io + 7]));
                        *(u32x2*)gd = w0; *(u32x2*)(gd + 8) = w1;
                    }
            }
        }
    }
    const float lam = ((const float*)(p.ws + WS_SCAL))[layer], lam_init = 0.8f - 0.6f * expf(-0.3f * (float)layer);
    const int hp = (lane >> 3) < 6 ? (lane >> 3) : 5, d0 = (lane & 7) * 8;
    float sg[8];
#pragma unroll
    for (int i = 0; i < 8; ++i) sg[i] = p.in[18][layer * 64 + d0 + i] * (1.f - lam_init);
    const int nq = (layer ? NB * L : ROWS) / 4;
    for (int qi = obid() * NWAVE + wave; qi < nq; qi += gridDim.x * NWAVE) {
        const int r0 = layer ? (qi >> 11) * RPB + LC + (qi & 2047) * 4 : qi * 4;
        const bf16_t* ob = (const bf16_t*)(p.ws + WS_OB) + (size_t)r0 * 768 + hp * 128 + d0;
        u32x4 w1[4], w2[4];
#pragma unroll
        for (int k = 0; k < 4; ++k) { w1[k] = *(const u32x4*)(ob + (size_t)k * 768); w2[k] = *(const u32x4*)(ob + (size_t)k * 768 + 64); }
#pragma unroll
        for (int k = 0; k < 4; ++k) {
            const unsigned a1[4] = {w1[k].x, w1[k].y, w1[k].z, w1[k].w}, a2[4] = {w2[k].x, w2[k].y, w2[k].z, w2[k].w};
            float v[8]; float ss = 0.f;
#pragma unroll
            for (int q = 0; q < 4; ++q) { v[2 * q] = bf2f(a1[q] & 0xffffu) - lam * bf2f(a2[q] & 0xffffu); v[2 * q + 1] = bf2f(a1[q] >> 16) - lam * bf2f(a2[q] >> 16); ss += v[2 * q] * v[2 * q] + v[2 * q + 1] * v[2 * q + 1]; }
            ss += __int_as_float(__builtin_amdgcn_update_dpp(0, __float_as_int(ss), 0xB1, 0xf, 0xf, true));
            ss += __int_as_float(__builtin_amdgcn_update_dpp(0, __float_as_int(ss), 0x4E, 0xf, 0xf, true));
            {   const float t7 = __int_as_float(__builtin_amdgcn_update_dpp(0, __float_as_int(ss), 0x141, 0xf, 0xf, true));
                ss += __int_as_float(__builtin_amdgcn_update_dpp(0, __float_as_int(t7), 0x1B, 0xf, 0xf, true)); }
            const float rinv = 1.f / sqrtf(ss * (1.f / 64.f) + EPS);
            u32x4 o; o.x = pk2(v[0] * rinv * sg[0], v[1] * rinv * sg[1]); o.y = pk2(v[2] * rinv * sg[2], v[3] * rinv * sg[3]); o.z = pk2(v[4] * rinv * sg[4], v[5] * rinv * sg[5]); o.w = pk2(v[6] * rinv * sg[6], v[7] * rinv * sg[7]);
            if (lane < 48) *(u32x4*)(MIX + (size_t)(r0 + k) * D + 384 + hp * 64 + d0) = o;
        }
    }
}
__device__ __forceinline__ void phase_glu(const Params& p, int layer, LAS unsigned char* lds) {
    const int tid = otid(), wave = tid >> 6, lane = tid & 63, r32 = lane & 31, hi = lane >> 5;
    const bf16_t* Gb = (const bf16_t*)(p.ws + WS_G); bf16_t* MIX = (bf16_t*)(p.ws + WS_MIX);
    const bf16_t* WT = (const bf16_t*)(p.ws + WS_WGLU_T) + (size_t)layer * 256 * 256;
    __syncthreads();
    for (int e = tid; e < 256 * 32; e += NTHR) { const int row = e >> 5, c16 = e & 31; *(LAS u32x4*)(lds + row * 528 + c16 * 16) = *(const u32x4*)(WT + (size_t)row * 256 + c16 * 8); }
    __syncthreads();
    for (int it = obid() * NWAVE + wave; it < NCH * 2; it += gridDim.x * NWAVE) {
        const int jh = it & 1, tt = it >> 1;
        if (layer == 1 && ((tt * 32) % RPB) < LC) continue;
        const size_t row = (size_t)tt * 32 + r32;
        f32x16_t acc[4];
#pragma unroll
        for (int mt = 0; mt < 4; ++mt) acc[mt] = (f32x16_t){0.f,0.f,0.f,0.f,0.f,0.f,0.f,0.f,0.f,0.f,0.f,0.f,0.f,0.f,0.f,0.f};
        const bf16_t* gp = Gb + row * 256 + 8 * hi;
        bf16x8_t bv[16];
#pragma unroll
        for (int kb = 0; kb < 16; ++kb) bv[kb] = *(const bf16x8_t*)(gp + kb * 16);
        u32x2 gw[16];
#pragma unroll
        for (int mt = 0; mt < 4; ++mt)
#pragma unroll
            for (int rq = 0; rq < 4; ++rq) gw[4 * mt + rq] = *(const u32x2*)(Gb + row * 256 + 128 * jh + 32 * mt + 8 * rq + 4 * hi);
        const LAS unsigned char* wl = lds + (128 * jh + r32) * 528 + 16 * hi;
#pragma unroll
        for (int kb = 0; kb < 16; ++kb) {
#pragma unroll
            for (int mt = 0; mt < 4; ++mt) { const bf16x8_t av = *(const LAS bf16x8_t*)(wl + mt * (32 * 528) + kb * 32); acc[mt] = __builtin_amdgcn_mfma_f32_32x32x16_bf16(av, bv[kb], acc[mt], 0, 0, 0); }
            __builtin_amdgcn_sched_barrier(0);
        }
#pragma unroll
        for (int mt = 0; mt < 4; ++mt)
#pragma unroll
            for (int rq = 0; rq < 4; ++rq) {
                const int jj = 128 * jh + 32 * mt + 8 * rq + 4 * hi;
                const u32x2 g2 = gw[4 * mt + rq];
                const float o0 = bf2f(g2.x & 0xffffu) * __builtin_amdgcn_rcpf(1.f + __builtin_amdgcn_exp2f(-LOG2E * acc[mt][4 * rq + 0]));
                const float o1 = bf2f(g2.x >> 16) * __builtin_amdgcn_rcpf(1.f + __builtin_amdgcn_exp2f(-LOG2E * acc[mt][4 * rq + 1]));
                const float o2 = bf2f(g2.y & 0xffffu) * __builtin_amdgcn_rcpf(1.f + __builtin_amdgcn_exp2f(-LOG2E * acc[mt][4 * rq + 2]));
                const float o3 = bf2f(g2.y >> 16) * __builtin_amdgcn_rcpf(1.f + __builtin_amdgcn_exp2f(-LOG2E * acc[mt][4 * rq + 3]));
                u32x2 w; w.x = pk2(o0, o1); w.y = pk2(o2, o3);
                *(u32x2*)(MIX + row * D + 768 + jj) = w;
            }
    }
}
__device__ __forceinline__ void phase_peer_conv(const Params& p, int layer) {
    const int gtid = obid() * NTHR + otid(), GT = gridDim.x * NTHR;
    const float* U = p.in[30] + (size_t)layer * 16384 * D; const float* V = p.in[31] + (size_t)layer * 16384 * D;
    u32x4* U8 = (u32x4*)(p.ws + WS_U8); u32x4* V8 = (u32x4*)(p.ws + WS_V8);
    for (int it = gtid; it < 2 * 16384 * 64; it += GT) {
        const bool isv = it >= 16384 * 64; const int e = isv ? it - 16384 * 64 : it;
        const f32x4* src = (const f32x4*)((isv ? V : U) + (size_t)e * 16); const float sc = isv ? 1.f : 256.f;
        u32x4 o; unsigned w[4];
#pragma unroll
        for (int q = 0; q < 4; ++q) { const f32x4 v = src[q]; int t = __builtin_amdgcn_cvt_pk_fp8_f32(v.x * sc, v.y * sc, 0, false); t = __builtin_amdgcn_cvt_pk_fp8_f32(v.z * sc, v.w * sc, t, true); w[q] = (unsigned)t; }
        o.x = w[0]; o.y = w[1]; o.z = w[2]; o.w = w[3];
        (isv ? V8 : U8)[(size_t)((e & 63) >> 3) * (16384 * 8) + (size_t)(e >> 6) * 8 + (e & 7)] = o;
    }
}
__device__ __forceinline__ float vmaxf(float a, float b) { float r; asm("v_max_f32_e32 %0, %1, %2" : "=v"(r) : "v"(a), "v"(b)); return r; }
__device__ __forceinline__ float vminf(float a, float b) { float r; asm("v_min_f32_e32 %0, %1, %2" : "=v"(r) : "v"(a), "v"(b)); return r; }
#define PK_INSERT(tv, v_) do { float _v = (v_); _Pragma("unroll") for (int _k = 0; _k < 16; ++_k) { const float _h = vmaxf(tv[_k], _v); _v = vminf(tv[_k], _v); tv[_k] = _h; } } while (0)
#define SN_CE(a, b) do { const float _h = vmaxf(a, b); b = vminf(a, b); a = _h; } while (0)
__device__ __forceinline__ void sort16_desc(float (&x)[16]) { SN_CE(x[0], x[1]); SN_CE(x[2], x[3]); SN_CE(x[0], x[2]); SN_CE(x[1], x[3]); SN_CE(x[1], x[2]); SN_CE(x[4], x[5]); SN_CE(x[6], x[7]); SN_CE(x[4], x[6]); SN_CE(x[5], x[7]); SN_CE(x[5], x[6]); SN_CE(x[0], x[4]); SN_CE(x[2], x[6]); SN_CE(x[2], x[4]); SN_CE(x[1], x[5]); SN_CE(x[3], x[7]); SN_CE(x[3], x[5]); SN_CE(x[1], x[2]); SN_CE(x[3], x[4]); SN_CE(x[5], x[6]); SN_CE(x[8], x[9]); SN_CE(x[10], x[11]); SN_CE(x[8], x[10]); SN_CE(x[9], x[11]); SN_CE(x[9], x[10]); SN_CE(x[12], x[13]); SN_CE(x[14], x[15]); SN_CE(x[12], x[14]); SN_CE(x[13], x[15]); SN_CE(x[13], x[14]); SN_CE(x[8], x[12]); SN_CE(x[10], x[14]); SN_CE(x[10], x[12]); SN_CE(x[9], x[13]); SN_CE(x[11], x[15]); SN_CE(x[11], x[13]); SN_CE(x[9], x[10]); SN_CE(x[11], x[12]); SN_CE(x[13], x[14]); SN_CE(x[0], x[8]); SN_CE(x[4], x[12]); SN_CE(x[4], x[8]); SN_CE(x[2], x[10]); SN_CE(x[6], x[14]); SN_CE(x[6], x[10]); SN_CE(x[2], x[4]); SN_CE(x[6], x[8]); SN_CE(x[10], x[12]); SN_CE(x[1], x[9]); SN_CE(x[5], x[13]); SN_CE(x[5], x[9]); SN_CE(x[3], x[11]); SN_CE(x[7], x[15]); SN_CE(x[7], x[11]); SN_CE(x[3], x[5]); SN_CE(x[7], x[9]); SN_CE(x[11], x[13]); SN_CE(x[1], x[2]); SN_CE(x[3], x[4]); SN_CE(x[5], x[6]); SN_CE(x[7], x[8]); SN_CE(x[9], x[10]); SN_CE(x[11], x[12]); SN_CE(x[13], x[14]); }
__device__ __forceinline__ void merge16_desc(float (&a)[16], const float (&b)[16]) {
#pragma unroll
    for (int i = 0; i < 16; ++i) a[i] = vmaxf(a[i], b[15 - i]);
#pragma unroll
    for (int i = 0; i < 8; ++i) SN_CE(a[i], a[i + 8]);
#pragma unroll
    for (int i = 0; i < 16; ++i) if ((i & 4) == 0) SN_CE(a[i], a[i + 4]);
#pragma unroll
    for (int i = 0; i < 16; ++i) if ((i & 2) == 0) SN_CE(a[i], a[i + 2]);
#pragma unroll
    for (int i = 0; i < 16; i += 2) SN_CE(a[i], a[i + 1]);
}
__device__ __forceinline__ void phase_peer_sel(const Params& p, int layer, LAS unsigned char* lds) {
    const int tid = otid(), wave = tid >> 6, lane = tid & 63, r32 = lane & 31, hi = lane >> 5;
    const bf16_t* Qp = (const bf16_t*)(p.ws + WS_P);
    const bf16_t* K16 = (const bf16_t*)(p.ws + WS_KEYS16) + (size_t)layer * 16 * 128 * 128;
    unsigned* SEL = (unsigned*)(p.ws + WS_SEL);
    const int hd = obid() & 7, bsub = obid() >> 3, nbs = ((int)gridDim.x + 7 - hd) >> 3;
    LAS unsigned char* lrow = lds + 2 * 34816 + wave * 1024 + r32 * 32;
    __syncthreads();
    {   u32x4 t[8];
#pragma unroll
        for (int q = 0; q < 8; ++q) { const int e = tid + q * NTHR; t[q] = *(const u32x4*)(K16 + (size_t)(2 * hd) * 128 * 128 + (size_t)e * 8); }
#pragma unroll
        for (int q = 0; q < 8; ++q) { const int e = tid + q * NTHR; *(LAS u32x4*)(lds + (e >> 11) * 34816 + ((e >> 4) & 127) * 272 + (e & 15) * 16) = t[q]; } }
    __syncthreads();
    const int nunit = layer ? NB * L / 32 : ROWS / 32;
    constexpr unsigned char PA[50] = {0,0,0,0,0,0,0,0,0,0,0,0,0,0,0,0,1,1,1,1,1,1,1,1,2,2,2,2,2,3,3,3,3,4,4,4,5,5,6,6,7,7,8,9,10,11,12,13,14,15};
    constexpr unsigned char PB[50] = {0,1,2,3,4,5,6,7,8,9,10,11,12,13,14,15,0,1,2,3,4,5,6,7,0,1,2,3,4,0,1,2,3,0,1,2,0,1,0,1,0,1,0,0,0,0,0,0,0,0};
    for (int u = bsub * NWAVE + wave; u < nunit; u += nbs * NWAVE) {
        const int r0 = layer ? (u >> 8) * RPB + LC + (u & 255) * 32 : u * 32;
        const int row = r0 + r32;
        float L1[16], L2[16];
#pragma unroll
        for (int hs = 0; hs < 2; ++hs) {
            const int hh = 2 * hd + hs;
            bf16x8_t qf[8];
#pragma unroll
            for (int ks = 0; ks < 8; ++ks) qf[ks] = *(const bf16x8_t*)(Qp + (size_t)row * INW + hh * 128 + ks * 16 + hi * 8);
            f32x16_t acc[4];
#pragma unroll
            for (int mt = 0; mt < 4; ++mt) {
                acc[mt] = (f32x16_t){0.f,0.f,0.f,0.f,0.f,0.f,0.f,0.f,0.f,0.f,0.f,0.f,0.f,0.f,0.f,0.f};
#pragma unroll
                for (int ks = 0; ks < 8; ++ks) { const bf16x8_t a = *(const LAS bf16x8_t*)(lds + hs * 34816 + (mt * 32 + r32) * 272 + ks * 32 + hi * 16);
                    acc[mt] = __builtin_amdgcn_mfma_f32_32x32x16_bf16(a, qf[ks], acc[mt], 0, 0, 0); }
            }
            float c0[16], c1[16], c2[16], c3[16];
#pragma unroll
            for (int r = 0; r < 16; ++r) { const unsigned n = (unsigned)((r & 3) + 8 * (r >> 2)) + 4u * (unsigned)hi;
                c0[r] = __uint_as_float((__float_as_uint(acc[0][r]) & ~127u) | n); c1[r] = __uint_as_float((__float_as_uint(acc[1][r]) & ~127u) | (n + 32u));
                c2[r] = __uint_as_float((__float_as_uint(acc[2][r]) & ~127u) | (n + 64u)); c3[r] = __uint_as_float((__float_as_uint(acc[3][r]) & ~127u) | (n + 96u)); }
            sort16_desc(c0); sort16_desc(c1); sort16_desc(c2); sort16_desc(c3);
            merge16_desc(c0, c1); merge16_desc(c2, c3); merge16_desc(c0, c2);
            float pv[16];
#pragma unroll
            for (int k = 0; k < 16; ++k) pv[k] = __shfl_xor(c0[k], 32);
            merge16_desc(c0, pv);
#pragma unroll
            for (int k = 0; k < 16; ++k) { if (hs == 0) L1[k] = c0[k]; else L2[k] = c0[k]; }
        }
        {   unsigned wa[4], wb[4];
#pragma unroll
            for (int q = 0; q < 4; ++q) { wa[q] = 0u; wb[q] = 0u;
#pragma unroll
                for (int jb = 0; jb < 4; ++jb) { wa[q] |= (__float_as_uint(L1[4 * q + jb]) & 127u) << (8 * jb); wb[q] |= (__float_as_uint(L2[4 * q + jb]) & 127u) << (8 * jb); } }
            u32x4 w4; w4.x = hi ? wb[0] : wa[0]; w4.y = hi ? wb[1] : wa[1]; w4.z = hi ? wb[2] : wa[2]; w4.w = hi ? wb[3] : wa[3];
            *(LAS u32x4*)(lrow + hi * 16) = w4; }
        float cv[16];
#pragma unroll
        for (int k = 0; k < 16; ++k) cv[k] = -3.0e38f;
#pragma unroll
        for (int i = 0; i < 25; ++i) {
            const int a0 = PA[2 * i], b0 = PB[2 * i], a1 = PA[2 * i + 1], b1 = PB[2 * i + 1];
            const float s0 = L1[a0] + L2[b0], s1 = L1[a1] + L2[b1];
            const unsigned k0 = (__float_as_uint(s0) & ~255u) | (unsigned)(a0 * 16 + b0), k1 = (__float_as_uint(s1) & ~255u) | (unsigned)(a1 * 16 + b1);
            PK_INSERT(cv, __uint_as_float(hi ? k1 : k0));
        }
        {   float pv[16];
#pragma unroll
            for (int k = 0; k < 16; ++k) pv[k] = __shfl_xor(cv[k], 32);
            merge16_desc(cv, pv); }
        float e[16], den = 0.f;
#pragma unroll
        for (int k = 0; k < 16; ++k) { e[k] = __expf(cv[k] - cv[0]); den += e[k]; }
        const float rd = 1.f / den;
        asm volatile("s_waitcnt lgkmcnt(0)" ::: "memory");
        unsigned wd[8];
#pragma unroll
        for (int k = 0; k < 8; ++k) {
            float cv_lo = cv[k], cv_hi = cv[8 + k], e_lo = e[k], e_hi = e[8 + k]; asm volatile("" : "+v"(cv_lo), "+v"(cv_hi), "+v"(e_lo), "+v"(e_hi));
            const unsigned code = __float_as_uint(hi ? cv_hi : cv_lo) & 255u; const float gk = (hi ? e_hi : e_lo) * rd;
            const unsigned i1 = lrow[code >> 4], i2 = lrow[16 + (code & 15u)];
            wd[k] = (i1 * 128u + i2) | (f2bf(gk) << 16);
        }
        u32x4 o0, o1; o0.x = wd[0]; o0.y = wd[1]; o0.z = wd[2]; o0.w = wd[3]; o1.x = wd[4]; o1.y = wd[5]; o1.z = wd[6]; o1.w = wd[7];
        unsigned* dst = SEL + (size_t)row * 128 + 2 * hd + hi;
        dst[0] = o0.x; dst[16] = o0.y; dst[32] = o0.z; dst[48] = o0.w; dst[64] = o1.x; dst[80] = o1.y; dst[96] = o1.z; dst[112] = o1.w;
    }
}
__device__ __forceinline__ float red16(const float (&x)[16], int lane) {
    float y[8], z[4], w2[2];
    {   const bool bt = (lane >> 3) & 1;
#pragma unroll
        for (int j = 0; j < 8; ++j) { const float keep = bt ? x[j + 8] : x[j], send = bt ? x[j] : x[j + 8]; y[j] = keep + __shfl_xor(send, 8); } }
    {   const bool bt = (lane >> 2) & 1;
#pragma unroll
        for (int j = 0; j < 4; ++j) { const float keep = bt ? y[j + 4] : y[j], send = bt ? y[j] : y[j + 4]; z[j] = keep + __shfl_xor(send, 4); } }
    {   const bool bt = (lane >> 1) & 1;
#pragma unroll
        for (int j = 0; j < 2; ++j) { const float keep = bt ? z[j + 2] : z[j], send = bt ? z[j] : z[j + 2]; w2[j] = keep + __shfl_xor(send, 2); } }
    const bool bt = lane & 1;
    float v = (bt ? w2[1] : w2[0]) + __shfl_xor(bt ? w2[0] : w2[1], 1);
    v += __shfl_xor(v, 16); v += __shfl_xor(v, 32);
    return v;
}

__device__ __forceinline__ int peer_row(int layer, int li) { return layer == 0 ? li : (li >> 13) * RPB + LC + (li & 8191); }
template <int CTRL> __device__ __forceinline__ float dppx(float x) { return __int_as_float(__builtin_amdgcn_update_dpp(0, __float_as_int(x), CTRL, 0xf, 0xf, true)); }
template <int WHICH> __device__ __forceinline__ void phase_peer_slice(const Params& p, int layer, LAS unsigned char* lds) {
    const int tid = otid(), wave = tid >> 6, lane = tid & 63, G = gridDim.x, bid = obid();
    const int sub = lane >> 3, c8 = lane & 7, cb = c8 * 16;
    const int rstart = bid * NWAVE + wave, rstep = G * NWAVE, nrows = layer ? NB * L : ROWS;
    const unsigned* SEL = (const unsigned*)(p.ws + WS_SEL);
    const bf16_t* H = (const bf16_t*)(p.ws + WS_H);
    LAS float* AC = (LAS float*)lds + wave * (24 * 128);
    float* W = (float*)(p.ws + WS_OB);
    const float* X = (const float*)(p.ws + WS_X);
    const float* mod = (const float*)(p.ws + WS_MOD) + (size_t)layer * 5 * 6144;
    const unsigned char* T8 = p.ws + (WHICH ? WS_V8 : WS_U8);
    const int xcc = (int)(xb_xcc_id() & 7u);
    const int colo = cb + ((lane >> 5) & 1) * 8 + ((lane >> 4) & 1) * 4 + ((lane >> 3) & 1) * 2;
    for (int pk = 0; pk < 8; ++pk) {
        const int part = (xcc + pk) & 7; const unsigned char* Tp = T8 + (size_t)part * (16384 * 128); const int col = part * 128 + colo;
        u32x4 sn[4]; u32x4 an[4]; f32x2 xn = {0.f, 0.f}, gn = {0.f, 0.f};
#pragma unroll
        for (int q = 0; q < 4; ++q) { sn[q] = (u32x4){0u, 0u, 0u, 0u}; an[q] = sn[q]; }
        if (rstart < nrows) { const int r = peer_row(layer, rstart);
#pragma unroll
            for (int q = 0; q < 4; ++q) sn[q] = *(const u32x4*)(SEL + (size_t)r * 128 + sub * 16 + 4 * q);
            if (WHICH == 0) { an[0] = *(const u32x4*)(H + (size_t)r * D + part * 128 + cb); an[1] = *(const u32x4*)(H + (size_t)r * D + part * 128 + cb + 8); }
            else {
#pragma unroll
                for (int q = 0; q < 4; ++q) an[q] = *(const u32x4*)(W + (size_t)r * 128 + sub * 16 + 4 * q);
                const int b = r / RPB, jr = r - b * RPB; xn = *(const f32x2*)(X + (size_t)r * D + col); gn = *(const f32x2*)(mod + (size_t)(jr < LC ? 4 : b) * 6144 + 5 * D + col); } }
        for (int li = rstart; li < nrows; li += rstep) {
            const int r = peer_row(layer, li);
            u32x4 sc[4], ac[4]; const f32x2 xv = xn, gv = gn;
#pragma unroll
            for (int q = 0; q < 4; ++q) { sc[q] = sn[q]; ac[q] = an[q]; }
            u32x4 buf[16];
#pragma unroll
            for (int t = 0; t < 16; ++t) buf[t] = *(const u32x4*)(Tp + (((sc[t >> 2][t & 3] & 0x3fffu) << 7) | (unsigned)cb));
            if (li + rstep < nrows) { const int rn = peer_row(layer, li + rstep);
#pragma unroll
                for (int q = 0; q < 4; ++q) sn[q] = *(const u32x4*)(SEL + (size_t)rn * 128 + sub * 16 + 4 * q);
                if (WHICH == 0) { an[0] = *(const u32x4*)(H + (size_t)rn * D + part * 128 + cb); an[1] = *(const u32x4*)(H + (size_t)rn * D + part * 128 + cb + 8); }
                else {
#pragma unroll
                    for (int q = 0; q < 4; ++q) an[q] = *(const u32x4*)(W + (size_t)rn * 128 + sub * 16 + 4 * q);
                    const int b = rn / RPB, jr = rn - b * RPB; xn = *(const f32x2*)(X + (size_t)rn * D + col); gn = *(const f32x2*)(mod + (size_t)(jr < LC ? 4 : b) * 6144 + 5 * D + col); } }
            if (WHICH == 0) {
                f32x2 hp[8];
                {   const unsigned hw[8] = {ac[0].x, ac[0].y, ac[0].z, ac[0].w, ac[1].x, ac[1].y, ac[1].z, ac[1].w};
#pragma unroll
                    for (int q = 0; q < 8; ++q) hp[q] = (f32x2){bf2f(hw[q] & 0xffffu), bf2f(hw[q] >> 16)}; }
                float pv[16];
#pragma unroll
                for (int t = 0; t < 16; ++t) {
                    const unsigned ww[4] = {buf[t].x, buf[t].y, buf[t].z, buf[t].w}; f32x2 a2 = {0.f, 0.f};
#pragma unroll
                    for (int q = 0; q < 4; ++q) { a2 += __builtin_amdgcn_cvt_pk_f32_fp8((int)ww[q], false) * hp[2 * q]; a2 += __builtin_amdgcn_cvt_pk_f32_fp8((int)ww[q], true) * hp[2 * q + 1]; }
                    pv[t] = a2.x + a2.y;
                }
#pragma unroll
                for (int t = 0; t < 16; ++t) pv[t] += dppx<0xB1>(pv[t]);
#pragma unroll
                for (int t = 0; t < 16; ++t) pv[t] += dppx<0x4E>(pv[t]);
#pragma unroll
                for (int t = 0; t < 16; ++t) pv[t] += dppx<0x1B>(dppx<0x141>(pv[t]));
                float k0 = 0.f, k1 = 0.f;
#pragma unroll
                for (int t = 0; t < 8; ++t) { k0 = (c8 == t) ? pv[t] : k0; k1 = (c8 == t) ? pv[t + 8] : k1; }
                LAS float* ac = AC + ((li - rstart) / rstep) * 128 + sub * 16 + c8;
                if (pk == 0) { ac[0] = k0; ac[8] = k1; } else { ac[0] += k0; ac[8] += k1; }
            } else {
                f32x2 acc[8];
#pragma unroll
                for (int q = 0; q < 8; ++q) acc[q] = (f32x2){0.f, 0.f};
#pragma unroll
                for (int t = 0; t < 16; ++t) { const float we = __uint_as_float(ac[t >> 2][t & 3]); const f32x2 w2 = {we, we};
                    const unsigned ww[4] = {buf[t].x, buf[t].y, buf[t].z, buf[t].w};
#pragma unroll
                    for (int q = 0; q < 4; ++q) { acc[2 * q] += w2 * __builtin_amdgcn_cvt_pk_f32_fp8((int)ww[q], false); acc[2 * q + 1] += w2 * __builtin_amdgcn_cvt_pk_f32_fp8((int)ww[q], true); } }
                float a8[8], a4[4], a2[2];
                {   const bool bt = (lane >> 5) & 1;
#pragma unroll
                    for (int k = 0; k < 8; ++k) { const float lo = acc[k >> 1][k & 1], hi = acc[4 + (k >> 1)][k & 1]; const float keep = bt ? hi : lo, send = bt ? lo : hi;
                        const auto rr = __builtin_amdgcn_permlane32_swap(__float_as_uint(send), __float_as_uint(send), false, false); a8[k] = keep + __uint_as_float(bt ? rr[0] : rr[1]); } }
                {   const bool bt = (lane >> 4) & 1;
#pragma unroll
                    for (int k = 0; k < 4; ++k) { const float keep = bt ? a8[k + 4] : a8[k], send = bt ? a8[k] : a8[k + 4];
                        const auto rr = __builtin_amdgcn_permlane16_swap(__float_as_uint(send), __float_as_uint(send), false, false); a4[k] = keep + __uint_as_float(bt ? rr[0] : rr[1]); } }
                {   const bool bt = (lane >> 3) & 1;
#pragma unroll
                    for (int k = 0; k < 2; ++k) { const float keep = bt ? a4[k + 2] : a4[k], send = bt ? a4[k] : a4[k + 2]; a2[k] = keep + dppx<0x128>(send); } }
                const int b = r / RPB, jr = r - b * RPB;
                f32x2 o; o.x = xv.x + gv.x * a2[0]; o.y = xv.y + gv.y * a2[1];
                float* orow = (layer == 0) ? (float*)(p.ws + WS_X) + (size_t)r * D + col : p.out + ((size_t)b * L + (jr - LC)) * D + col;
                *(f32x2*)orow = o;
            }
        }
    }
    if (WHICH == 0) {
        asm volatile("s_waitcnt lgkmcnt(0)" ::: "memory");
        for (int li = rstart; li < nrows; li += rstep) { const int r = peer_row(layer, li); const LAS float* ac = AC + ((li - rstart) / rstep) * 128;
#pragma unroll
            for (int hf = 0; hf < 2; ++hf) { const int pos = hf * 64 + lane; const float wv = bf2f(SEL[(size_t)r * 128 + pos] >> 16) * gelu_tanh(ac[pos] * (1.f / 256.f));
                W[(size_t)r * 128 + pos] = wv;
                const float ws = wv * 64.f; const int hi8 = __builtin_amdgcn_cvt_pk_fp8_f32(ws, 0.f, 0, false) & 0xff; const f32x2 fh = __builtin_amdgcn_cvt_pk_f32_fp8(hi8, false);
                const int lo8 = __builtin_amdgcn_cvt_pk_fp8_f32(ws - fh.x, 0.f, 0, false) & 0xff;
                unsigned char* rec = (unsigned char*)(p.ws + WS_OB) + 20 * MiB + (size_t)r * 512;
                ((unsigned short*)rec)[pos] = (unsigned short)(SEL[(size_t)r * 128 + pos] & 0x3fffu); rec[256 + pos] = (unsigned char)hi8; rec[384 + pos] = (unsigned char)lo8; } }
    }
}

typedef int v2i_t __attribute__((ext_vector_type(2)));
__device__ __forceinline__ void dma16(const void* gsrc, LAS void* dst) { unsigned keep; const unsigned d = (unsigned)__builtin_amdgcn_readfirstlane((int)(unsigned)(uintptr_t)dst);
    asm volatile("s_mov_b32 %0, m0\n\ts_mov_b32 m0, %2\n\ts_nop 0\n\tglobal_load_lds_dwordx4 %1, off\n\ts_mov_b32 m0, %0" : "=&s"(keep) : "v"(gsrc), "s"(d) : "memory"); }
__device__ __forceinline__ void dma4(const void* gsrc, LAS void* dst) { unsigned keep; const unsigned d = (unsigned)__builtin_amdgcn_readfirstlane((int)(unsigned)(uintptr_t)dst);
    asm volatile("s_mov_b32 %0, m0\n\ts_mov_b32 m0, %2\n\ts_nop 0\n\tglobal_load_lds_dword %1, off\n\ts_mov_b32 m0, %0" : "=&s"(keep) : "v"(gsrc), "s"(d) : "memory"); }
__device__ __forceinline__ void phase_peer_v_mfma(const Params& p, int layer, LAS unsigned char* lds) {
    const int tid = otid(), wave = tid >> 6, lane = tid & 63, G = gridDim.x, bid = obid();
    const int m16 = lane & 15, g = lane >> 4, sub = lane >> 3, c8 = lane & 7, q = m16 >> 1, pp = m16 & 1;
    const int rstart = bid * NWAVE + wave, rstep = G * NWAVE, nrows = layer ? NB * L : ROWS;
    const int nv = rstart < nrows ? (nrows - rstart + rstep - 1) / rstep : 0;
    const unsigned char* REC = p.ws + WS_OB + 20 * MiB;
    const float* X = (const float*)(p.ws + WS_X);
    const float* mod = (const float*)(p.ws + WS_MOD) + (size_t)layer * 5 * 6144;
    LAS unsigned char* HB = lds + wave * 19456;
    LAS unsigned char* ST = HB + 16384;
    LAS float* GT = (LAS float*)(lds + 8 * 19456);
    const int xcc = (int)(xb_xcc_id() & 7u);
#define PV_ROW(v) peer_row(layer, rstart + ((v) < nv ? (v) : nv - 1) * rstep)
#define PV_SMALL(v) do { const int r_ = PV_ROW(v); LAS unsigned char* st_ = ST + ((v) % 3) * 1024; const unsigned char* rc_ = REC + (size_t)r_ * 512; const float* xr_ = X + (size_t)r_ * D + part * 128; \
        dma4(rc_ + 4 * lane, st_); dma4(rc_ + 256 + 4 * lane, st_ + 256); dma4(xr_ + lane, st_ + 512); dma4(xr_ + 64 + lane, st_ + 768); } while (0)
#define PV_HALF(v, hf) do { const LAS unsigned short* ix_ = (const LAS unsigned short*)(ST + ((v) % 3) * 1024); \
        _Pragma("unroll") for (int t_ = 0; t_ < 8; ++t_) { const unsigned idx_ = ix_[64 * (hf) + 8 * t_ + sub]; \
            dma16(Tp + (size_t)idx_ * 128 + ((c8 ^ sub) * 16), HB + (hf) * 8192 + t_ * 1024); } } while (0)
#define PV_COMP(v, hf) do { const LAS unsigned char* st_ = ST + ((v) % 3) * 1024; const LAS unsigned char* rb_ = HB + (hf) * 8192 + (8 * g + q) * 128 + 8 * pp; \
        _Pragma("unroll") for (int k2_ = 0; k2_ < 2; ++k2_) { const int ks_ = 2 * (hf) + k2_; \
            const long hi_ = *(const LAS long*)(st_ + 256 + 32 * ks_ + 8 * g), lo_ = *(const LAS long*)(st_ + 384 + 32 * ks_ + 8 * g); const long af_ = m16 == 0 ? hi_ : (m16 == 1 ? lo_ : 0l); \
            v2i_t bq_[8]; _Pragma("unroll") for (int j_ = 0; j_ < 8; ++j_) bq_[j_] = __builtin_amdgcn_ds_read_tr8_b64_v2i32((LAS v2i_t*)(rb_ + k2_ * 4096 + ((j_ ^ q) * 16))); \
            _Pragma("unroll") for (int j_ = 0; j_ < 8; ++j_) { const long bl_ = (long)(((unsigned long long)(unsigned)bq_[j_].y << 32) | (unsigned long long)(unsigned)bq_[j_].x); \
                acc[j_] = __builtin_amdgcn_mfma_f32_16x16x32_fp8_fp8(af_, bl_, acc[j_], 0, 0, 0); } } } while (0)
    for (int pk = 0; pk < 8; ++pk) {
        const int part = (xcc + pk) & 7; const unsigned char* Tp = p.ws + WS_V8 + (size_t)part * (16384 * 128);
        __syncthreads();
        for (int e = tid; e < 5 * 128; e += NTHR) GT[e] = mod[(size_t)(e >> 7) * 6144 + 5 * D + part * 128 + (e & 127)];
        asm volatile("s_waitcnt vmcnt(0) lgkmcnt(0)" ::: "memory");
        __syncthreads();
        if (nv > 0) {
            PV_SMALL(0); PV_SMALL(1);
            asm volatile("s_waitcnt vmcnt(0)" ::: "memory");
            PV_HALF(0, 0);
            for (int v = 0; v < nv; ++v) {
                f32x4 acc[8];
#pragma unroll
                for (int j = 0; j < 8; ++j) acc[j] = (f32x4){0.f, 0.f, 0.f, 0.f};
                PV_HALF(v, 1);
                if (v == 0) asm volatile("s_waitcnt vmcnt(8)" ::: "memory"); else asm volatile("s_waitcnt vmcnt(16)" ::: "memory");
                PV_COMP(v, 0);
                asm volatile("s_waitcnt lgkmcnt(0)" ::: "memory");
                PV_SMALL(v + 2);
                PV_HALF(v + 1, 0);
                asm volatile("s_waitcnt vmcnt(12)" ::: "memory");
                PV_COMP(v, 1);
                {
                    const int r = PV_ROW(v); const int b = r / RPB, jr = r - b * RPB;
                    const LAS float* xs = (const LAS float*)(ST + (v % 3) * 1024 + 512); const LAS float* gt = GT + (jr < LC ? 4 : b) * 128;
                    float* orow = (layer == 0) ? (float*)(p.ws + WS_X) + (size_t)r * D + part * 128 + m16 : p.out + ((size_t)b * L + (jr - LC)) * D + part * 128 + m16;
                    float ov[8];
#pragma unroll
                    for (int j = 0; j < 8; ++j) ov[j] = xs[16 * j + m16] + gt[16 * j + m16] * ((acc[j][0] + acc[j][1]) * (1.f / 64.f));
                    asm volatile("s_waitcnt lgkmcnt(0)" ::: "memory");
                    if (lane < 16) {
#pragma unroll
                        for (int j = 0; j < 8; ++j) asm volatile("global_store_dword %0, %1, off" :: "v"(orow + 16 * j), "v"(ov[j]) : "memory");
                    }
                }
            }
            asm volatile("s_waitcnt vmcnt(0)" ::: "memory");
        }
    }
#undef PV_ROW
#undef PV_SMALL
#undef PV_HALF
#undef PV_COMP
}
constexpr int NPH = 2 + 2 * 11;
__global__ void __launch_bounds__(NTHR, 2) mk_fwd(Params p) {
    extern __shared__ __attribute__((aligned(16))) unsigned char lds_raw[];
    LAS unsigned char* lds = (LAS unsigned char*)lds_raw;
    volatile LAS unsigned* misc = (volatile LAS unsigned*)(lds + LDS_BYTES - 64);
    if (threadIdx.x < 16) misc[threadIdx.x] = 0u;
    __syncthreads();
    const int lo = p.ph_lo, hi = p.ph_hi;
    XcdBarrier bar; bar.bar = (unsigned*)(p.ws + WS_CTL) + 1024; bar.x = 0; bar.st = nullptr;
    if (hi - lo > 1) bar = xcd_barrier_post((unsigned*)(p.ws + WS_CTL) + 1024, misc);
#define IN(k) (lo <= (k) && (k) < hi)
#define SEAM(k) do { if (IN(k) && IN((k) + 1)) xcd_barrier(bar); } while (0)
    if (IN(0)) { phase_pro_a(p, lds); phase_pro_w(p, lds); } SEAM(0);
    if (IN(1)) { phase_pro_b(p); } SEAM(1);
#define LAYER_BODY(l) do { constexpr int k0 = 2 + 11 * (l); \
        if (IN(k0 + 0)) { phase_norm(p, (l), 0); } SEAM(k0 + 0); \
        if (IN(k0 + 1)) { phase_gemm<0>(p, (l), lds); } SEAM(k0 + 1); \
        if (IN(k0 + 2)) { phase_qkrope_s5a(p, (l), lds); } SEAM(k0 + 2); \
        if (IN(k0 + 3)) { phase_attn_s5b(p, (l), lds); } SEAM(k0 + 3); \
        if (IN(k0 + 4)) { phase_s5c(p, (l), lds); } SEAM(k0 + 4); \
        if (IN(k0 + 5)) { phase_glu(p, (l), lds); } SEAM(k0 + 5); \
        if (IN(k0 + 6)) { phase_gemm<1>(p, (l), lds); } SEAM(k0 + 6); \
        if (IN(k0 + 7)) { phase_norm(p, (l), 1); phase_peer_conv(p, (l)); } SEAM(k0 + 7); \
        if (IN(k0 + 8)) { phase_gemm<2>(p, (l), lds); } SEAM(k0 + 8); \
        if (IN(k0 + 9)) { phase_peer_sel(p, (l), lds); } SEAM(k0 + 9); \
          \
        if (IN(k0 + 10)) { phase_peer_slice<0>(p, (l), lds); asm volatile("s_waitcnt vmcnt(0) lgkmcnt(0)" ::: "memory"); phase_peer_v_mfma(p, (l), lds); } SEAM(k0 + 10); } while (0)
    LAYER_BODY(0);
    LAYER_BODY(1);
#undef LAYER_BODY
#undef IN
#undef SEAM
}

extern "C" void kernel_launch(void* const* d_in, const int* in_sizes, int n_in, void* d_out, int out_size, void* d_ws, size_t ws_size, hipStream_t stream) {
    static int grid = 0;
    if (grid == 0) {
        if (n_in != 32 || ws_size < WS_END) { fprintf(stderr, "kernel_launch: unexpected n_in %d / ws %zu\n", n_in, ws_size); grid = -1; return; }
        int dev = 0, cus = 0;
        if (hipGetDevice(&dev) != hipSuccess || hipDeviceGetAttribute(&cus, hipDeviceAttributeMultiprocessorCount, dev) != hipSuccess) { grid = -1; return; }
        if (hipFuncSetAttribute((const void*)mk_fwd, hipFuncAttributeMaxDynamicSharedMemorySize, LDS_BYTES) != hipSuccess) { fprintf(stderr, "kernel_launch: hipFuncSetAttribute failed\n"); grid = -1; return; }
        int per_cu = 0;
        (void)hipOccupancyMaxActiveBlocksPerMultiprocessor(&per_cu, (const void*)mk_fwd, NTHR, LDS_BYTES);
        (void)hipGetLastError();
        grid = cus > 0 ? cus : 256;
    }
    if (grid < 0) return;
    (void)hipMemsetAsync((char*)d_ws + WS_CTL, 0, CTL_ZERO_BYTES, stream);
    Params p{};
    for (int i = 0; i < 32; ++i) p.in[i] = (const float*)d_in[i];
    p.out = (float*)d_out; p.ws = (unsigned char*)d_ws;
#if MK_ONE_LAUNCH
    p.ph_lo = 0; p.ph_hi = NPH;
    hipLaunchKernelGGL(mk_fwd, dim3(grid), dim3(NTHR), LDS_BYTES, stream, p);
#else
    for (int k = 0; k < NPH; ++k) { p.ph_lo = k; p.ph_hi = k + 1; hipLaunchKernelGGL(mk_fwd, dim3(grid), dim3(NTHR), LDS_BYTES, stream, p); }
#endif
}
```

```cpp
#include <hip/hip_runtime.h>
#include <stdint.h>
#include <cstdio>

#ifndef MK_ONE_LAUNCH
#define MK_ONE_LAUNCH 1
#endif

#define GAS __attribute__((address_space(1)))
#define LAS __attribute__((address_space(3)))
typedef unsigned short bf16_t;
typedef float f32x4 __attribute__((ext_vector_type(4)));
typedef unsigned u32x4 __attribute__((ext_vector_type(4)));
typedef unsigned u32x2 __attribute__((ext_vector_type(2)));
typedef float f32x2 __attribute__((ext_vector_type(2)));
typedef short bf16x8_t __attribute__((ext_vector_type(8)));
typedef float f32x16_t __attribute__((ext_vector_type(16)));

constexpr int D = 1024, NB = 4, L = 8192, LC = 256, RPB = L + LC, ROWS = NB * RPB;
constexpr int INW = 2048;
constexpr int C_QA = 0, C_KA = 384, C_VA = 512, C_QB = 640, C_KB = 1024, C_VB = 1408, C_US = 1792;
constexpr int NCH = ROWS / 32, CPB = RPB / 32;
constexpr float EPS = 1e-6f;
constexpr float LOG2E = 1.4426950408889634f;
constexpr int NTHR = 512, NWAVE = 8;
constexpr int LDS_BYTES = 163840;

constexpr size_t MiB = 1u << 20;
constexpr size_t WS_CTL = 0, CTL_ZERO_BYTES = 65536;
constexpr size_t WS_MODP = 1 * MiB;
constexpr size_t WS_MOD = 3 * MiB;
constexpr size_t WS_TABA = 3 * MiB + 512 * 1024;
constexpr size_t WS_TABB = WS_TABA + 32768;
constexpr size_t WS_SCAL = WS_TABB + 32768;
constexpr size_t WS_BBAR = 4 * MiB;
constexpr size_t WS_APOW = 4 * MiB + 512 * 1024;
constexpr size_t WS_B2CAT = 6 * MiB;
constexpr size_t WS_KT = 14 * MiB;
constexpr size_t WS_WGLU_T = 15 * MiB;
constexpr size_t WS_G2CAT = 501 * MiB;
constexpr size_t WS_S5S = 148 * MiB;
constexpr size_t WS_HCAT = 165 * MiB;
constexpr size_t WS_G = 174 * MiB;
constexpr size_t WS_X = 16 * MiB;
constexpr size_t WS_H = 148 * MiB;
constexpr size_t WS_P = 214 * MiB;
constexpr size_t WS_MIX = 346 * MiB;
constexpr size_t WS_WIN_T = 412 * MiB;
constexpr size_t WS_WOUT_T = 420 * MiB;
constexpr size_t WS_WQ_T = 424 * MiB;
constexpr size_t WS_OB = 432 * MiB;
constexpr size_t WS_KEYS16 = 482 * MiB;
constexpr size_t WS_SEL = 484 * MiB;
constexpr size_t WS_U8 = WS_MIX;
constexpr size_t WS_V8 = WS_MIX + 16 * MiB;
constexpr size_t WS_END = 509 * MiB;

struct Params { const float* in[32]; float* out; unsigned char* ws; int ph_lo, ph_hi; };

__device__ __forceinline__ int otid() { int t = threadIdx.x; asm volatile("" : "+v"(t)); return t; }
__device__ __forceinline__ int obid() { int b = blockIdx.x; asm volatile("" : "+s"(b)); return b; }
__device__ __forceinline__ float bf2f(unsigned u) { return __uint_as_float(u << 16); }
__device__ __forceinline__ unsigned f2bf(float f) { unsigned u = __float_as_uint(f); return (u + 0x7fffu + ((u >> 16) & 1u)) >> 16; }
__device__ __forceinline__ unsigned pk2(float lo, float hi) { return f2bf(lo) | (f2bf(hi) << 16); }
__device__ __forceinline__ float gelu_tanh(float x) { const float u = 0.7978845608028654f * (x + 0.044715f * x * x * x); return 0.5f * x * (1.f + tanhf(u)); }
__device__ __forceinline__ float wave_sum(float v) {
#pragma unroll
    for (int o = 1; o < 64; o <<= 1) v += __shfl_xor(v, o);
    return v;
}
__device__ __forceinline__ void sincos_d(double x, double& s, double& c) {
    const double TWO_PI = 6.283185307179586476925286766559;
    const double k = rint(x / TWO_PI);
    const double r = x - k * TWO_PI;
    const double r2 = r * r;
    double ts = r, tc = 1.0, ss = r, cc = 1.0;
#pragma unroll
    for (int n = 1; n <= 16; ++n) {
        tc = -tc * r2 * (1.0 / (double)((2 * n - 1) * (2 * n)));
        ts = -ts * r2 * (1.0 / (double)((2 * n) * (2 * n + 1)));
        cc += tc; ss += ts;
    }
    s = ss; c = cc;
}
__device__ __forceinline__ const float* src_row(const Params& p, int layer, int r) {
    if (layer == 0) { const int b = r / RPB, j = r - b * RPB; return j < LC ? p.in[2] + ((size_t)b * LC + j) * D : p.in[0] + ((size_t)b * L + (j - LC)) * D; }
    return (const float*)(p.ws + WS_X) + (size_t)r * D;
}

#define XB_TMO      128
#define XB_XCNT(j)  (256  + 64 * (j))
#define XB_XSUB(j)  (1280 + 64 * (j))
#define XB_XGEN(j)  (2304 + 64 * (j))
#define XB_TOP      3328
#define XB_TOPGEN   3392
#define XCD_BAR_WORDS 3456
#define XB_SPIN_CAP (1u << 22)
__device__ __forceinline__ unsigned xb_ld(unsigned* p)              { return __hip_atomic_load(p, __ATOMIC_RELAXED, __HIP_MEMORY_SCOPE_AGENT); }
__device__ __forceinline__ unsigned xb_add(unsigned* p, unsigned v) { return __hip_atomic_fetch_add(p, v, __ATOMIC_RELAXED, __HIP_MEMORY_SCOPE_AGENT); }
__device__ __forceinline__ unsigned xb_xcc_id() { return (unsigned)__builtin_amdgcn_s_getreg((3 << 11) | 20) & 0xFu; }
#define XB_SPIN(cond, bar) do { unsigned _sp = 0; while (cond) { __builtin_amdgcn_s_sleep(1); \
    if ((++_sp & 255u) == 0u) { if (xb_ld(&(bar)[XB_TMO])) break; if (_sp > XB_SPIN_CAP) { atomicAdd(&(bar)[XB_TMO], 1u); break; } } } } while (0)
struct XcdBarrier { unsigned* bar; unsigned x; volatile LAS unsigned* st; };
__device__ __forceinline__ XcdBarrier xcd_barrier_post(unsigned* bar, volatile LAS unsigned* st) {
    XcdBarrier b; b.bar = bar; b.x = xb_xcc_id(); b.st = st;
    if (threadIdx.x == 0) (void)xb_add(&bar[XB_XCNT(b.x)], 1u);
    return b;
}
__device__ __forceinline__ void xcd_barrier_complete(unsigned* bar, unsigned x, unsigned& nloc, unsigned& nx) {
    const unsigned G = gridDim.x * gridDim.y * gridDim.z;
    unsigned sum, cnt, mine, sp = 0u;
    for (;;) {
        sum = 0u; cnt = 0u; mine = 0u;
#pragma unroll
        for (unsigned j = 0; j < 16; ++j) { const unsigned c = xb_ld(&bar[XB_XCNT(j)]); sum += c; cnt += (c > 0u) ? 1u : 0u; mine = (j == x) ? c : mine; }
        if (sum == G) break;
        __builtin_amdgcn_s_sleep(1);
        if ((++sp & 255u) == 0u) { if (xb_ld(&bar[XB_TMO])) break; if (sp > XB_SPIN_CAP) { atomicAdd(&bar[XB_TMO], 1u); break; } }
    }
    nloc = mine > 0u ? mine : 1u; nx = cnt > 0u ? cnt : 1u;
}
__device__ __forceinline__ void xcd_barrier(const XcdBarrier& b) {
    asm volatile("s_waitcnt vmcnt(0)" ::: "memory");
    __syncthreads();
    if (threadIdx.x == 0) {
        unsigned* bar = b.bar;
        __builtin_amdgcn_s_waitcnt(0);
        unsigned nloc = b.st[0], nx = b.st[1];
        if (nloc == 0u) { xcd_barrier_complete(bar, b.x, nloc, nx); b.st[0] = nloc; b.st[1] = nx; }
        const unsigned old = xb_add(&bar[XB_XSUB(b.x)], 1u);
        const unsigned gen = old / nloc;
        if (old + 1u == (gen + 1u) * nloc) {
            __builtin_amdgcn_fence(__ATOMIC_RELEASE, "agent");
            asm volatile("s_waitcnt vmcnt(0)" ::: "memory");
            const unsigned og = xb_add(&bar[XB_TOP], 1u);
            const unsigned tg = og / nx;
            if (og + 1u == (tg + 1u) * nx) xb_add(&bar[XB_TOPGEN], 1u);
            else XB_SPIN(xb_ld(&bar[XB_TOPGEN]) == tg, bar);
            __builtin_amdgcn_fence(__ATOMIC_ACQUIRE, "agent");
            xb_add(&bar[XB_XGEN(b.x)], 1u);
            asm volatile("s_waitcnt vmcnt(0)" ::: "memory");
        } else {
            XB_SPIN(xb_ld(&bar[XB_XGEN(b.x)]) == gen, bar);
            __builtin_amdgcn_fence(__ATOMIC_ACQUIRE, "agent");
            asm volatile("s_waitcnt vmcnt(0)" ::: "memory");
        }
    }
    __syncthreads();
}

namespace pg8 {
#define PG8_LAS __attribute__((address_space(3)))
typedef unsigned short bf16_t;
typedef short bf16x8 __attribute__((ext_vector_type(8)));
typedef float f32x4 __attribute__((ext_vector_type(4)));
typedef unsigned u32x4 __attribute__((ext_vector_type(4)));
constexpr int BM = 256, BK = 64, HALF = 128, HTB = HALF * BK * 2  , STAGE_BYTES = 8 * HTB, NXCD = 8, WGM = 8;

__host__ __device__ __forceinline__ int lds_byte(int r, int c) { const int st = (r >> 4) * 2 + (c >> 5), rr = r & 15, cc = c & 31, ob = rr * 64 + cc * 2; return st * 1024 + (ob ^ (((ob >> 9) & 1) << 5)); }
__host__ __device__ __forceinline__ void stage_rc(int b, int& R, int& C) { const int st = b / 1024, sb = b % 1024, swz = sb ^ (((sb >> 9) & 1) << 5); R = (st >> 1) * 16 + swz / 64; C = (st & 1) * 32 + (swz % 64) / 2; }
__host__ __device__ __forceinline__ int perm32(int rho) { const int n = rho >> 4, i = rho & 15; return 8 * (i >> 2) + 4 * n + (i & 3); }

struct Unit { int pm, pn; };
struct Gemm { const bf16_t* A; const bf16_t* Bt; int M, N, K; };
__device__ __forceinline__ unsigned cvt_pk_bf16(float lo, float hi) { unsigned r; asm volatile("v_cvt_pk_bf16_f32 %0, %1, %2" : "=v"(r) : "v"(lo), "v"(hi)); return r; }
template <class Epi, class Sched, bool ALIGN_EPI = false, bool SP2 = false>
__device__ __forceinline__ void gemm_phase(PG8_LAS unsigned char* lds, const Gemm g, const Sched& S, const Epi& E) {
    const int tid = threadIdx.x, wid = __builtin_amdgcn_readfirstlane(tid >> 6), lane = tid & 63, wr = wid >> 2, wc = wid & 3, fr = lane & 15, fq = lane >> 4;
    const int K = g.K, nt = K / BK;
    unsigned voffA[2], voffB[2];
#pragma unroll
    for (int i = 0; i < 2; ++i) { int R, C; stage_rc(tid * 16 + i * 8192, R, C); const int Rb = Epi::PERM ? ((R & ~31) + perm32(R & 31)) : R;
        voffA[i] = (unsigned)(R * K + C) * 2u; voffB[i] = (unsigned)(Rb * K + C) * 2u; }
    const size_t kstep = (size_t)(BK * 2);
    const size_t hstep = (size_t)HALF * K * 2;
    const size_t tstep = 2 * hstep;
    const unsigned ldsw = (unsigned)wid * 1024u;
    const int aoff = lds_byte(wr * 64 + fr, fq * 8), boff = lds_byte(wc * 32 + fr, fq * 8);
#define PG8_SA(b, h) (((b) * 2 + (h)) * HTB)
#define PG8_SB(b, h) ((4 + (b) * 2 + (h)) * HTB)
#define PG8_STAGE(bufoff, gbase, voff) do { _Pragma("unroll") for (int _i = 0; _i < 2; ++_i) \
        __builtin_amdgcn_global_load_lds((const unsigned*)((const char*)(gbase) + (voff)[_i]), (PG8_LAS unsigned*)(lds + (bufoff) + ldsw + _i * 8192), 16, 0, 0); } while (0)
#define PG8_LDA(dst, b, h) do { _Pragma("unroll") for (int m = 0; m < 4; ++m) _Pragma("unroll") for (int k = 0; k < 2; ++k) dst[m][k] = *(const PG8_LAS bf16x8*)(lds + PG8_SA(b, h) + aoff + m * 2048 + k * 1024); } while (0)
#define PG8_LDB(dst, b, h) do { _Pragma("unroll") for (int n = 0; n < 2; ++n) _Pragma("unroll") for (int k = 0; k < 2; ++k) dst[n][k] = *(const PG8_LAS bf16x8*)(lds + PG8_SB(b, h) + boff + n * 2048 + k * 1024); } while (0)
#define PG8_MMA(ai, bj, At, Bt) do { __builtin_amdgcn_s_setprio(1); _Pragma("unroll") for (int m = 0; m < 4; ++m) _Pragma("unroll") for (int n = 0; n < 2; ++n) _Pragma("unroll") for (int k = 0; k < 2; ++k) \
        acc[ai][bj][m][n] = __builtin_amdgcn_mfma_f32_16x16x32_bf16(Bt[n][k], At[m][k], acc[ai][bj][m][n], 0, 0, 0); __builtin_amdgcn_s_setprio(0); } while (0)
#define PG8_WAIT_V(n) asm volatile("s_waitcnt vmcnt(" #n ")" ::: "memory")
#define PG8_WAIT_L(n) asm volatile("s_waitcnt lgkmcnt(" #n ")" ::: "memory")
#define PG8_BAR __builtin_amdgcn_s_barrier()
#define PG8_SCHED __builtin_amdgcn_sched_barrier(0)
    Unit cur, nxt; int ui = 0;
    if (!S.next(0, cur)) return;
    f32x4 acc[2][2][4][2];
#pragma unroll
    for (int a = 0; a < 2; ++a)
#pragma unroll
        for (int b = 0; b < 2; ++b)
#pragma unroll
            for (int m = 0; m < 4; ++m)
#pragma unroll
                for (int n = 0; n < 2; ++n) acc[a][b][m][n] = (f32x4){0.f, 0.f, 0.f, 0.f};
    bf16x8 At[4][2], B0[2][2], B1[2][2];
    const char* cA = (const char*)g.A + (size_t)cur.pm * tstep; const char* cB = (const char*)g.Bt + (size_t)cur.pn * tstep;
    S.a_ready(cur);
    if constexpr (SP2) {
        PG8_STAGE(PG8_SB(0, 0), cB, voffB); PG8_STAGE(PG8_SB(0, 1), cB + hstep, voffB); PG8_STAGE(PG8_SA(0, 0), cA, voffA); PG8_STAGE(PG8_SA(0, 1), cA + hstep, voffA);
        if (wr == 1) PG8_BAR;
        PG8_WAIT_V(2); PG8_BAR;
        PG8_STAGE(PG8_SB(1, 0), cB + kstep, voffB); PG8_STAGE(PG8_SA(1, 0), cA + kstep, voffA); PG8_STAGE(PG8_SB(1, 1), cB + hstep + kstep, voffB);
        PG8_WAIT_V(6); PG8_BAR;
    } else {
        PG8_STAGE(PG8_SB(0, 0), cB, voffB); PG8_STAGE(PG8_SA(0, 0), cA, voffA); PG8_STAGE(PG8_SB(0, 1), cB + hstep, voffB); PG8_STAGE(PG8_SA(0, 1), cA + hstep, voffA);
        if (wr == 1) PG8_BAR;
        PG8_WAIT_V(4); PG8_BAR;
        PG8_STAGE(PG8_SB(1, 0), cB + kstep, voffB); PG8_STAGE(PG8_SA(1, 0), cA + kstep, voffA); PG8_STAGE(PG8_SB(1, 1), cB + hstep + kstep, voffB);
        PG8_WAIT_V(6); PG8_BAR;
    }
    for (;;) {
        const bool has_next = S.next(ui + 1, nxt);
        const char* nA = has_next ? (const char*)g.A + (size_t)nxt.pm * tstep : cA; const char* nB = has_next ? (const char*)g.Bt + (size_t)nxt.pn * tstep : cB;
        for (int t = 0; t < nt; t += 2) {
            const bool last = (t == nt - 2);
            const char* a1 = cA + (size_t)(t + 1) * kstep;
            const char* a2 = last ? nA : cA + (size_t)(t + 2) * kstep; const char* b2 = last ? nB : cB + (size_t)(t + 2) * kstep;
            const char* a3 = a2 + kstep; const char* b3 = b2 + kstep;
            if (last && has_next) S.a_ready(nxt);
            if constexpr (SP2) {
            PG8_LDB(B0, 0, 0); PG8_LDB(B1, 0, 1); PG8_SCHED; PG8_LDA(At, 0, 0); PG8_STAGE(PG8_SA(1, 1), a1 + hstep, voffA);
            PG8_WAIT_V(8); PG8_WAIT_L(0); PG8_BAR; PG8_MMA(0, 0, At, B0); PG8_MMA(0, 1, At, B1); PG8_BAR; PG8_SCHED;
            PG8_LDA(At, 0, 1); PG8_STAGE(PG8_SB(0, 0), b2, voffB); PG8_STAGE(PG8_SB(0, 1), b2 + hstep, voffB); PG8_STAGE(PG8_SA(0, 0), a2, voffA);
            PG8_WAIT_V(8); PG8_WAIT_L(0); PG8_BAR; PG8_MMA(1, 0, At, B0); PG8_MMA(1, 1, At, B1); PG8_BAR; PG8_SCHED;
            PG8_LDB(B0, 1, 0); PG8_LDB(B1, 1, 1); PG8_SCHED; PG8_LDA(At, 1, 0); PG8_STAGE(PG8_SA(0, 1), a2 + hstep, voffA);
            PG8_WAIT_V(8); PG8_WAIT_L(0); PG8_BAR; PG8_MMA(0, 0, At, B0); PG8_MMA(0, 1, At, B1); PG8_BAR; PG8_SCHED;
            PG8_LDA(At, 1, 1); PG8_STAGE(PG8_SB(1, 0), b3, voffB); PG8_STAGE(PG8_SB(1, 1), b3 + hstep, voffB); PG8_STAGE(PG8_SA(1, 0), a3, voffA);
            PG8_WAIT_V(8); PG8_WAIT_L(0); PG8_BAR; PG8_MMA(1, 0, At, B0); PG8_MMA(1, 1, At, B1); PG8_BAR; PG8_SCHED;
            } else {
            PG8_LDB(B0, 0, 0); PG8_SCHED; PG8_LDA(At, 0, 0); PG8_STAGE(PG8_SA(1, 1), a1 + hstep, voffA);
            PG8_WAIT_L(8); PG8_BAR; PG8_WAIT_L(0); PG8_MMA(0, 0, At, B0); PG8_BAR; PG8_SCHED;
            PG8_LDB(B1, 0, 1); PG8_STAGE(PG8_SB(0, 0), b2, voffB);
            PG8_BAR; PG8_WAIT_L(0); PG8_MMA(0, 1, At, B1); PG8_BAR;
            PG8_LDA(At, 0, 1); PG8_STAGE(PG8_SA(0, 0), a2, voffA);
            PG8_BAR; PG8_WAIT_L(0); PG8_MMA(1, 0, At, B0); PG8_BAR; PG8_SCHED;
            PG8_STAGE(PG8_SB(0, 1), b2 + hstep, voffB);
            PG8_WAIT_V(6); PG8_BAR; PG8_MMA(1, 1, At, B1); PG8_BAR;
            PG8_LDB(B0, 1, 0); PG8_SCHED; PG8_LDA(At, 1, 0); PG8_STAGE(PG8_SA(0, 1), a2 + hstep, voffA);
            PG8_WAIT_L(8); PG8_BAR; PG8_WAIT_L(0); PG8_MMA(0, 0, At, B0); PG8_BAR; PG8_SCHED;
            PG8_LDB(B1, 1, 1); PG8_STAGE(PG8_SB(1, 0), b3, voffB);
            PG8_BAR; PG8_WAIT_L(0); PG8_MMA(0, 1, At, B1); PG8_BAR;
            PG8_LDA(At, 1, 1); PG8_STAGE(PG8_SA(1, 0), a3, voffA);
            PG8_BAR; PG8_WAIT_L(0); PG8_MMA(1, 0, At, B0); PG8_BAR; PG8_SCHED;
            PG8_STAGE(PG8_SB(1, 1), b3 + hstep, voffB);
            PG8_WAIT_V(6); PG8_BAR; PG8_MMA(1, 1, At, B1); PG8_BAR;
            }
        }
        if constexpr (ALIGN_EPI) { if (wr == 0) PG8_BAR; }
        if constexpr (!Epi::AFTER_DRAIN) { E(acc, cur, wr, wc, fr, fq); S.done(cur); }
        if (!has_next) break;
#pragma unroll
        for (int a = 0; a < 2; ++a)
#pragma unroll
            for (int b = 0; b < 2; ++b)
#pragma unroll
                for (int m = 0; m < 4; ++m)
#pragma unroll
                    for (int n = 0; n < 2; ++n) acc[a][b][m][n] = (f32x4){0.f, 0.f, 0.f, 0.f};
        cur = nxt; cA = nA; cB = nB; ++ui;
        if constexpr (ALIGN_EPI) { if (wr == 1) PG8_BAR; }
    }
    PG8_WAIT_V(0);
    if constexpr (!ALIGN_EPI) { if (wr == 0) PG8_BAR; }
    PG8_BAR;
    if constexpr (Epi::AFTER_DRAIN) { E.fused(acc, cur, wr, wc, fr, fq, lds, wid, lane); S.done(cur); }
#undef PG8_SA
#undef PG8_SB
#undef PG8_STAGE
#undef PG8_LDA
#undef PG8_LDB
#undef PG8_MMA
#undef PG8_WAIT_V
#undef PG8_WAIT_L
#undef PG8_BAR
#undef PG8_SCHED
}
}

struct RowOrder {
    int nM, nN, nwg, G, c; bool lat_only;
    __device__ __forceinline__ void init(int nM_, int nN_, int G_, int c_, bool lat) { nM = nM_; nN = nN_; nwg = nM * nN; G = G_; c = c_; lat_only = lat; }
    __device__ __forceinline__ bool next(int i, pg8::Unit& u) const {
        const long Lx = (long)i * G + c; if (Lx >= nwg) return false;
        int wgid = (int)Lx; { const int q = nwg / pg8::NXCD, r = nwg % pg8::NXCD, xcd = wgid % pg8::NXCD, off = wgid / pg8::NXCD; wgid = (xcd < r ? xcd * (q + 1) : r * (q + 1) + (xcd - r) * q) + off; }
        const int nig = pg8::WGM * nN, gid = wgid / nig, fm = gid * pg8::WGM, gsz = (nM - fm) < pg8::WGM ? (nM - fm) : pg8::WGM;
        const int pm = fm + ((wgid % nig) % gsz); u.pn = (wgid % nig) / gsz;
        u.pm = lat_only ? (pm / 32) * 33 + 1 + (pm % 32) : pm; return true;
    }
    __device__ __forceinline__ void a_ready(const pg8::Unit&) const {}
    __device__ __forceinline__ void done(const pg8::Unit&) const {}
};
struct EpiBf {
    static constexpr bool PERM = true, AFTER_DRAIN = false;
    bf16_t* O; int ldc;
    __device__ __forceinline__ void operator()(const pg8::f32x4 (&acc)[2][2][4][2], const pg8::Unit& u, int wr, int wc, int fr, int fq) const {
        const int row0 = u.pm * 256 + wr * 64 + fr, col0 = u.pn * 256 + wc * 32 + 8 * fq;
#pragma unroll
        for (int ai = 0; ai < 2; ++ai)
#pragma unroll
            for (int m = 0; m < 4; ++m) { bf16_t* rowp = O + (size_t)(row0 + ai * 128 + m * 16) * ldc + col0;
#pragma unroll
                for (int bj = 0; bj < 2; ++bj) { const pg8::f32x4 v0 = acc[ai][bj][m][0], v1 = acc[ai][bj][m][1];
                    u32x4 w; w.x = pg8::cvt_pk_bf16(v0[0], v0[1]); w.y = pg8::cvt_pk_bf16(v0[2], v0[3]); w.z = pg8::cvt_pk_bf16(v1[0], v1[1]); w.w = pg8::cvt_pk_bf16(v1[2], v1[3]);
                    *(u32x4*)(rowp + bj * 128) = w; } }
    }
};
struct EpiRes {
    static constexpr bool PERM = true, AFTER_DRAIN = false;
    const float* x_in; const float* ctx_in; float* X; const float* mod; int layer; int gate_chunk;
    __device__ __forceinline__ void operator()(const pg8::f32x4 (&acc)[2][2][4][2], const pg8::Unit& u, int wr, int wc, int fr, int fq) const {
        const int b = u.pm / 33, jt = u.pm - b * 33;
        const float* src = layer == 0 ? (jt == 0 ? ctx_in + (size_t)b * LC * D : x_in + ((size_t)b * L + (size_t)(jt - 1) * 256) * D) : X + (size_t)u.pm * 256 * D;
        float* dst = X + (size_t)u.pm * 256 * D;
        const float* g = mod + (size_t)(jt == 0 ? 4 : b) * 6144 + gate_chunk * D;
        const int rl0 = wr * 64 + fr, col0 = u.pn * 256 + wc * 32 + 8 * fq;
        pg8::f32x4 gv[2][2];
#pragma unroll
        for (int bj = 0; bj < 2; ++bj)
#pragma unroll
            for (int n = 0; n < 2; ++n) gv[bj][n] = *(const pg8::f32x4*)(g + col0 + bj * 128 + 4 * n);
#pragma unroll
        for (int ai = 0; ai < 2; ++ai)
#pragma unroll
            for (int m = 0; m < 4; ++m) { const size_t ro = (size_t)(rl0 + ai * 128 + m * 16) * D + col0;
#pragma unroll
                for (int bj = 0; bj < 2; ++bj)
#pragma unroll
                    for (int n = 0; n < 2; ++n) { const size_t off = ro + bj * 128 + 4 * n; const pg8::f32x4 xi = *(const pg8::f32x4*)(src + off);
                        *(pg8::f32x4*)(dst + off) = xi + gv[bj][n] * acc[ai][bj][m][n]; } }
    }
};
struct TrItem { const float* W; bf16_t* WT; int K, N, k0, n0; };
__device__ __forceinline__ TrItem transpose_decode(const Params& p, int it) {
    constexpr int I_IN = 16 * 64, I_OUT = 16 * 32, I_Q = 16 * 64, I_G = 4 * 8, PER_L = I_IN + I_OUT + I_Q + I_G;
    const int l = it / PER_L; int r = it - l * PER_L; TrItem t;
    if (r < I_IN) { t.W = p.in[8] + (size_t)l * 1024 * 2048; t.K = 1024; t.N = 2048; t.WT = (bf16_t*)(p.ws + WS_WIN_T) + (size_t)l * 2048 * 1024; }
    else if ((r -= I_IN) < I_OUT) { t.W = p.in[9] + (size_t)l * 1024 * 1024; t.K = 1024; t.N = 1024; t.WT = (bf16_t*)(p.ws + WS_WOUT_T) + (size_t)l * 1024 * 1024; }
    else if ((r -= I_OUT) < I_G) { t.W = p.in[27] + (size_t)l * 256 * 256; t.K = 256; t.N = 256; t.WT = (bf16_t*)(p.ws + WS_WGLU_T) + (size_t)l * 256 * 256; }
    else { r -= I_G; t.W = p.in[28] + (size_t)l * 1024 * 2048; t.K = 1024; t.N = 2048; t.WT = (bf16_t*)(p.ws + WS_WQ_T) + (size_t)l * 2048 * 1024; }
    const int nblk = t.N / 32; t.k0 = 64 * (r / nblk); t.n0 = 32 * (r % nblk); return t;
}
__device__ __forceinline__ void phase_pro_w(const Params& p, LAS unsigned char* lds) {
    const int tid = otid(), wave = tid >> 6, lane = tid & 63;
    LAS float* scr = (LAS float*)lds + wave * (64 * 33);
    constexpr int PER_L = 16 * 64 + 16 * 32 + 16 * 64 + 4 * 8, NIT = 2 * PER_L;
    const int step = gridDim.x * NWAVE;
    for (int it0 = obid() * NWAVE + wave; it0 < NIT; it0 += 3 * step) {
        f32x4 wv[3][8];
#pragma unroll
        for (int u = 0; u < 3; ++u) { const int it = it0 + u * step; const TrItem t = transpose_decode(p, it < NIT ? it : it0);
#pragma unroll
            for (int i = 0; i < 8; ++i) wv[u][i] = *(const f32x4*)(t.W + (size_t)(t.k0 + 8 * i + (lane >> 3)) * t.N + t.n0 + 4 * (lane & 7)); }
#pragma unroll
        for (int u = 0; u < 3; ++u) { const int it = it0 + u * step; if (it >= NIT) continue; const TrItem t = transpose_decode(p, it);
#pragma unroll
            for (int i = 0; i < 8; ++i) { LAS float* sp = scr + (8 * i + (lane >> 3)) * 33 + 4 * (lane & 7); sp[0] = wv[u][i].x; sp[1] = wv[u][i].y; sp[2] = wv[u][i].z; sp[3] = wv[u][i].w; }
            asm volatile("s_waitcnt lgkmcnt(0)" ::: "memory");
            const int c = lane & 7;
#pragma unroll
            for (int j = 0; j < 4; ++j) { const int n = (lane >> 3) + 8 * j; const LAS float* sp = scr + (8 * c) * 33 + n;
                u32x4 o; o.x = pk2(sp[0 * 33], sp[1 * 33]); o.y = pk2(sp[2 * 33], sp[3 * 33]); o.z = pk2(sp[4 * 33], sp[5 * 33]); o.w = pk2(sp[6 * 33], sp[7 * 33]);
                *(u32x4*)(t.WT + (size_t)(t.n0 + n) * t.K + t.k0 + 8 * c) = o; }
            asm volatile("s_waitcnt lgkmcnt(0)" ::: "memory"); }
    }
}
template <int MODE>
__device__ __forceinline__ void phase_gemm(const Params& p, int layer, LAS unsigned char* lds) {
    const bool lat_only = (MODE != 0) && (layer == 1);
    RowOrder S; S.init(lat_only ? 128 : 132, MODE == 1 ? 4 : 8, (int)gridDim.x, obid(), lat_only);
    if (MODE == 1) {
        pg8::Gemm g{(const bf16_t*)(p.ws + WS_MIX), (const bf16_t*)(p.ws + WS_WOUT_T) + (size_t)layer * 1024 * 1024, ROWS, 1024, 1024};
        EpiRes E{p.in[0], p.in[2], (float*)(p.ws + WS_X), (const float*)(p.ws + WS_MOD) + (size_t)layer * 5 * 6144, layer, 2};
        pg8::gemm_phase<EpiRes, RowOrder, true, true>(lds, g, S, E);
    } else {
        pg8::Gemm g{(const bf16_t*)(p.ws + WS_H), (const bf16_t*)(p.ws + (MODE == 0 ? WS_WIN_T : WS_WQ_T)) + (size_t)layer * 2048 * 1024, ROWS, 2048, 1024};
        EpiBf E{(bf16_t*)(p.ws + WS_P), INW};
        pg8::gemm_phase<EpiBf, RowOrder, true, true>(lds, g, S, E);
    }
}
#include <hip/hip_bf16.h>
namespace attn_body {
using bf16=__hip_bfloat16;
using bf16x8=__attribute__((ext_vector_type(8)))short;
using s16x4=__attribute__((ext_vector_type(4)))short;
using f32x16=__attribute__((ext_vector_type(16)))float;
using u32x4=__attribute__((ext_vector_type(4)))unsigned;
constexpr int D=64,PQ=2048;
constexpr int NW=8,QBLK=32,QB=QBLK*NW,KVBLK=64;
__device__ __forceinline__ int crow(int r,int hi){return (r&3)+8*(r>>2)+4*hi;}
#define SBAR() __builtin_amdgcn_sched_barrier(0)
__device__ __forceinline__ void cmask(f32x16&p0,f32x16&p1,int jb,int qrel,int hi){
  const float NEG=-INFINITY; int kb=64*jb+4*hi;
  #pragma unroll
  for(int r=0;r<16;++r){int kv=kb+(r&3)+8*(r>>2); if(kv>qrel)p0[r]=NEG; if(kv+32>qrel)p1[r]=NEG;}
}

constexpr int NSLOT=3, SLOTB=8192;
constexpr int LDS_K=0, LDS_V=NSLOT*SLOTB, LDS_WS=2*NSLOT*SLOTB, LDS_OST=LDS_WS+NW*64*4, LDS_BYTES=LDS_OST+NW*4096;
constexpr float C2=0.125f*1.4426950408889634f;
__device__ __forceinline__ void glds16(const void*gsrc,unsigned lds_dst){unsigned keep;
  asm volatile("s_mov_b32 %0, m0\n\ts_mov_b32 m0, %2\n\ts_nop 0\n\tglobal_load_lds_dwordx4 %1, off\n\ts_mov_b32 m0, %0":"=&s"(keep):"v"(gsrc),"s"(lds_dst):"memory");}
__device__ __forceinline__ float max3f(float a,float b,float c){float r;asm("v_max3_f32 %0, %1, %2, %3":"=v"(r):"v"(a),"v"(b),"v"(c));return r;}
__device__ __forceinline__ float max2f(float a,float b){float r;asm("v_max_f32_e32 %0, %1, %2":"=v"(r):"v"(a),"v"(b));return r;}
__device__ __forceinline__ float fadd_s(float a,float b){float r;asm("v_add_f32_e32 %0, %1, %2":"=v"(r):"v"(a),"v"(b));return r;}
__device__ __forceinline__ float fsub_s(float a,float b){float r;asm("v_sub_f32_e32 %0, %1, %2":"=v"(r):"v"(a),"v"(b));return r;}
typedef float f32x2_t __attribute__((ext_vector_type(2))); typedef __bf16 bf16x2_t __attribute__((ext_vector_type(2)));
__device__ __forceinline__ unsigned cvtpk_s(float lo,float hi){f32x2_t v={lo,hi};bf16x2_t b=__builtin_convertvector(v,bf16x2_t);return __builtin_bit_cast(unsigned,b);}
#define WAIT_BAR(N) asm volatile("s_waitcnt vmcnt(" #N ") lgkmcnt(0)\n\ts_barrier":::"memory")

template<int DQK> __device__ __forceinline__ void qkt(f32x16&p0,f32x16&p1,const char*Kslot,const bf16x8*qr,const f32x16&negm,int r32,int hi){
  const char*kb=Kslot+hi*1024+r32*16;
  #pragma unroll
  for(int d0=0;d0<DQK/16;++d0){
    const bf16x8 b0=*reinterpret_cast<const bf16x8*>(kb+d0*2048);
    const bf16x8 b1=*reinterpret_cast<const bf16x8*>(kb+d0*2048+512);
    if(d0==0){p0=__builtin_amdgcn_mfma_f32_32x32x16_bf16(b0,qr[0],negm,0,0,0);p1=__builtin_amdgcn_mfma_f32_32x32x16_bf16(b1,qr[0],negm,0,0,0);}
    else{p0=__builtin_amdgcn_mfma_f32_32x32x16_bf16(b0,qr[d0],p0,0,0,0);p1=__builtin_amdgcn_mfma_f32_32x32x16_bf16(b1,qr[d0],p1,0,0,0);}}
}
typedef __attribute__((address_space(3))) const char* lds_cptr;
typedef short v4i16_t __attribute__((ext_vector_type(4)));
template<int DQK> __device__ __forceinline__ void kload8(bf16x8*kf,lds_cptr kp){
  kf[0]=*(const __attribute__((address_space(3))) bf16x8*)(kp);      kf[1]=*(const __attribute__((address_space(3))) bf16x8*)(kp+512);
  kf[2]=*(const __attribute__((address_space(3))) bf16x8*)(kp+2048); kf[3]=*(const __attribute__((address_space(3))) bf16x8*)(kp+2560);
  if constexpr(DQK==64){
  kf[4]=*(const __attribute__((address_space(3))) bf16x8*)(kp+4096); kf[5]=*(const __attribute__((address_space(3))) bf16x8*)(kp+4608);
  kf[6]=*(const __attribute__((address_space(3))) bf16x8*)(kp+6144); kf[7]=*(const __attribute__((address_space(3))) bf16x8*)(kp+6656);}
}
__device__ __forceinline__ void kload2(bf16x8*kf,lds_cptr kp,int j){ kf[2*j]=*(const __attribute__((address_space(3))) bf16x8*)(kp+j*2048); kf[2*j+1]=*(const __attribute__((address_space(3))) bf16x8*)(kp+j*2048+512); }
__device__ __forceinline__ s16x4 vtr(lds_cptr p){ return __builtin_bit_cast(s16x4,__builtin_amdgcn_ds_read_tr16_b64_v4i16((__attribute__((address_space(3))) v4i16_t*)p)); }
__device__ __forceinline__ float rowmax(const f32x16&p0,const f32x16&p1){
  float a=max3f(p0[0],p0[1],p1[0]),b=max3f(p0[2],p0[3],p1[1]);a=max3f(a,p1[2],p1[3]);
  #pragma unroll
  for(int r=4;r<16;r+=4){a=max3f(a,p0[r],p0[r+1]);b=max3f(b,p0[r+2],p0[r+3]);a=max3f(a,p1[r],p1[r+1]);b=max3f(b,p1[r+2],p1[r+3]);}
  const float m=max2f(a,b);
  auto rr=__builtin_amdgcn_permlane32_swap(__float_as_uint(m),__float_as_uint(m),false,false);
  return max2f(__uint_as_float(rr[0]),__uint_as_float(rr[1]));
}
__device__ __forceinline__ void pv(f32x16*o,int vb,bf16x8 pa0,bf16x8 pa1,bf16x8 pa2,bf16x8 pa3){
  #pragma unroll
  for(int d0=0;d0<2;++d0){s16x4 lo[4],hi[4];
    #pragma unroll
    for(int ks=0;ks<4;++ks){
      asm volatile("ds_read_b64_tr_b16 %0,%1 offset:%c2":"=&v"(lo[ks]):"v"(vb),"i"(d0*4096+ks*1024):"memory");
      asm volatile("ds_read_b64_tr_b16 %0,%1 offset:%c2":"=&v"(hi[ks]):"v"(vb),"i"(d0*4096+ks*1024+512):"memory");}
    asm volatile("s_waitcnt lgkmcnt(0)":::"memory");SBAR();
    #define PK(k) (bf16x8){lo[k][0],lo[k][1],lo[k][2],lo[k][3],hi[k][0],hi[k][1],hi[k][2],hi[k][3]}
    o[d0]=__builtin_amdgcn_mfma_f32_32x32x16_bf16(pa0,PK(0),o[d0],0,0,0);
    o[d0]=__builtin_amdgcn_mfma_f32_32x32x16_bf16(pa1,PK(1),o[d0],0,0,0);
    o[d0]=__builtin_amdgcn_mfma_f32_32x32x16_bf16(pa2,PK(2),o[d0],0,0,0);
    o[d0]=__builtin_amdgcn_mfma_f32_32x32x16_bf16(pa3,PK(3),o[d0],0,0,0);
    #undef PK
  }
}

#ifndef ATTN_STORE16
#define ATTN_STORE16(p,v) (*(u32x4*)(p)=(v))
#endif
template<int THRL,int DQK,bool FIXM> __device__ __forceinline__ void attn_unit(const bf16*Qu,const bf16*__restrict__ Kh,const bf16*__restrict__ Vh,bf16*Ou,const int po,const int NT,const float Mfix,char*shm){
  const int tid=threadIdx.x,lane=tid&63,r32=lane&31,hi=lane>>5; const int wid=__builtin_amdgcn_readfirstlane(tid>>6);
  const bf16*Qw=Qu+(long)(wid*QBLK)*PQ;
  const unsigned lds0=(unsigned)(uintptr_t)shm;
  float*wsf=(float*)(shm+LDS_WS)+wid*64;
  const int kch=(DQK==64)?wid:(wid&3);
  const bf16*ksrc=Kh+(long)lane*PQ+kch*8;
  const bf16*vsrc=Vh+(long)(16*(wid&3)+(lane>>2))*PQ+(wid>>2)*32+(lane&3)*8;
  const unsigned kdst=lds0+LDS_K+kch*1024, vdst=lds0+LDS_V+wid*1024;
  #define DMA_K(t,slot) glds16(ksrc+(long)(t)*KVBLK*PQ,(unsigned)__builtin_amdgcn_readfirstlane(kdst+(slot)))
  #define DMA_V(t,slot) glds16(vsrc+(long)(t)*KVBLK*PQ,(unsigned)__builtin_amdgcn_readfirstlane(vdst+(slot)))
  const int vb0=(int)(lds0+LDS_V)+((lane>>4)&1)*32+(lane&3)*8+(4*hi+((lane&15)>>2))*64;
  const char*Kbase=shm+LDS_K; bf16x8 kf[8];
  const lds_cptr shm3=(lds_cptr)shm; const lds_cptr kp0=shm3+LDS_K+hi*1024+r32*16; const lds_cptr vp0=shm3+LDS_V+((lane>>4)&1)*32+(lane&3)*8+(4*hi+((lane&15)>>2))*64;
  DMA_K(0,0);DMA_V(0,0);DMA_K(1,SLOTB);
  bf16x8 qr[4];
  #pragma unroll
  for(int d0=0;d0<DQK/16;++d0)qr[d0]=*reinterpret_cast<const bf16x8*>(&Qw[(long)r32*PQ+d0*16+hi*8]);
  float mhat=0.f,l_reg=0.f;f32x16 o[2];o[0]=f32x16{};o[1]=f32x16{};f32x16 negm=f32x16{};asm volatile("":"+v"(negm));
  #define CMASK(P0,P1,t) do{}while(0)
  bool resc=false;
  #define START(P0,P1) do{ const float rm=FIXM?Mfix:rowmax(P0,P1); resc=false; \
    { const float dl=rm; mhat=fadd_s(mhat,dl); \
      _Pragma("unroll") for(int r=0;r<16;++r){P0[r]=fsub_s(P0[r],dl);P1[r]=fsub_s(P1[r],dl);} \
      _Pragma("unroll") for(int r=0;r<16;++r)negm[r]=-mhat; asm volatile("":"+v"(negm)); } \
    _Pragma("unroll") for(int r=0;r<16;++r)P0[r]=__builtin_amdgcn_exp2f(P0[r]); }while(0)
  #define RESC() do{ if(resc){ asm volatile("s_waitcnt lgkmcnt(0)":::"memory"); \
      _Pragma("unroll") for(int d_=0;d_<2;++d_) _Pragma("unroll") for(int r=0;r<16;++r)o[d_][r]*=wsf[crow(r,hi)]; } }while(0)
  f32x16 pA0,pA1,pB0,pB1;
  int sl_prev=0,sl_cur=0,sl_next=SLOTB;
  #define ROT() do{sl_prev=sl_cur;sl_cur=sl_next;sl_next=(sl_next==(NSLOT-1)*SLOTB)?0:sl_next+SLOTB;}while(0)
  DMA_K(2,2*SLOTB);
  WAIT_BAR(3);
  qkt<DQK>(pA0,pA1,Kbase,qr,negm,r32,hi);asm volatile("s_nop 15\n\ts_nop 7":"+v"(pA0),"+v"(pA1));CMASK(pA0,pA1,0);
  START(pA0,pA1);
  _Pragma("unroll") for(int r=0;r<16;++r)pA1[r]=__builtin_amdgcn_exp2f(pA1[r]);
  WAIT_BAR(0);
  DMA_K(3,0);DMA_V(1,SLOTB);
  ROT();
  kload8<DQK>(kf,kp0+sl_cur);
  WAIT_BAR(2);
  s16x4 vlo[8],vhi[8]; u32x4 pw0,pw1,pw2,pw3;
  #define PKW(P,B) cvtpk_s(P[B],P[B+1])
  #define PAF(k) __builtin_bit_cast(bf16x8,pw##k)
  #define VFR(i) (bf16x8){vlo[i][0],vlo[i][1],vlo[i][2],vlo[i][3],vhi[i][0],vhi[i][1],vhi[i][2],vhi[i][3]}
  #define PIN(x) asm volatile("":"+v"(x))
  #define MX3(a,b,c) __builtin_fmaxf(__builtin_fmaxf((a),(b)),(c))
  #define GAPA(MF,A0,A1,A2,A3,W0,W1,PW) do{ MF; sacc+=A0; sacc+=A1; sacc+=A2; sacc+=A3; PIN(sacc); W0; W1; PIN(PW); SBAR(); }while(0)
  #define EX(v) __builtin_amdgcn_exp2f(v)
  #define GAPB(MF,X,B) do{ MF; X[B]=EX(X[B]); X[B+1]=EX(X[B+1]); X[B+2]=EX(X[B+2]); X[B+3]=EX(X[B+3]); PIN(X); SBAR(); }while(0)
  #define VRD(i) do{ vlo[i]=vtr(vp_+(((i)>>2)*4096+((i)&3)*1024)); vhi[i]=vtr(vp_+(((i)>>2)*4096+((i)&3)*1024+512)); }while(0)
  #define KRD(G,j) do{ if((G)&&(DQK==64||(j)<2)){ kload2(kf,kp0+sl_next,j); SBAR(); } }while(0)
  #define STEP(C0,C1,P0,P1,t,GK,GV,GL) do{ SBAR(); \
    const lds_cptr vp_=vp0+sl_prev; \
    VRD(0); SBAR(); float sacc=(P0[0]+P0[1]); \
    GAPA(C0=__builtin_amdgcn_mfma_f32_32x32x16_bf16(kf[0],qr[0],negm,0,0,0), P0[2],P0[3],P0[4],P0[5],     pw0[0]=PKW(P0,0), pw0[1]=PKW(P0,2), pw0); \
    VRD(4); SBAR(); GAPA(C1=__builtin_amdgcn_mfma_f32_32x32x16_bf16(kf[1],qr[0],negm,0,0,0), P0[6],P0[7],P0[8],P0[9],     pw0[2]=PKW(P0,4), pw0[3]=PKW(P0,6), pw0); \
    VRD(1); SBAR(); GAPA(C0=__builtin_amdgcn_mfma_f32_32x32x16_bf16(kf[2],qr[1],C0,0,0,0),   P0[10],P0[11],P0[12],P0[13], pw1[0]=PKW(P0,8), pw1[1]=PKW(P0,10), pw1); \
    VRD(5); SBAR(); GAPA(C1=__builtin_amdgcn_mfma_f32_32x32x16_bf16(kf[3],qr[1],C1,0,0,0),   P0[14],P0[15],P1[0],P1[1],   pw1[2]=PKW(P0,12),pw1[3]=PKW(P0,14), pw1); \
    VRD(2); SBAR(); GAPA(if constexpr(DQK==64){C0=__builtin_amdgcn_mfma_f32_32x32x16_bf16(kf[4],qr[2],C0,0,0,0);},   P1[2],P1[3],P1[4],P1[5],     pw2[0]=PKW(P1,0), pw2[1]=PKW(P1,2), pw2); \
    VRD(6); SBAR(); GAPA(if constexpr(DQK==64){C1=__builtin_amdgcn_mfma_f32_32x32x16_bf16(kf[5],qr[2],C1,0,0,0);},   P1[6],P1[7],P1[8],P1[9],     pw2[2]=PKW(P1,4), pw2[3]=PKW(P1,6), pw2); \
    VRD(3); SBAR(); GAPA(if constexpr(DQK==64){C0=__builtin_amdgcn_mfma_f32_32x32x16_bf16(kf[6],qr[3],C0,0,0,0);},   P1[10],P1[11],P1[12],P1[13], pw3[0]=PKW(P1,8), pw3[1]=PKW(P1,10), pw3); \
    VRD(7); SBAR(); GAPA(if constexpr(DQK==64){C1=__builtin_amdgcn_mfma_f32_32x32x16_bf16(kf[7],qr[3],C1,0,0,0);},   P1[14],P1[15],0.f,0.f,       pw3[2]=PKW(P1,12),pw3[3]=PKW(P1,14), pw3); \
    l_reg+=sacc; \
    if(GK){DMA_K((t)+3,sl_cur);} if(GV){DMA_V((t)+1,sl_next);} \
    CMASK(C0,C1,t); \
    if constexpr(!FIXM){ float a=MX3(C0[0],C0[1],C1[0]),b=MX3(C0[2],C0[3],C1[1]); a=MX3(a,C1[2],C1[3]); \
      _Pragma("unroll") for(int r=4;r<16;r+=4){a=MX3(a,C0[r],C0[r+1]);b=MX3(b,C0[r+2],C0[r+3]);a=MX3(a,C1[r],C1[r+1]);b=MX3(b,C1[r+2],C1[r+3]);} \
      float rm=__builtin_fmaxf(a,b); { auto rr=__builtin_amdgcn_permlane32_swap(__float_as_uint(rm),__float_as_uint(rm),false,false); rm=__builtin_fmaxf(__uint_as_float(rr[0]),__uint_as_float(rr[1])); } \
      resc=false; \
      if(__builtin_expect(__any(rm>(float)THRL),0)){ const float dl=__builtin_fmaxf(rm,0.f); mhat+=dl; \
        _Pragma("unroll") for(int r=0;r<16;++r){C0[r]-=dl;C1[r]-=dl;} \
        _Pragma("unroll") for(int r=0;r<16;++r)negm[r]=-mhat; asm volatile("":"+v"(negm)); \
        const float f=__builtin_amdgcn_exp2f(-dl); l_reg*=f; if(hi==0)wsf[r32]=f; resc=true; } } \
    SBAR(); \
    GAPB(o[0]=__builtin_amdgcn_mfma_f32_32x32x16_bf16(PAF(0),VFR(0),o[0],0,0,0), C0,0); \
    GAPB(o[1]=__builtin_amdgcn_mfma_f32_32x32x16_bf16(PAF(0),VFR(4),o[1],0,0,0), C0,4); \
    KRD(GL,0); GAPB(o[0]=__builtin_amdgcn_mfma_f32_32x32x16_bf16(PAF(1),VFR(1),o[0],0,0,0), C0,8); \
    KRD(GL,1); GAPB(o[1]=__builtin_amdgcn_mfma_f32_32x32x16_bf16(PAF(1),VFR(5),o[1],0,0,0), C0,12); \
    KRD(GL,2); GAPB(o[0]=__builtin_amdgcn_mfma_f32_32x32x16_bf16(PAF(2),VFR(2),o[0],0,0,0), C1,0); \
    KRD(GL,3); GAPB(o[1]=__builtin_amdgcn_mfma_f32_32x32x16_bf16(PAF(2),VFR(6),o[1],0,0,0), C1,4); \
    GAPB(o[0]=__builtin_amdgcn_mfma_f32_32x32x16_bf16(PAF(3),VFR(3),o[0],0,0,0), C1,8); \
    GAPB(o[1]=__builtin_amdgcn_mfma_f32_32x32x16_bf16(PAF(3),VFR(7),o[1],0,0,0), C1,12); \
    }while(0)
  int t=1;
  #undef CMASK
  #define CMASK(P0,P1,t) do{}while(0)
  for(;t+5<NT;t+=2){
    STEP(pB0,pB1,pA0,pA1,t,true,true,true);     WAIT_BAR(2); RESC(); ROT();
    STEP(pA0,pA1,pB0,pB1,t+1,true,true,true);   WAIT_BAR(2); RESC(); ROT();
  }
  #undef CMASK
  #define CMASK(P0,P1,t) do{}while(0)
  #define ENDW(tt) do{ if((tt)+3<NT){WAIT_BAR(2);} else if((tt)+2<NT){WAIT_BAR(1);} else {WAIT_BAR(0);} }while(0)
  for(;t+1<NT;t+=2){
    STEP(pB0,pB1,pA0,pA1,t,(t+3<NT),(t+1<NT),(t+1<NT));       ENDW(t);   RESC(); ROT();
    STEP(pA0,pA1,pB0,pB1,t+1,(t+4<NT),(t+2<NT),(t+2<NT));     ENDW(t+1); RESC(); ROT();
  }
  STEP(pB0,pB1,pA0,pA1,NT-1,false,false,false); RESC();
  { float sacc=pB0[0]+pB0[1]; _Pragma("unroll") for(int r=2;r<16;++r)sacc+=pB0[r]; _Pragma("unroll") for(int r=0;r<16;++r)sacc+=pB1[r]; l_reg+=sacc;
    pw0=(u32x4){PKW(pB0,0),PKW(pB0,2),PKW(pB0,4),PKW(pB0,6)};pw1=(u32x4){PKW(pB0,8),PKW(pB0,10),PKW(pB0,12),PKW(pB0,14)};pw2=(u32x4){PKW(pB1,0),PKW(pB1,2),PKW(pB1,4),PKW(pB1,6)};pw3=(u32x4){PKW(pB1,8),PKW(pB1,10),PKW(pB1,12),PKW(pB1,14)};
    SBAR(); pv(o,vb0+sl_cur,PAF(0),PAF(1),PAF(2),PAF(3)); }
  #undef PKW
  #undef PAF
  #undef VFR
  #undef PIN
  #undef MX3
  #undef GAPA
  #undef GAPB
  #undef EX
  #undef VRD
  #undef KRD
  #undef STEP
  #undef ENDW
  {auto rr=__builtin_amdgcn_permlane32_swap(__float_as_uint(l_reg),__float_as_uint(l_reg),false,false);l_reg=__uint_as_float(rr[0])+__uint_as_float(rr[1]);}
  if(hi==0)wsf[32+r32]=l_reg;asm volatile("s_waitcnt lgkmcnt(0)":::"memory");
  float rli[16];
  #pragma unroll
  for(int r=0;r<16;++r)rli[r]=__builtin_amdgcn_rcpf(wsf[32+crow(r,hi)]);
  bf16*Ow=Ou+(long)(wid*QBLK)*po;
  { bf16*stg=(bf16*)(shm+LDS_OST)+wid*2048;
    #pragma unroll
    for(int r=0;r<16;++r){const int orow=crow(r,hi);
      #pragma unroll
      for(int d0=0;d0<2;++d0)stg[orow*64+d0*32+r32]=__float2bfloat16(o[d0][r]*rli[r]);}
    asm volatile("s_waitcnt lgkmcnt(0)":::"memory");
    #pragma unroll
    for(int i=0;i<4;++i){const int row=i*8+(lane>>3),ch=lane&7; const u32x4 v=*(const u32x4*)(stg+row*64+ch*8); ATTN_STORE16(Ow+(long)row*po+ch*8,v);} }
  asm volatile("s_waitcnt lgkmcnt(0)\n\ts_barrier":::"memory");
  #undef DMA_K
  #undef DMA_V
  #undef CMASK
  #undef START
  #undef RESC
  #undef ROT
}
constexpr int ATTN_LDS_BYTES=LDS_BYTES;
#undef SBAR
#undef WAIT_BAR
}

__device__ __forceinline__ void phase_pro_a(const Params& p, LAS unsigned char* lds) {
    const int gtid = obid() * NTHR + otid(), GT = gridDim.x * NTHR;
    {
        LAS float* sl = (LAS float*)lds; const int tid = otid();
        for (int bi = obid(); bi < 2 * 8 * 16; bi += gridDim.x) {
            const int l = bi >> 7, kq = (bi >> 4) & 7, n = (bi & 15) * 384 + tid;
            __syncthreads();
            for (int e = tid; e < 5 * 128; e += NTHR) { const int v = e >> 7, k = kq * 128 + (e & 127); const float cv = v < 4 ? p.in[1][v * D + k] : p.in[3][k]; sl[e] = cv / (1.f + expf(-cv)); }
            __syncthreads();
            if (tid < 384) {
                const float* W = p.in[4] + (size_t)l * D * 6144 + (size_t)(kq * 128) * 6144 + n;
                float acc[5] = {0.f, 0.f, 0.f, 0.f, 0.f};
#pragma unroll 32
                for (int k = 0; k < 128; ++k) { const float w = W[(size_t)k * 6144];
#pragma unroll
                    for (int v = 0; v < 5; ++v) acc[v] += sl[v * 128 + k] * w; }
                float* modp = (float*)(p.ws + WS_MODP);
#pragma unroll
                for (int v = 0; v < 5; ++v) modp[((size_t)(kq * 2 + l) * 5 + v) * 6144 + n] = acc[v];
            }
        }
        __syncthreads();
    }
    constexpr int N_A = 0, N_B = 192 * 16, N_C = 192 * 8, N_D = 2 * 2 * 16 * 64 * 34, N_E = 2, N_K = 2 * 16 * 128 * 128 / 2;
    float2* tabA = (float2*)(p.ws + WS_TABA); float2* tabB = (float2*)(p.ws + WS_TABB);
    float* scal = (float*)(p.ws + WS_SCAL);
    float2* apow = (float2*)(p.ws + WS_APOW); float2* bbar = (float2*)(p.ws + WS_BBAR);
    for (int it = gtid; it < N_A + N_B + N_C + N_D + N_E + N_K; it += GT) {
        int r = it;
        if (r >= N_A + N_B + N_C + N_D + N_E) { r -= N_A + N_B + N_C + N_D + N_E; ((unsigned*)(p.ws + WS_KEYS16))[r] = pk2(p.in[29][2 * r], p.in[29][2 * r + 1]); continue; }
        r -= N_A;
        if (r < N_B) {
            const int e = r / 16, j = r % 16; const int pos = e < 128 ? e : e - 128;
            const float inv = (float)exp(-((double)(2 * j) / 32.0) * 9.210340371976184);
            const float ang = (float)pos * inv; double s, c; sincos_d((double)ang, s, c);
            tabA[r] = make_float2((float)c, (float)s); continue;
        }
        r -= N_B;
        if (r < N_C) {
            const int e = r / 8, j = r % 8; const int pos = e < 128 ? e : e - 128;
            const float inv = (float)exp(-((double)(2 * j) / 16.0) * 9.210340371976184);
            const float ang = (float)pos * inv; double s, c; sincos_d((double)ang, s, c);
            tabB[r] = make_float2((float)c, (float)s); continue;
        }
        r -= N_C;
        if (r < N_D) {
            const int m = r % 34; r /= 34;
            const int ldg = r / 64;
            const double are = p.in[19][r], aim = p.in[20][r], dt = exp((double)p.in[21][ldg]);
            if (m <= 32) { const double em = exp(are * dt * (double)m); double sm, cm; sincos_d(aim * dt * (double)m, sm, cm); apow[(size_t)r * 33 + m] = make_float2((float)(em * cm), (float)(em * sm)); continue; }
            const double er = exp(are * dt); double sn, cs; sincos_d(aim * dt, sn, cs);
            const double abr = er * cs, abi = er * sn;
            const double nr = abr - 1.0, ni = abi, den = are * are + aim * aim;
            const double cr = (nr * are + ni * aim) / den, ci = (ni * are - nr * aim) / den;
#pragma unroll 1
            for (int q = 0; q < 16; ++q) { const double br = p.in[22][(size_t)r * 16 + q], bi = p.in[23][(size_t)r * 16 + q];
                bbar[(size_t)r * 16 + q] = make_float2((float)(cr * br - ci * bi), (float)(cr * bi + ci * br)); }
            continue;
        }
        r -= N_D;
        {
            const int l = r; float s1 = 0.f, s2 = 0.f;
            for (int i = 0; i < 32; ++i) { s1 += p.in[14][l * 32 + i] * p.in[15][l * 32 + i]; s2 += p.in[16][l * 32 + i] * p.in[17][l * 32 + i]; }
            const float lam_init = 0.8f - 0.6f * expf(-0.3f * (float)l);
            scal[l] = expf(s1) - expf(s2) + lam_init;
            float mqa = 0.f, mka = 0.f, mqb = 0.f, mkb = 0.f;
            for (int i = 0; i < 64; ++i) { mqa = fmaxf(mqa, fabsf(p.in[10][l * 64 + i])); mka = fmaxf(mka, fabsf(p.in[11][l * 64 + i])); }
            for (int i = 0; i < 32; ++i) { mqb = fmaxf(mqb, fabsf(p.in[12][l * 32 + i])); mkb = fmaxf(mkb, fabsf(p.in[13][l * 32 + i])); }
            scal[2 + l] = fminf(LOG2E * 8.f * mqa * mka * 1.02f, 60.f);
            scal[4 + l] = fminf(LOG2E * 5.656854249f * mqb * mkb * 1.02f, 60.f);
        }
    }
}
__device__ __forceinline__ void phase_pro_b(const Params& p) {
    const int gtid = obid() * NTHR + otid(), GT = gridDim.x * NTHR;
    const float* modp = (const float*)(p.ws + WS_MODP); float* mod = (float*)(p.ws + WS_MOD);
    for (int it = gtid; it < 2 * 5 * 6144; it += GT) {
        const int l = it / (5 * 6144), v = (it / 6144) % 5, n = it % 6144;
        float a = p.in[5][l * 6144 + n];
        for (int kq = 0; kq < 8; ++kq) a += modp[((size_t)(kq * 2 + l) * 5 + v) * 6144 + n];
        mod[it] = a;
    }
    const float2* apow = (const float2*)(p.ws + WS_APOW); const float2* bbar = (const float2*)(p.ws + WS_BBAR);
    bf16_t* KT = (bf16_t*)(p.ws + WS_KT); bf16_t* B2 = (bf16_t*)(p.ws + WS_B2CAT); bf16_t* G2 = (bf16_t*)(p.ws + WS_G2CAT);
    for (int it4 = gtid; it4 < 2 * 16 * 63 * 16 * 4; it4 += GT) {
        const int it = it4 >> 2, nq = it4 & 3;
        const int pp = it & 15, idx = (it >> 4) % 63, g = ((it >> 4) / 63) & 15, l = (it >> 4) / (63 * 16);
        const int lam = idx - 31; float val[16];
#pragma unroll
        for (int q = 0; q < 16; ++q) val[q] = 0.f;
#pragma unroll 1
        for (int dir = 0; dir < 2; ++dir) {
            if (dir == 0 ? lam < 0 : lam > 0) continue;
            const int m = lam < 0 ? -lam : lam; const int pb = (l * 2 + dir) * 16 + g;
            const float* cre = p.in[24] + (size_t)(pb * 16 + pp) * 64; const float* cim = p.in[25] + (size_t)(pb * 16 + pp) * 64;
#pragma unroll 4
            for (int jn = 0; jn < 16; ++jn) { const int n = 4 * jn + nq; const float2 A = apow[(size_t)(pb * 64 + n) * 33 + m]; const float cr = cre[n], ci = cim[n];
                const float zr = cr * A.x - ci * A.y, zi = cr * A.y + ci * A.x;
                const f32x4* bq = (const f32x4*)(bbar + (size_t)(pb * 64 + n) * 16);
#pragma unroll
                for (int q2 = 0; q2 < 8; ++q2) { const f32x4 bb = bq[q2]; val[2 * q2] += zr * bb.x - zi * bb.y; val[2 * q2 + 1] += zr * bb.z - zi * bb.w; } }
        }
#pragma unroll
        for (int q = 0; q < 16; ++q) { val[q] += __shfl_xor(val[q], 1); val[q] += __shfl_xor(val[q], 2); }
        if (lam == 0) {
#pragma unroll
            for (int q = 0; q < 16; ++q) if (q == pp) val[q] += p.in[26][l * 256 + g * 16 + pp];
        }
        if (nq == 0) {
            u32x4 o0, o1;
            o0.x = pk2(val[0], val[1]); o0.y = pk2(val[2], val[3]); o0.z = pk2(val[4], val[5]); o0.w = pk2(val[6], val[7]);
            o1.x = pk2(val[8], val[9]); o1.y = pk2(val[10], val[11]); o1.z = pk2(val[12], val[13]); o1.w = pk2(val[14], val[15]);
            *(u32x4*)(KT + (size_t)it * 16) = o0; *(u32x4*)(KT + (size_t)it * 16 + 8) = o1;
        }
    }
    for (int it = gtid; it < 2 * 16 * 256 * 64; it += GT) {
        const int col8 = it & 63, k = (it >> 6) & 255, g = (it >> 14) & 15, l = it >> 18;
        const int dir = k >> 7, part = (k >> 6) & 1, n = k & 63, i = col8 >> 1, q0 = (col8 & 1) * 8; const int e = dir == 0 ? 31 - i : i;
        const int pb = (l * 2 + dir) * 16 + g;
        const float2 A = apow[(size_t)(pb * 64 + n) * 33 + e]; const f32x4* bq = (const f32x4*)(bbar + (size_t)(pb * 64 + n) * 16 + q0);
        float v[8];
#pragma unroll
        for (int q2 = 0; q2 < 4; ++q2) { const f32x4 bb = bq[q2];
            v[2 * q2] = part == 0 ? A.x * bb.x - A.y * bb.y : A.x * bb.y + A.y * bb.x; v[2 * q2 + 1] = part == 0 ? A.x * bb.z - A.y * bb.w : A.x * bb.w + A.y * bb.z; }
        u32x4 o; o.x = pk2(v[0], v[1]); o.y = pk2(v[2], v[3]); o.z = pk2(v[4], v[5]); o.w = pk2(v[6], v[7]);
        *(u32x4*)(B2 + (size_t)it * 8) = o;
    }
    for (int it0 = gtid; it0 < 2 * 16 * 512 * 32; it0 += 4 * GT) {
        float2 A[4][8]; f32x4 crv[4][2], civ[4][2];
#pragma unroll
        for (int u = 0; u < 4; ++u) { const int it = it0 + u * GT; const int itc = it < 2 * 16 * 512 * 32 ? it : it0;
            const int k8 = itc & 31, row = (itc >> 5) & 511, g = (itc >> 14) & 15, l = itc >> 18;
            const int k = k8 * 8, dir = k >> 7, n0 = k & 63, i = row >> 4, pp = row & 15; const int e = dir == 0 ? i + 1 : 32 - i;
            const int pb = (l * 2 + dir) * 16 + g;
            const float* cre = p.in[24] + (size_t)(pb * 16 + pp) * 64 + n0; const float* cim = p.in[25] + (size_t)(pb * 16 + pp) * 64 + n0;
            crv[u][0] = *(const f32x4*)cre; crv[u][1] = *(const f32x4*)(cre + 4); civ[u][0] = *(const f32x4*)cim; civ[u][1] = *(const f32x4*)(cim + 4);
#pragma unroll
            for (int jn = 0; jn < 8; ++jn) A[u][jn] = apow[(size_t)(pb * 64 + n0 + jn) * 33 + e]; }
#pragma unroll
        for (int u = 0; u < 4; ++u) { const int it = it0 + u * GT; if (it >= 2 * 16 * 512 * 32) continue;
            const int part = (((it & 31) * 8) >> 6) & 1;
            const float cr[8] = {crv[u][0].x, crv[u][0].y, crv[u][0].z, crv[u][0].w, crv[u][1].x, crv[u][1].y, crv[u][1].z, crv[u][1].w};
            const float ci[8] = {civ[u][0].x, civ[u][0].y, civ[u][0].z, civ[u][0].w, civ[u][1].x, civ[u][1].y, civ[u][1].z, civ[u][1].w};
            float v[8];
#pragma unroll
            for (int jn = 0; jn < 8; ++jn) v[jn] = part == 0 ? cr[jn] * A[u][jn].x - ci[jn] * A[u][jn].y : -(cr[jn] * A[u][jn].y + ci[jn] * A[u][jn].x);
            u32x4 o; o.x = pk2(v[0], v[1]); o.y = pk2(v[2], v[3]); o.z = pk2(v[4], v[5]); o.w = pk2(v[6], v[7]);
            *(u32x4*)(G2 + (size_t)it * 8) = o; }
    }
}
__device__ __forceinline__ void phase_norm(const Params& p, int layer, int which) {
    const int wave = otid() >> 6, lane = otid() & 63;
    const float* mod = (const float*)(p.ws + WS_MOD) + (size_t)layer * 5 * 6144;
    const float* gain = (which ? p.in[7] : p.in[6]) + layer * D;
    bf16_t* H = (bf16_t*)(p.ws + WS_H);
    const bool xin_ws = (which == 1) || (layer == 1);
    const bool lat = (which == 1 && layer == 1);
    const int nrows = lat ? NB * L : ROWS, rstart = (obid() * NWAVE + wave) * 4, rstep = gridDim.x * NWAVE * 4;
    f32x4 gs[4], shv[4]; int mcur = -1;
#pragma unroll
    for (int q = 0; q < 4; ++q) { gs[q] = (f32x4){0.f, 0.f, 0.f, 0.f}; shv[q] = gs[q]; }
    for (int li = rstart; li < nrows; li += rstep) {
        const int r0 = lat ? (li >> 13) * RPB + LC + (li & 8191) : li; const int b = r0 / RPB, j = r0 - b * RPB;
        const float* xr = xin_ws ? (const float*)(p.ws + WS_X) + (size_t)r0 * D : src_row(p, 0, r0);
        f32x4 v[16];
#pragma unroll
        for (int q = 0; q < 16; ++q) v[q] = *(const f32x4*)(xr + (size_t)(q >> 2) * D + 4 * lane + 256 * (q & 3));
        const int mrow = j < LC ? 4 : b;
        if (mrow != mcur) { mcur = mrow; const float* mv = mod + (size_t)mrow * 6144;
#pragma unroll
            for (int q = 0; q < 4; ++q) { const int c = 4 * lane + 256 * q;
                const f32x4 g = *(const f32x4*)(gain + c); const f32x4 sc = *(const f32x4*)(mv + (which ? 4 : 1) * D + c);
                shv[q] = *(const f32x4*)(mv + (which ? 3 : 0) * D + c);
                gs[q].x = g.x * (1.f + sc.x); gs[q].y = g.y * (1.f + sc.y); gs[q].z = g.z * (1.f + sc.z); gs[q].w = g.w * (1.f + sc.w); } }
        float ss[4];
#pragma unroll
        for (int k = 0; k < 4; ++k) { ss[k] = 0.f;
#pragma unroll
            for (int q = 0; q < 4; ++q) { const f32x4 t = v[4 * k + q]; ss[k] += t.x * t.x + t.y * t.y + t.z * t.z + t.w * t.w; } }
#pragma unroll
        for (int o = 1; o < 64; o <<= 1) {
#pragma unroll
            for (int k = 0; k < 4; ++k) ss[k] += __shfl_xor(ss[k], o); }
#pragma unroll
        for (int k = 0; k < 4; ++k) {
            const float rinv = 1.f / sqrtf(ss[k] * (1.f / D) + EPS);
#pragma unroll
            for (int q = 0; q < 4; ++q) { const int c = 4 * lane + 256 * q; const f32x4 t = v[4 * k + q];
                const float y0 = t.x * rinv * gs[q].x + shv[q].x, y1 = t.y * rinv * gs[q].y + shv[q].y;
                const float y2 = t.z * rinv * gs[q].z + shv[q].z, y3 = t.w * rinv * gs[q].w + shv[q].w;
                u32x2 o; o.x = pk2(y0, y1); o.y = pk2(y2, y3);
                *(u32x2*)(H + (size_t)(r0 + k) * D + c) = o; }
        }
    }
}
template <int GL>
__device__ __forceinline__ void norm_rope_pass(bf16_t* prow, int colbase, const float* gain, const float2* tab, int tok, float scale, int lane) {
    const int pi = lane & (GL - 1), hsel = lane / GL;
    bf16_t* ptr = prow + colbase + hsel * (2 * GL) + 2 * pi;
    const unsigned raw = *(const unsigned*)ptr;
    const float x0 = bf2f(raw & 0xffffu), x1 = bf2f(raw >> 16);
    float ss = x0 * x0 + x1 * x1;
#pragma unroll
    for (int o = 1; o < GL; o <<= 1) ss += __shfl_xor(ss, o);
    const float rinv = 1.f / sqrtf(ss * (1.f / (2 * GL)) + EPS);
    float y0 = x0 * rinv * gain[2 * pi], y1 = x1 * rinv * gain[2 * pi + 1];
    if (tok >= 0) {
        constexpr int Q = GL / 2;
        const int e = pi < Q ? (tok >> 6) : 128 + (tok & 63);
        const float2 cs = tab[e * Q + (pi & (Q - 1))];
        const float o0 = y0 * cs.x - y1 * cs.y, o1 = y0 * cs.y + y1 * cs.x; y0 = o0; y1 = o1;
    }
    *(unsigned*)ptr = pk2(y0 * scale, y1 * scale);
}
__device__ __forceinline__ void phase_qkrope_s5a(const Params& p, int layer, LAS unsigned char* lds) {
    const int wave = otid() >> 6, lane = otid() & 63;
    bf16_t* P = (bf16_t*)(p.ws + WS_P);
    const float2* tabA = (const float2*)(p.ws + WS_TABA); const float2* tabB = (const float2*)(p.ws + WS_TABB);
    const float* qna = p.in[10] + layer * 64; const float* kna = p.in[11] + layer * 64;
    const float* qnb = p.in[12] + layer * 32; const float* knb = p.in[13] + layer * 32;
    const float scA = 0.125f * LOG2E, scB = 0.17677669529663687f * LOG2E;
    float gA[8], gB[8], gBk[8];
    {   const int hA = lane >> 3, dA = (lane & 7) * 8, dB = (lane & 3) * 8;
#pragma unroll
        for (int i = 0; i < 8; ++i) { gA[i] = (hA < 6 ? qna : kna)[dA + i] * (hA < 6 ? scA : 1.f); gB[i] = lane < 48 ? qnb[dB + i] * scB : knb[dB + i]; gBk[i] = knb[dB + i]; } }
#define QKR_PASS(colbase, NL, gsel, LSEL, DOST, WIN, T0, T1) do { \
        bf16_t* ptr_ = prow + (colbase) + (LSEL) * 8; const u32x4 w_ = (WIN); const unsigned ww_[4] = {w_.x, w_.y, w_.z, w_.w}; \
        float x_[8]; float ss_ = 0.f; \
        _Pragma("unroll") for (int q_ = 0; q_ < 4; ++q_) { x_[2 * q_] = bf2f(ww_[q_] & 0xffffu); x_[2 * q_ + 1] = bf2f(ww_[q_] >> 16); ss_ += x_[2 * q_] * x_[2 * q_] + x_[2 * q_ + 1] * x_[2 * q_ + 1]; } \
        ss_ += __int_as_float(__builtin_amdgcn_update_dpp(0, __float_as_int(ss_), 0xB1, 0xf, 0xf, true)); \
        ss_ += __int_as_float(__builtin_amdgcn_update_dpp(0, __float_as_int(ss_), 0x4E, 0xf, 0xf, true)); \
        if ((NL) == 8) { const float t7_ = __int_as_float(__builtin_amdgcn_update_dpp(0, __float_as_int(ss_), 0x141, 0xf, 0xf, true)); ss_ += __int_as_float(__builtin_amdgcn_update_dpp(0, __float_as_int(t7_), 0x1B, 0xf, 0xf, true)); } \
        const float rinv_ = 1.f / sqrtf(ss_ * (1.f / ((NL) * 8)) + EPS); \
        const f32x4 t0_ = (T0), t1_ = (T1); const float cs_[8] = {t0_.x, t0_.y, t0_.z, t0_.w, t1_.x, t1_.y, t1_.z, t1_.w}; \
        unsigned o_[4]; \
        _Pragma("unroll") for (int q_ = 0; q_ < 4; ++q_) { const float y0_ = x_[2 * q_] * rinv_ * gsel[2 * q_], y1_ = x_[2 * q_ + 1] * rinv_ * gsel[2 * q_ + 1]; \
            o_[q_] = pk2(y0_ * cs_[2 * q_] - y1_ * cs_[2 * q_ + 1], y0_ * cs_[2 * q_ + 1] + y1_ * cs_[2 * q_]); } \
        u32x4 ov_; ov_.x = o_[0]; ov_.y = o_[1]; ov_.z = o_[2]; ov_.w = o_[3]; if (DOST) *(u32x4*)ptr_ = ov_; } while (0)
#define QKR_LOAD(S, rr) do { const int r_ = (rr); const int b_ = r_ / RPB, j_ = r_ - b_ * RPB; const int tk_ = j_ < LC ? 0 : j_ - LC; const bf16_t* pr_ = P + (size_t)r_ * INW; \
        S##d0 = *(const u32x4*)(pr_ + lane * 8); S##d1 = *(const u32x4*)(pr_ + C_QB + lane * 8); S##d2 = *(const u32x4*)(pr_ + C_QB + 512 + (lane & 31) * 8); \
        {   const int pl_ = lane & 7; const int e_ = pl_ < 4 ? (tk_ >> 6) : 128 + (tk_ & 63); const float* tp_ = (const float*)tabA + ((size_t)e_ * 16 + (pl_ & 3) * 4) * 2; S##a0 = *(const f32x4*)tp_; S##a1 = *(const f32x4*)(tp_ + 4); } \
        {   const int pl_ = lane & 3; const int e_ = pl_ < 2 ? (tk_ >> 6) : 128 + (tk_ & 63); const float* tp_ = (const float*)tabB + ((size_t)e_ * 8 + (pl_ & 1) * 4) * 2; S##b0 = *(const f32x4*)tp_; S##b1 = *(const f32x4*)(tp_ + 4); } } while (0)
#define QKR_ROW(S, rr) do { bf16_t* prow = P + (size_t)(rr) * INW; \
        QKR_PASS(0, 8, gA, lane, true, S##d0, S##a0, S##a1);                          \
        QKR_PASS(C_QB, 4, gB, lane, true, S##d1, S##b0, S##b1);                       \
        QKR_PASS(C_QB + 512, 4, gBk, (lane & 31), lane < 32, S##d2, S##b0, S##b1);    } while (0)
    {   const int pstart = obid() * NWAVE + wave, pstep = gridDim.x * NWAVE, npair = ROWS / 2;
        const u32x4 z4 = {0u, 0u, 0u, 0u}; const f32x4 zf = {0.f, 0.f, 0.f, 0.f};
        u32x4 Ad0 = z4, Ad1 = z4, Ad2 = z4, Bd0 = z4, Bd1 = z4, Bd2 = z4; f32x4 Aa0 = zf, Aa1 = zf, Ab0 = zf, Ab1 = zf, Ba0 = zf, Ba1 = zf, Bb0 = zf, Bb1 = zf;
        if (pstart < npair) { QKR_LOAD(A, 2 * pstart); QKR_LOAD(B, 2 * pstart + 1); }
        for (int pi = pstart; pi < npair; pi += pstep) {
            const u32x4 Cd0 = Ad0, Cd1 = Ad1, Cd2 = Ad2, Ed0 = Bd0, Ed1 = Bd1, Ed2 = Bd2; const f32x4 Ca0 = Aa0, Ca1 = Aa1, Cb0 = Ab0, Cb1 = Ab1, Ea0 = Ba0, Ea1 = Ba1, Eb0 = Bb0, Eb1 = Bb1;
            if (pi + pstep < npair) { QKR_LOAD(A, 2 * (pi + pstep)); QKR_LOAD(B, 2 * (pi + pstep) + 1); }
            QKR_ROW(C, 2 * pi);
            QKR_ROW(E, 2 * pi + 1);
        }
    }
#undef QKR_PASS
#undef QKR_LOAD
#undef QKR_ROW
    {
        const int tid = otid(), r32 = lane & 31, hi = lane >> 5;
        const bf16_t* B2 = (const bf16_t*)(p.ws + WS_B2CAT) + (size_t)layer * 16 * 256 * 512;
        float* S = (float*)(p.ws + WS_S5S);
        const int NBC = (int)gridDim.x >= 32 ? (int)gridDim.x / 32 : 1;
        for (int combo = obid() / NBC; combo < 32; combo += (int)gridDim.x / NBC) {
            const int g = combo >> 1, mh = combo & 1, sb = obid() % NBC;
            __syncthreads();
            {   const bf16_t* bsrc = B2 + (size_t)(g * 256 + 128 * mh) * 512;
#pragma unroll 1
                for (int q0 = 0; q0 < 16; q0 += 8) { u32x4 t[8];
#pragma unroll
                    for (int q = 0; q < 8; ++q) { const int e = tid + (q0 + q) * NTHR; t[q] = *(const u32x4*)(bsrc + (size_t)(e >> 6) * 512 + (e & 63) * 8); }
#pragma unroll
                    for (int q = 0; q < 8; ++q) { const int e = tid + (q0 + q) * NTHR; *(LAS u32x4*)(lds + (e >> 6) * 1040 + (e & 63) * 16) = t[q]; } } }
            __syncthreads();
            for (int ct = sb * NWAVE + wave; ct < 33; ct += NBC * NWAVE) {
                f32x16_t acc[4];
#pragma unroll
                for (int mt = 0; mt < 4; ++mt) acc[mt] = (f32x16_t){0.f,0.f,0.f,0.f,0.f,0.f,0.f,0.f,0.f,0.f,0.f,0.f,0.f,0.f,0.f,0.f};
                const bf16_t* up = P + (size_t)((ct * 32 + r32) * 32) * INW + C_US + g * 16 + 8 * hi;
                const LAS unsigned char* al = lds + r32 * 1040 + 16 * hi;
#define S_LOAD(buf, k0) do { _Pragma("unroll") for (int i_ = 0; i_ < 8; ++i_) buf[i_] = *(const bf16x8_t*)(up + (size_t)((k0) + i_) * INW); } while (0)
#define S_COMP(buf, k0) do { _Pragma("unroll") for (int i_ = 0; i_ < 8; ++i_) { \
            _Pragma("unroll") for (int mt = 0; mt < 4; ++mt) { const bf16x8_t av = *(const LAS bf16x8_t*)(al + mt * (32 * 1040) + ((k0) + i_) * 32); acc[mt] = __builtin_amdgcn_mfma_f32_32x32x16_bf16(av, buf[i_], acc[mt], 0, 0, 0); } \
            __builtin_amdgcn_sched_barrier(0); } } while (0)
                bf16x8_t ua[8], ub[8];
                S_LOAD(ua, 0); S_LOAD(ub, 8);
                S_COMP(ua, 0); S_LOAD(ua, 16);
                S_COMP(ub, 8); S_LOAD(ub, 24);
                S_COMP(ua, 16); S_COMP(ub, 24);
#undef S_LOAD
#undef S_COMP
                float* sp = S + ((size_t)(ct * 32 + r32) * 16 + g) * 256 + 128 * mh + 4 * hi;
#pragma unroll
                for (int mt = 0; mt < 4; ++mt)
#pragma unroll
                    for (int rq = 0; rq < 4; ++rq) { f32x4 v; v.x = acc[mt][4 * rq]; v.y = acc[mt][4 * rq + 1]; v.z = acc[mt][4 * rq + 2]; v.w = acc[mt][4 * rq + 3]; *(f32x4*)(sp + 32 * mt + 8 * rq) = v; }
            }
        }
    }
}
__device__ __forceinline__ void s5_scan_items(const Params& p, int layer) {
    const int gtid = obid() * NTHR + otid(), GT = gridDim.x * NTHR;
    const float* __restrict__ S = (const float*)(p.ws + WS_S5S); bf16_t* __restrict__ HC = (bf16_t*)(p.ws + WS_HCAT);
    const float2* apow = (const float2*)(p.ws + WS_APOW);
    for (int it = gtid; it < NB * 16 * 128; it += GT) {
        const int kk = it & 127, g = (it >> 7) & 15, b = it >> 11; const int dir = kk >> 6, n = kk & 63;
        const float2 a32 = apow[(size_t)(((layer * 2 + dir) * 16 + g) * 64 + n) * 33 + 32];
        float hr = 0.f, hi = 0.f;
        for (int s0 = 0; s0 < CPB; s0 += 24) {
            float sr[24], si[24]; size_t ov[24];
#pragma unroll
            for (int k = 0; k < 24; ++k) { const int sidx = s0 + k;
                const int cr = dir == 0 ? sidx : (sidx < 8 ? 7 - sidx : (CPB + 7) - sidx);
                ov[k] = ((size_t)(b * CPB + cr) * 16 + g) * 256 + dir * 128 + n;
                sr[k] = S[ov[k]]; si[k] = S[ov[k] + 64]; }
#pragma unroll
            for (int k = 0; k < 24; ++k) {
                HC[ov[k]] = (bf16_t)f2bf(hr); HC[ov[k] + 64] = (bf16_t)f2bf(hi);
                const float nr = a32.x * hr - a32.y * hi + sr[k], ni = a32.x * hi + a32.y * hr + si[k]; hr = nr; hi = ni; }
        }
    }
}
__device__ __forceinline__ void phase_attn_s5b(const Params& p, int layer, LAS unsigned char* lds) {
    const int G = gridDim.x, bid = obid();
    const int vcu = (G % 8 == 0) ? (bid % 8) * (G / 8) + bid / 8 : bid;
    const int NCTX = (layer == 0) ? NB * 6 : 0;
    const float MA = ((const float*)(p.ws + WS_SCAL))[2 + layer], MB = ((const float*)(p.ws + WS_SCAL))[4 + layer];
    s5_scan_items(p, layer);
    {
        typedef attn_body::bf16 abf;
        const abf* P = (const abf*)(p.ws + WS_P); abf* MIX = (abf*)(p.ws + WS_MIX);
        for (int s = vcu; s < 256 + NCTX; s += G) {
            const int nk = s < 256 ? 3 : 1;
            for (int k = 0; k < nk; ++k) {
                int b, h, kvh, NT; size_t qrow;
                if (s < 256) { const int x = s >> 5; b = x >> 1; kvh = x & 1; h = 3 * kvh + k; qrow = (size_t)b * RPB + LC + (size_t)(s & 31) * 256; NT = RPB / 64; }
                else { const int f = s - 256; b = f / 6; h = f % 6; kvh = h / 3; qrow = (size_t)b * RPB; NT = LC / 64; }
                const size_t krow = (size_t)b * RPB;
                attn_body::attn_unit<8, 64, true>(P + qrow * INW + C_QA + h * 64, P + krow * INW + C_KA + kvh * 64, P + krow * INW + C_VA + kvh * 64, MIX + qrow * D + h * 64, D, NT, MA, (char*)lds);
            }
        }
    }
    {
        typedef attn_body::bf16 abf;
        const abf* P = (const abf*)(p.ws + WS_P); abf* OB = (abf*)(p.ws + WS_OB);
        const int NCTXB = (layer == 0) ? NB * 12 : 0;
        for (int s = vcu; s < 256 + NCTXB; s += G) {
            const int nk = s < 256 ? 6 : 1;
            for (int k = 0; k < nk; ++k) {
                int b, sh, NT; size_t qrow;
                if (s < 256) { const int combo = 3 * (s >> 5) + (k >> 1); b = combo / 6; sh = 2 * (combo % 6) + (k & 1); qrow = (size_t)b * RPB + LC + (size_t)(s & 31) * 256; NT = RPB / 64; }
                else { const int f = s - 256; b = f / 12; sh = f % 12; qrow = (size_t)b * RPB; NT = LC / 64; }
                const size_t krow = (size_t)b * RPB;
                attn_body::attn_unit<8, 32, true>(P + qrow * INW + C_QB + sh * 32, P + krow * INW + C_KB + sh * 32, P + krow * INW + C_VB + (sh >> 1) * 64, OB + qrow * 768 + sh * 64, 768, NT, MB, (char*)lds);
            }
        }
    }
}
__device__ __forceinline__ void phase_s5c(const Params& p, int layer, LAS unsigned char* lds) {
    const int tid = otid(), wave = tid >> 6, lane = tid & 63;
    const bf16_t* P = (const bf16_t*)(p.ws + WS_P); bf16_t* MIX = (bf16_t*)(p.ws + WS_MIX);
    {
        const int r32 = lane & 31, hi = lane >> 5;
        const bf16_t* KT = (const bf16_t*)(p.ws + WS_KT) + (size_t)layer * 16 * 63 * 256;
        const bf16_t* G2 = (const bf16_t*)(p.ws + WS_G2CAT) + (size_t)layer * 16 * 512 * 256;
        const bf16_t* HC = (const bf16_t*)(p.ws + WS_HCAT); bf16_t* Gb = (bf16_t*)(p.ws + WS_G);
        const int NBC = (int)gridDim.x >= 64 ? (int)gridDim.x / 64 : 1;
        for (int combo = obid() / NBC; combo < 64; combo += (int)gridDim.x / NBC) {
            const int g = combo >> 2, mq = combo & 3, sb = obid() % NBC;
            __syncthreads();
            {   const u32x4* ksrc = (const u32x4*)(KT + (size_t)(g * 63) * 256); u32x4 t[4];
#pragma unroll
                for (int q = 0; q < 4; ++q) { const int e = tid + q * NTHR; t[q] = e < 2016 ? ksrc[e] : (u32x4){0u, 0u, 0u, 0u}; }
#pragma unroll
                for (int q = 0; q < 4; ++q) { const int e = tid + q * NTHR; if (e < 2016) *(LAS u32x4*)(lds + e * 16) = t[q]; }
                const bf16_t* gsrc = G2 + (size_t)(g * 512 + mq * 128) * 256; u32x4 u[8];
#pragma unroll
                for (int q = 0; q < 8; ++q) { const int e = tid + q * NTHR; u[q] = *(const u32x4*)(gsrc + (size_t)(e >> 5) * 256 + (e & 31) * 8); }
#pragma unroll
                for (int q = 0; q < 8; ++q) { const int e = tid + q * NTHR; *(LAS u32x4*)(lds + 32768 + (e >> 5) * 528 + (e & 31) * 16) = u[q]; } }
            __syncthreads();
            for (int ct = sb * NWAVE + wave; ct < 33; ct += NBC * NWAVE) {
                const int gc = ct * 32 + r32, tok0 = 8 * mq + (r32 >> 4);
                f32x16_t acc[4];
#pragma unroll
                for (int mt = 0; mt < 4; ++mt) acc[mt] = (f32x16_t){0.f,0.f,0.f,0.f,0.f,0.f,0.f,0.f,0.f,0.f,0.f,0.f,0.f,0.f,0.f,0.f};
                const bf16_t* up = P + (size_t)(gc * 32) * INW + C_US + g * 16 + 8 * hi;
                const bf16_t* hp = HC + ((size_t)gc * 16 + g) * 256 + 8 * hi;
                const LAS unsigned char* ktl = lds + (tok0 + 31) * 512 + (r32 & 15) * 32 + 16 * hi;
                const LAS unsigned char* g2l = lds + 32768 + r32 * 528 + 16 * hi;
#define Y_LOAD(buf, k0) do { _Pragma("unroll") for (int i_ = 0; i_ < 12; ++i_) { constexpr int kk_ = (k0); const int k_ = kk_ + i_; \
            buf[i_] = k_ < 32 ? *(const bf16x8_t*)(up + (size_t)k_ * INW) : *(const bf16x8_t*)(hp + (k_ - 32) * 16); } } while (0)
#define Y_COMP(buf, k0) do { _Pragma("unroll") for (int i_ = 0; i_ < 12; ++i_) { constexpr int kk_ = (k0); const int k_ = kk_ + i_; \
            _Pragma("unroll") for (int mt = 0; mt < 4; ++mt) { const bf16x8_t av = k_ < 32 ? *(const LAS bf16x8_t*)(ktl + (2 * mt - k_) * 512) : *(const LAS bf16x8_t*)(g2l + mt * (32 * 528) + (k_ - 32) * 32); \
                acc[mt] = __builtin_amdgcn_mfma_f32_32x32x16_bf16(av, buf[i_], acc[mt], 0, 0, 0); } \
            __builtin_amdgcn_sched_barrier(0); } } while (0)
                bf16x8_t ua[12], ub[12];
                Y_LOAD(ua, 0); Y_LOAD(ub, 12);
                Y_COMP(ua, 0); Y_LOAD(ua, 24);
                Y_COMP(ub, 12); Y_LOAD(ub, 36);
                Y_COMP(ua, 24); Y_COMP(ub, 36);
#undef Y_LOAD
#undef Y_COMP
#pragma unroll
                for (int mt = 0; mt < 4; ++mt)
#pragma unroll
                    for (int io = 0; io < 2; ++io) {
                        bf16_t* gd = Gb + (size_t)(gc * 32 + 8 * mq + 2 * mt + io) * 256 + g * 16 + 4 * hi;
                        u32x2 w0, w1;
                        w0.x = pk2(gelu_tanh(acc[mt][8 * io + 0]), gelu_tanh(acc[mt][8 * io + 1])); w0.y = pk2(gelu_tanh(acc[mt][8 * io + 2]), gelu_tanh(acc[mt][8 * io + 3]));
                        w1.x = pk2(gelu_tanh(acc[mt][8 * io + 4]), gelu_tanh(acc[mt][8 * io + 5])); w1.y = pk2(gelu_tanh(acc[mt][8 * io + 6]), gelu_tanh(acc[mt][8 * io + 7]));
                        *(u32x2*)gd = w0; *(u32x2*)(gd + 8) = w1;
                    }
            }
        }
    }
    const float lam = ((const float*)(p.ws + WS_SCAL))[layer], lam_init = 0.8f - 0.6f * expf(-0.3f * (float)layer);
    const int hp = (lane >> 3) < 6 ? (lane >> 3) : 5, d0 = (lane & 7) * 8;
    float sg[8];
#pragma unroll
    for (int i = 0; i < 8; ++i) sg[i] = p.in[18][layer * 64 + d0 + i] * (1.f - lam_init);
    const int nq = (layer ? NB * L : ROWS) / 4;
    for (int qi = obid() * NWAVE + wave; qi < nq; qi += gridDim.x * NWAVE) {
        const int r0 = layer ? (qi >> 11) * RPB + LC + (qi & 2047) * 4 : qi * 4;
        const bf16_t* ob = (const bf16_t*)(p.ws + WS_OB) + (size_t)r0 * 768 + hp * 128 + d0;
        u32x4 w1[4], w2[4];
#pragma unroll
        for (int k = 0; k < 4; ++k) { w1[k] = *(const u32x4*)(ob + (size_t)k * 768); w2[k] = *(const u32x4*)(ob + (size_t)k * 768 + 64); }
#pragma unroll
        for (int k = 0; k < 4; ++k) {
            const unsigned a1[4] = {w1[k].x, w1[k].y, w1[k].z, w1[k].w}, a2[4] = {w2[k].x, w2[k].y, w2[k].z, w2[k].w};
            float v[8]; float ss = 0.f;
#pragma unroll
            for (int q = 0; q < 4; ++q) { v[2 * q] = bf2f(a1[q] & 0xffffu) - lam * bf2f(a2[q] & 0xffffu); v[2 * q + 1] = bf2f(a1[q] >> 16) - lam * bf2f(a2[q] >> 16); ss += v[2 * q] * v[2 * q] + v[2 * q + 1] * v[2 * q + 1]; }
            ss += __int_as_float(__builtin_amdgcn_update_dpp(0, __float_as_int(ss), 0xB1, 0xf, 0xf, true));
            ss += __int_as_float(__builtin_amdgcn_update_dpp(0, __float_as_int(ss), 0x4E, 0xf, 0xf, true));
            {   const float t7 = __int_as_float(__builtin_amdgcn_update_dpp(0, __float_as_int(ss), 0x141, 0xf, 0xf, true));
                ss += __int_as_float(__builtin_amdgcn_update_dpp(0, __float_as_int(t7), 0x1B, 0xf, 0xf, true)); }
            const float rinv = 1.f / sqrtf(ss * (1.f / 64.f) + EPS);
            u32x4 o; o.x = pk2(v[0] * rinv * sg[0], v[1] * rinv * sg[1]); o.y = pk2(v[2] * rinv * sg[2], v[3] * rinv * sg[3]); o.z = pk2(v[4] * rinv * sg[4], v[5] * rinv * sg[5]); o.w = pk2(v[6] * rinv * sg[6], v[7] * rinv * sg[7]);
            if (lane < 48) *(u32x4*)(MIX + (size_t)(r0 + k) * D + 384 + hp * 64 + d0) = o;
        }
    }
}
__device__ __forceinline__ void phase_glu(const Params& p, int layer, LAS unsigned char* lds) {
    const int tid = otid(), wave = tid >> 6, lane = tid & 63, r32 = lane & 31, hi = lane >> 5;
    const bf16_t* Gb = (const bf16_t*)(p.ws + WS_G); bf16_t* MIX = (bf16_t*)(p.ws + WS_MIX);
    const bf16_t* WT = (const bf16_t*)(p.ws + WS_WGLU_T) + (size_t)layer * 256 * 256;
    __syncthreads();
    for (int e = tid; e < 256 * 32; e += NTHR) { const int row = e >> 5, c16 = e & 31; *(LAS u32x4*)(lds + row * 528 + c16 * 16) = *(const u32x4*)(WT + (size_t)row * 256 + c16 * 8); }
    __syncthreads();
    for (int it = obid() * NWAVE + wave; it < NCH * 2; it += gridDim.x * NWAVE) {
        const int jh = it & 1, tt = it >> 1;
        if (layer == 1 && ((tt * 32) % RPB) < LC) continue;
        const size_t row = (size_t)tt * 32 + r32;
        f32x16_t acc[4];
#pragma unroll
        for (int mt = 0; mt < 4; ++mt) acc[mt] = (f32x16_t){0.f,0.f,0.f,0.f,0.f,0.f,0.f,0.f,0.f,0.f,0.f,0.f,0.f,0.f,0.f,0.f};
        const bf16_t* gp = Gb + row * 256 + 8 * hi;
        bf16x8_t bv[16];
#pragma unroll
        for (int kb = 0; kb < 16; ++kb) bv[kb] = *(const bf16x8_t*)(gp + kb * 16);
        u32x2 gw[16];
#pragma unroll
        for (int mt = 0; mt < 4; ++mt)
#pragma unroll
            for (int rq = 0; rq < 4; ++rq) gw[4 * mt + rq] = *(const u32x2*)(Gb + row * 256 + 128 * jh + 32 * mt + 8 * rq + 4 * hi);
        const LAS unsigned char* wl = lds + (128 * jh + r32) * 528 + 16 * hi;
#pragma unroll
        for (int kb = 0; kb < 16; ++kb) {
#pragma unroll
            for (int mt = 0; mt < 4; ++mt) { const bf16x8_t av = *(const LAS bf16x8_t*)(wl + mt * (32 * 528) + kb * 32); acc[mt] = __builtin_amdgcn_mfma_f32_32x32x16_bf16(av, bv[kb], acc[mt], 0, 0, 0); }
            __builtin_amdgcn_sched_barrier(0);
        }
#pragma unroll
        for (int mt = 0; mt < 4; ++mt)
#pragma unroll
            for (int rq = 0; rq < 4; ++rq) {
                const int jj = 128 * jh + 32 * mt + 8 * rq + 4 * hi;
                const u32x2 g2 = gw[4 * mt + rq];
                const float o0 = bf2f(g2.x & 0xffffu) * __builtin_amdgcn_rcpf(1.f + __builtin_amdgcn_exp2f(-LOG2E * acc[mt][4 * rq + 0]));
                const float o1 = bf2f(g2.x >> 16) * __builtin_amdgcn_rcpf(1.f + __builtin_amdgcn_exp2f(-LOG2E * acc[mt][4 * rq + 1]));
                const float o2 = bf2f(g2.y & 0xffffu) * __builtin_amdgcn_rcpf(1.f + __builtin_amdgcn_exp2f(-LOG2E * acc[mt][4 * rq + 2]));
                const float o3 = bf2f(g2.y >> 16) * __builtin_amdgcn_rcpf(1.f + __builtin_amdgcn_exp2f(-LOG2E * acc[mt][4 * rq + 3]));
                u32x2 w; w.x = pk2(o0, o1); w.y = pk2(o2, o3);
                *(u32x2*)(MIX + row * D + 768 + jj) = w;
            }
    }
}
__device__ __forceinline__ void phase_peer_conv(const Params& p, int layer) {
    const int gtid = obid() * NTHR + otid(), GT = gridDim.x * NTHR;
    const float* U = p.in[30] + (size_t)layer * 16384 * D; const float* V = p.in[31] + (size_t)layer * 16384 * D;
    u32x4* U8 = (u32x4*)(p.ws + WS_U8); u32x4* V8 = (u32x4*)(p.ws + WS_V8);
    for (int it = gtid; it < 2 * 16384 * 64; it += GT) {
        const bool isv = it >= 16384 * 64; const int e = isv ? it - 16384 * 64 : it;
        const f32x4* src = (const f32x4*)((isv ? V : U) + (size_t)e * 16); const float sc = isv ? 1.f : 256.f;
        u32x4 o; unsigned w[4];
#pragma unroll
        for (int q = 0; q < 4; ++q) { const f32x4 v = src[q]; int t = __builtin_amdgcn_cvt_pk_fp8_f32(v.x * sc, v.y * sc, 0, false); t = __builtin_amdgcn_cvt_pk_fp8_f32(v.z * sc, v.w * sc, t, true); w[q] = (unsigned)t; }
        o.x = w[0]; o.y = w[1]; o.z = w[2]; o.w = w[3];
        (isv ? V8 : U8)[(size_t)((e & 63) >> 3) * (16384 * 8) + (size_t)(e >> 6) * 8 + (e & 7)] = o;
    }
}
__device__ __forceinline__ float vmaxf(float a, float b) { float r; asm("v_max_f32_e32 %0, %1, %2" : "=v"(r) : "v"(a), "v"(b)); return r; }
__device__ __forceinline__ float vminf(float a, float b) { float r; asm("v_min_f32_e32 %0, %1, %2" : "=v"(r) : "v"(a), "v"(b)); return r; }
#define PK_INSERT(tv, v_) do { float _v = (v_); _Pragma("unroll") for (int _k = 0; _k < 16; ++_k) { const float _h = vmaxf(tv[_k], _v); _v = vminf(tv[_k], _v); tv[_k] = _h; } } while (0)
#define SN_CE(a, b) do { const float _h = vmaxf(a, b); b = vminf(a, b); a = _h; } while (0)
__device__ __forceinline__ void sort16_desc(float (&x)[16]) { SN_CE(x[0], x[1]); SN_CE(x[2], x[3]); SN_CE(x[0], x[2]); SN_CE(x[1], x[3]); SN_CE(x[1], x[2]); SN_CE(x[4], x[5]); SN_CE(x[6], x[7]); SN_CE(x[4], x[6]); SN_CE(x[5], x[7]); SN_CE(x[5], x[6]); SN_CE(x[0], x[4]); SN_CE(x[2], x[6]); SN_CE(x[2], x[4]); SN_CE(x[1], x[5]); SN_CE(x[3], x[7]); SN_CE(x[3], x[5]); SN_CE(x[1], x[2]); SN_CE(x[3], x[4]); SN_CE(x[5], x[6]); SN_CE(x[8], x[9]); SN_CE(x[10], x[11]); SN_CE(x[8], x[10]); SN_CE(x[9], x[11]); SN_CE(x[9], x[10]); SN_CE(x[12], x[13]); SN_CE(x[14], x[15]); SN_CE(x[12], x[14]); SN_CE(x[13], x[15]); SN_CE(x[13], x[14]); SN_CE(x[8], x[12]); SN_CE(x[10], x[14]); SN_CE(x[10], x[12]); SN_CE(x[9], x[13]); SN_CE(x[11], x[15]); SN_CE(x[11], x[13]); SN_CE(x[9], x[10]); SN_CE(x[11], x[12]); SN_CE(x[13], x[14]); SN_CE(x[0], x[8]); SN_CE(x[4], x[12]); SN_CE(x[4], x[8]); SN_CE(x[2], x[10]); SN_CE(x[6], x[14]); SN_CE(x[6], x[10]); SN_CE(x[2], x[4]); SN_CE(x[6], x[8]); SN_CE(x[10], x[12]); SN_CE(x[1], x[9]); SN_CE(x[5], x[13]); SN_CE(x[5], x[9]); SN_CE(x[3], x[11]); SN_CE(x[7], x[15]); SN_CE(x[7], x[11]); SN_CE(x[3], x[5]); SN_CE(x[7], x[9]); SN_CE(x[11], x[13]); SN_CE(x[1], x[2]); SN_CE(x[3], x[4]); SN_CE(x[5], x[6]); SN_CE(x[7], x[8]); SN_CE(x[9], x[10]); SN_CE(x[11], x[12]); SN_CE(x[13], x[14]); }
__device__ __forceinline__ void merge16_desc(float (&a)[16], const float (&b)[16]) {
#pragma unroll
    for (int i = 0; i < 16; ++i) a[i] = vmaxf(a[i], b[15 - i]);
#pragma unroll
    for (int i = 0; i < 8; ++i) SN_CE(a[i], a[i + 8]);
#pragma unroll
    for (int i = 0; i < 16; ++i) if ((i & 4) == 0) SN_CE(a[i], a[i + 4]);
#pragma unroll
    for (int i = 0; i < 16; ++i) if ((i & 2) == 0) SN_CE(a[i], a[i + 2]);
#pragma unroll
    for (int i = 0; i < 16; i += 2) SN_CE(a[i], a[i + 1]);
}
__device__ __forceinline__ void phase_peer_sel(const Params& p, int layer, LAS unsigned char* lds) {
    const int tid = otid(), wave = tid >> 6, lane = tid & 63, r32 = lane & 31, hi = lane >> 5;
    const bf16_t* Qp = (const bf16_t*)(p.ws + WS_P);
    const bf16_t* K16 = (const bf16_t*)(p.ws + WS_KEYS16) + (size_t)layer * 16 * 128 * 128;
    unsigned* SEL = (unsigned*)(p.ws + WS_SEL);
    const int hd = obid() & 7, bsub = obid() >> 3, nbs = ((int)gridDim.x + 7 - hd) >> 3;
    LAS unsigned char* lrow = lds + 2 * 34816 + wave * 1024 + r32 * 32;
    __syncthreads();
    {   u32x4 t[8];
#pragma unroll
        for (int q = 0; q < 8; ++q) { const int e = tid + q * NTHR; t[q] = *(const u32x4*)(K16 + (size_t)(2 * hd) * 128 * 128 + (size_t)e * 8); }
#pragma unroll
        for (int q = 0; q < 8; ++q) { const int e = tid + q * NTHR; *(LAS u32x4*)(lds + (e >> 11) * 34816 + ((e >> 4) & 127) * 272 + (e & 15) * 16) = t[q]; } }
    __syncthreads();
    const int nunit = layer ? NB * L / 32 : ROWS / 32;
    constexpr unsigned char PA[50] = {0,0,0,0,0,0,0,0,0,0,0,0,0,0,0,0,1,1,1,1,1,1,1,1,2,2,2,2,2,3,3,3,3,4,4,4,5,5,6,6,7,7,8,9,10,11,12,13,14,15};
    constexpr unsigned char PB[50] = {0,1,2,3,4,5,6,7,8,9,10,11,12,13,14,15,0,1,2,3,4,5,6,7,0,1,2,3,4,0,1,2,3,0,1,2,0,1,0,1,0,1,0,0,0,0,0,0,0,0};
#define SEL_QROW(u_) ((layer ? ((u_) >> 8) * RPB + LC + ((u_) & 255) * 32 : (u_) * 32) + r32)
#define SEL_QLOAD(dst, u_, hs_) do { const bf16_t* qp_ = Qp + (size_t)SEL_QROW(u_) * INW + (2 * hd + (hs_)) * 128 + hi * 8; _Pragma("unroll") for (int ks_ = 0; ks_ < 8; ++ks_) dst[ks_] = *(const bf16x8_t*)(qp_ + ks_ * 16); } while (0)
    bf16x8_t qn[2][8];
#pragma unroll
    for (int ks = 0; ks < 8; ++ks) { qn[0][ks] = (bf16x8_t){0, 0, 0, 0, 0, 0, 0, 0}; qn[1][ks] = qn[0][ks]; }
    if (bsub * NWAVE + wave < nunit) { SEL_QLOAD(qn[0], bsub * NWAVE + wave, 0); SEL_QLOAD(qn[1], bsub * NWAVE + wave, 1); }
    for (int u = bsub * NWAVE + wave; u < nunit; u += nbs * NWAVE) {
        const int row = SEL_QROW(u);
        float L1[16], L2[16];
#pragma unroll
        for (int hs = 0; hs < 2; ++hs) {
            f32x16_t acc[4];
#pragma unroll
            for (int mt = 0; mt < 4; ++mt) {
                acc[mt] = (f32x16_t){0.f,0.f,0.f,0.f,0.f,0.f,0.f,0.f,0.f,0.f,0.f,0.f,0.f,0.f,0.f,0.f};
#pragma unroll
                for (int ks = 0; ks < 8; ++ks) { const bf16x8_t a = *(const LAS bf16x8_t*)(lds + hs * 34816 + (mt * 32 + r32) * 272 + ks * 32 + hi * 16);
                    acc[mt] = __builtin_amdgcn_mfma_f32_32x32x16_bf16(a, qn[hs][ks], acc[mt], 0, 0, 0); }
            }
            if (u + nbs * NWAVE < nunit) SEL_QLOAD(qn[hs], u + nbs * NWAVE, hs);
            float c0[16], c1[16], c2[16], c3[16];
#pragma unroll
            for (int r = 0; r < 16; ++r) { const unsigned n = (unsigned)((r & 3) + 8 * (r >> 2)) + 4u * (unsigned)hi;
                c0[r] = __uint_as_float((__float_as_uint(acc[0][r]) & ~127u) | n); c1[r] = __uint_as_float((__float_as_uint(acc[1][r]) & ~127u) | (n + 32u));
                c2[r] = __uint_as_float((__float_as_uint(acc[2][r]) & ~127u) | (n + 64u)); c3[r] = __uint_as_float((__float_as_uint(acc[3][r]) & ~127u) | (n + 96u)); }
            sort16_desc(c0); sort16_desc(c1); sort16_desc(c2); sort16_desc(c3);
            merge16_desc(c0, c1); merge16_desc(c2, c3); merge16_desc(c0, c2);
            float pv[16];
#pragma unroll
            for (int k = 0; k < 16; ++k) pv[k] = __shfl_xor(c0[k], 32);
            merge16_desc(c0, pv);
#pragma unroll
            for (int k = 0; k < 16; ++k) { if (hs == 0) L1[k] = c0[k]; else L2[k] = c0[k]; }
        }
        {   unsigned wa[4], wb[4];
#pragma unroll
            for (int q = 0; q < 4; ++q) { wa[q] = 0u; wb[q] = 0u;
#pragma unroll
                for (int jb = 0; jb < 4; ++jb) { wa[q] |= (__float_as_uint(L1[4 * q + jb]) & 127u) << (8 * jb); wb[q] |= (__float_as_uint(L2[4 * q + jb]) & 127u) << (8 * jb); } }
            u32x4 w4; w4.x = hi ? wb[0] : wa[0]; w4.y = hi ? wb[1] : wa[1]; w4.z = hi ? wb[2] : wa[2]; w4.w = hi ? wb[3] : wa[3];
            *(LAS u32x4*)(lrow + hi * 16) = w4; }
        float cv[16], cw[16];
#pragma unroll
        for (int k = 0; k < 16; ++k) cw[k] = -3.0e38f;
#pragma unroll
        for (int i = 0; i < 25; ++i) {
            const int a0 = PA[2 * i], b0 = PB[2 * i], a1 = PA[2 * i + 1], b1 = PB[2 * i + 1];
            const float s0 = L1[a0] + L2[b0], s1 = L1[a1] + L2[b1];
            const unsigned k0 = (__float_as_uint(s0) & ~255u) | (unsigned)(a0 * 16 + b0), k1 = (__float_as_uint(s1) & ~255u) | (unsigned)(a1 * 16 + b1);
            const float kv = __uint_as_float(hi ? k1 : k0);
            if (i < 16) cv[i] = kv; else cw[i - 16] = kv;
        }
        sort16_desc(cv); sort16_desc(cw); merge16_desc(cv, cw);
        {   float pv[16];
#pragma unroll
            for (int k = 0; k < 16; ++k) pv[k] = __shfl_xor(cv[k], 32);
            merge16_desc(cv, pv); }
        float e[16], den = 0.f;
#pragma unroll
        for (int k = 0; k < 16; ++k) { e[k] = __expf(cv[k] - cv[0]); den += e[k]; }
        const float rd = 1.f / den;
        asm volatile("s_waitcnt lgkmcnt(0)" ::: "memory");
        unsigned wd[8];
#pragma unroll
        for (int k = 0; k < 8; ++k) {
            float cv_lo = cv[k], cv_hi = cv[8 + k], e_lo = e[k], e_hi = e[8 + k]; asm volatile("" : "+v"(cv_lo), "+v"(cv_hi), "+v"(e_lo), "+v"(e_hi));
            const unsigned code = __float_as_uint(hi ? cv_hi : cv_lo) & 255u; const float gk = (hi ? e_hi : e_lo) * rd;
            const unsigned i1 = lrow[code >> 4], i2 = lrow[16 + (code & 15u)];
            wd[k] = (i1 * 128u + i2) | (f2bf(gk) << 16);
        }
        u32x4 o0, o1; o0.x = wd[0]; o0.y = wd[1]; o0.z = wd[2]; o0.w = wd[3]; o1.x = wd[4]; o1.y = wd[5]; o1.z = wd[6]; o1.w = wd[7];
        unsigned* dst = SEL + (size_t)row * 128 + 2 * hd + hi;
        dst[0] = o0.x; dst[16] = o0.y; dst[32] = o0.z; dst[48] = o0.w; dst[64] = o1.x; dst[80] = o1.y; dst[96] = o1.z; dst[112] = o1.w;
    }
}
__device__ __forceinline__ float red16(const float (&x)[16], int lane) {
    float y[8], z[4], w2[2];
    {   const bool bt = (lane >> 3) & 1;
#pragma unroll
        for (int j = 0; j < 8; ++j) { const float keep = bt ? x[j + 8] : x[j], send = bt ? x[j] : x[j + 8]; y[j] = keep + __shfl_xor(send, 8); } }
    {   const bool bt = (lane >> 2) & 1;
#pragma unroll
        for (int j = 0; j < 4; ++j) { const float keep = bt ? y[j + 4] : y[j], send = bt ? y[j] : y[j + 4]; z[j] = keep + __shfl_xor(send, 4); } }
    {   const bool bt = (lane >> 1) & 1;
#pragma unroll
        for (int j = 0; j < 2; ++j) { const float keep = bt ? z[j + 2] : z[j], send = bt ? z[j] : z[j + 2]; w2[j] = keep + __shfl_xor(send, 2); } }
    const bool bt = lane & 1;
    float v = (bt ? w2[1] : w2[0]) + __shfl_xor(bt ? w2[0] : w2[1], 1);
    v += __shfl_xor(v, 16); v += __shfl_xor(v, 32);
    return v;
}

__device__ __forceinline__ int peer_row(int layer, int li) { return layer == 0 ? li : (li >> 13) * RPB + LC + (li & 8191); }
template <int CTRL> __device__ __forceinline__ float dppx(float x) { return __int_as_float(__builtin_amdgcn_update_dpp(0, __float_as_int(x), CTRL, 0xf, 0xf, true)); }
template <int WHICH> __device__ __forceinline__ void phase_peer_slice(const Params& p, int layer, LAS unsigned char* lds) {
    const int tid = otid(), wave = tid >> 6, lane = tid & 63, G = gridDim.x, bid = obid();
    const int sub = lane >> 3, c8 = lane & 7, cb = c8 * 16;
    const int rstart = bid * NWAVE + wave, rstep = G * NWAVE, nrows = layer ? NB * L : ROWS;
    const unsigned* SEL = (const unsigned*)(p.ws + WS_SEL);
    const bf16_t* H = (const bf16_t*)(p.ws + WS_H);
    LAS float* AC = (LAS float*)lds + wave * (24 * 128);
    float* W = (float*)(p.ws + WS_OB);
    const float* X = (const float*)(p.ws + WS_X);
    const float* mod = (const float*)(p.ws + WS_MOD) + (size_t)layer * 5 * 6144;
    const unsigned char* T8 = p.ws + (WHICH ? WS_V8 : WS_U8);
    const int xcc = (int)(xb_xcc_id() & 7u);
    const int colo = cb + ((lane >> 5) & 1) * 8 + ((lane >> 4) & 1) * 4 + ((lane >> 3) & 1) * 2;
    for (int pk = 0; pk < 8; ++pk) {
        const int part = (xcc + pk) & 7; const unsigned char* Tp = T8 + (size_t)part * (16384 * 128); const int col = part * 128 + colo;
        u32x4 sn[4]; u32x4 an[4]; f32x2 xn = {0.f, 0.f}, gn = {0.f, 0.f};
#pragma unroll
        for (int q = 0; q < 4; ++q) { sn[q] = (u32x4){0u, 0u, 0u, 0u}; an[q] = sn[q]; }
        if (rstart < nrows) { const int r = peer_row(layer, rstart);
#pragma unroll
            for (int q = 0; q < 4; ++q) sn[q] = *(const u32x4*)(SEL + (size_t)r * 128 + sub * 16 + 4 * q);
            if (WHICH == 0) { an[0] = *(const u32x4*)(H + (size_t)r * D + part * 128 + cb); an[1] = *(const u32x4*)(H + (size_t)r * D + part * 128 + cb + 8); }
            else {
#pragma unroll
                for (int q = 0; q < 4; ++q) an[q] = *(const u32x4*)(W + (size_t)r * 128 + sub * 16 + 4 * q);
                const int b = r / RPB, jr = r - b * RPB; xn = *(const f32x2*)(X + (size_t)r * D + col); gn = *(const f32x2*)(mod + (size_t)(jr < LC ? 4 : b) * 6144 + 5 * D + col); } }
        for (int li = rstart; li < nrows; li += rstep) {
            const int r = peer_row(layer, li);
            u32x4 sc[4], ac[4]; const f32x2 xv = xn, gv = gn;
#pragma unroll
            for (int q = 0; q < 4; ++q) { sc[q] = sn[q]; ac[q] = an[q]; }
            u32x4 buf[16];
#pragma unroll
            for (int t = 0; t < 16; ++t) buf[t] = *(const u32x4*)(Tp + (((sc[t >> 2][t & 3] & 0x3fffu) << 7) | (unsigned)cb));
            if (li + rstep < nrows) { const int rn = peer_row(layer, li + rstep);
#pragma unroll
                for (int q = 0; q < 4; ++q) sn[q] = *(const u32x4*)(SEL + (size_t)rn * 128 + sub * 16 + 4 * q);
                if (WHICH == 0) { an[0] = *(const u32x4*)(H + (size_t)rn * D + part * 128 + cb); an[1] = *(const u32x4*)(H + (size_t)rn * D + part * 128 + cb + 8); }
                else {
#pragma unroll
                    for (int q = 0; q < 4; ++q) an[q] = *(const u32x4*)(W + (size_t)rn * 128 + sub * 16 + 4 * q);
                    const int b = rn / RPB, jr = rn - b * RPB; xn = *(const f32x2*)(X + (size_t)rn * D + col); gn = *(const f32x2*)(mod + (size_t)(jr < LC ? 4 : b) * 6144 + 5 * D + col); } }
            if (WHICH == 0) {
                f32x2 hp[8];
                {   const unsigned hw[8] = {ac[0].x, ac[0].y, ac[0].z, ac[0].w, ac[1].x, ac[1].y, ac[1].z, ac[1].w};
#pragma unroll
                    for (int q = 0; q < 8; ++q) hp[q] = (f32x2){bf2f(hw[q] & 0xffffu), bf2f(hw[q] >> 16)}; }
                float pv[16];
#pragma unroll
                for (int t = 0; t < 16; ++t) {
                    const unsigned ww[4] = {buf[t].x, buf[t].y, buf[t].z, buf[t].w}; f32x2 a2 = {0.f, 0.f};
#pragma unroll
                    for (int q = 0; q < 4; ++q) { a2 += __builtin_amdgcn_cvt_pk_f32_fp8((int)ww[q], false) * hp[2 * q]; a2 += __builtin_amdgcn_cvt_pk_f32_fp8((int)ww[q], true) * hp[2 * q + 1]; }
                    pv[t] = a2.x + a2.y;
                }
#pragma unroll
                for (int t = 0; t < 16; ++t) pv[t] += dppx<0xB1>(pv[t]);
#pragma unroll
                for (int t = 0; t < 16; ++t) pv[t] += dppx<0x4E>(pv[t]);
#pragma unroll
                for (int t = 0; t < 16; ++t) pv[t] += dppx<0x1B>(dppx<0x141>(pv[t]));
                float k0 = 0.f, k1 = 0.f;
#pragma unroll
                for (int t = 0; t < 8; ++t) { k0 = (c8 == t) ? pv[t] : k0; k1 = (c8 == t) ? pv[t + 8] : k1; }
                LAS float* ac = AC + ((li - rstart) / rstep) * 128 + sub * 16 + c8;
                if (pk == 0) { ac[0] = k0; ac[8] = k1; } else { ac[0] += k0; ac[8] += k1; }
            } else {
                f32x2 acc[8];
#pragma unroll
                for (int q = 0; q < 8; ++q) acc[q] = (f32x2){0.f, 0.f};
#pragma unroll
                for (int t = 0; t < 16; ++t) { const float we = __uint_as_float(ac[t >> 2][t & 3]); const f32x2 w2 = {we, we};
                    const unsigned ww[4] = {buf[t].x, buf[t].y, buf[t].z, buf[t].w};
#pragma unroll
                    for (int q = 0; q < 4; ++q) { acc[2 * q] += w2 * __builtin_amdgcn_cvt_pk_f32_fp8((int)ww[q], false); acc[2 * q + 1] += w2 * __builtin_amdgcn_cvt_pk_f32_fp8((int)ww[q], true); } }
                float a8[8], a4[4], a2[2];
                {   const bool bt = (lane >> 5) & 1;
#pragma unroll
                    for (int k = 0; k < 8; ++k) { const float lo = acc[k >> 1][k & 1], hi = acc[4 + (k >> 1)][k & 1]; const float keep = bt ? hi : lo, send = bt ? lo : hi;
                        const auto rr = __builtin_amdgcn_permlane32_swap(__float_as_uint(send), __float_as_uint(send), false, false); a8[k] = keep + __uint_as_float(bt ? rr[0] : rr[1]); } }
                {   const bool bt = (lane >> 4) & 1;
#pragma unroll
                    for (int k = 0; k < 4; ++k) { const float keep = bt ? a8[k + 4] : a8[k], send = bt ? a8[k] : a8[k + 4];
                        const auto rr = __builtin_amdgcn_permlane16_swap(__float_as_uint(send), __float_as_uint(send), false, false); a4[k] = keep + __uint_as_float(bt ? rr[0] : rr[1]); } }
                {   const bool bt = (lane >> 3) & 1;
#pragma unroll
                    for (int k = 0; k < 2; ++k) { const float keep = bt ? a4[k + 2] : a4[k], send = bt ? a4[k] : a4[k + 2]; a2[k] = keep + dppx<0x128>(send); } }
                const int b = r / RPB, jr = r - b * RPB;
                f32x2 o; o.x = xv.x + gv.x * a2[0]; o.y = xv.y + gv.y * a2[1];
                float* orow = (layer == 0) ? (float*)(p.ws + WS_X) + (size_t)r * D + col : p.out + ((size_t)b * L + (jr - LC)) * D + col;
                *(f32x2*)orow = o;
            }
        }
    }
    if (WHICH == 0) {
        asm volatile("s_waitcnt lgkmcnt(0)" ::: "memory");
        for (int li = rstart; li < nrows; li += rstep) { const int r = peer_row(layer, li); const LAS float* ac = AC + ((li - rstart) / rstep) * 128;
#pragma unroll
            for (int hf = 0; hf < 2; ++hf) { const int pos = hf * 64 + lane; const float wv = bf2f(SEL[(size_t)r * 128 + pos] >> 16) * gelu_tanh(ac[pos] * (1.f / 256.f));
                W[(size_t)r * 128 + pos] = wv;
                const float ws = wv * 64.f; const int hi8 = __builtin_amdgcn_cvt_pk_fp8_f32(ws, 0.f, 0, false) & 0xff; const f32x2 fh = __builtin_amdgcn_cvt_pk_f32_fp8(hi8, false);
                const int lo8 = __builtin_amdgcn_cvt_pk_fp8_f32(ws - fh.x, 0.f, 0, false) & 0xff;
                unsigned char* rec = (unsigned char*)(p.ws + WS_OB) + 20 * MiB + (size_t)r * 512;
                ((unsigned short*)rec)[pos] = (unsigned short)(SEL[(size_t)r * 128 + pos] & 0x3fffu); rec[256 + pos] = (unsigned char)hi8; rec[384 + pos] = (unsigned char)lo8; } }
    }
}

typedef int v2i_t __attribute__((ext_vector_type(2)));
__device__ __forceinline__ void dma16(const void* gsrc, LAS void* dst) { unsigned keep; const unsigned d = (unsigned)__builtin_amdgcn_readfirstlane((int)(unsigned)(uintptr_t)dst);
    asm volatile("s_mov_b32 %0, m0\n\ts_mov_b32 m0, %2\n\ts_nop 0\n\tglobal_load_lds_dwordx4 %1, off\n\ts_mov_b32 m0, %0" : "=&s"(keep) : "v"(gsrc), "s"(d) : "memory"); }
__device__ __forceinline__ void dma4(const void* gsrc, LAS void* dst) { unsigned keep; const unsigned d = (unsigned)__builtin_amdgcn_readfirstlane((int)(unsigned)(uintptr_t)dst);
    asm volatile("s_mov_b32 %0, m0\n\ts_mov_b32 m0, %2\n\ts_nop 0\n\tglobal_load_lds_dword %1, off\n\ts_mov_b32 m0, %0" : "=&s"(keep) : "v"(gsrc), "s"(d) : "memory"); }
__device__ __forceinline__ void phase_peer_v_mfma(const Params& p, int layer, LAS unsigned char* lds) {
    const int tid = otid(), wave = tid >> 6, lane = tid & 63, G = gridDim.x, bid = obid();
    const int m16 = lane & 15, g = lane >> 4, sub = lane >> 3, c8 = lane & 7, q = m16 >> 1, pp = m16 & 1;
    const int rstart = bid * NWAVE + wave, rstep = G * NWAVE, nrows = layer ? NB * L : ROWS;
    const int nv = rstart < nrows ? (nrows - rstart + rstep - 1) / rstep : 0;
    const unsigned char* REC = p.ws + WS_OB + 20 * MiB;
    const float* X = (const float*)(p.ws + WS_X);
    const float* mod = (const float*)(p.ws + WS_MOD) + (size_t)layer * 5 * 6144;
    LAS unsigned char* HB = lds + wave * 19456;
    LAS unsigned char* ST = HB + 16384;
    LAS float* GT = (LAS float*)(lds + 8 * 19456);
    const int xcc = (int)(xb_xcc_id() & 7u);
#define PV_ROW(v) peer_row(layer, rstart + ((v) < nv ? (v) : nv - 1) * rstep)
#define PV_SMALL(v) do { const int r_ = PV_ROW(v); LAS unsigned char* st_ = ST + ((v) % 3) * 1024; const unsigned char* rc_ = REC + (size_t)r_ * 512; const float* xr_ = X + (size_t)r_ * D + part * 128; \
        dma4(rc_ + 4 * lane, st_); dma4(rc_ + 256 + 4 * lane, st_ + 256); dma4(xr_ + lane, st_ + 512); dma4(xr_ + 64 + lane, st_ + 768); } while (0)
#define PV_HALF(v, hf) do { const LAS unsigned short* ix_ = (const LAS unsigned short*)(ST + ((v) % 3) * 1024); \
        _Pragma("unroll") for (int t_ = 0; t_ < 8; ++t_) { const unsigned idx_ = ix_[64 * (hf) + 8 * t_ + sub]; \
            dma16(Tp + (size_t)idx_ * 128 + ((c8 ^ sub) * 16), HB + (hf) * 8192 + t_ * 1024); } } while (0)
#define PV_COMP(v, hf) do { const LAS unsigned char* st_ = ST + ((v) % 3) * 1024; const LAS unsigned char* rb_ = HB + (hf) * 8192 + (8 * g + q) * 128 + 8 * pp; \
        _Pragma("unroll") for (int k2_ = 0; k2_ < 2; ++k2_) { const int ks_ = 2 * (hf) + k2_; \
            const long hi_ = *(const LAS long*)(st_ + 256 + 32 * ks_ + 8 * g), lo_ = *(const LAS long*)(st_ + 384 + 32 * ks_ + 8 * g); const long af_ = m16 == 0 ? hi_ : (m16 == 1 ? lo_ : 0l); \
            v2i_t bq_[8]; _Pragma("unroll") for (int j_ = 0; j_ < 8; ++j_) bq_[j_] = __builtin_amdgcn_ds_read_tr8_b64_v2i32((LAS v2i_t*)(rb_ + k2_ * 4096 + ((j_ ^ q) * 16))); \
            _Pragma("unroll") for (int j_ = 0; j_ < 8; ++j_) { const long bl_ = (long)(((unsigned long long)(unsigned)bq_[j_].y << 32) | (unsigned long long)(unsigned)bq_[j_].x); \
                acc[j_] = __builtin_amdgcn_mfma_f32_16x16x32_fp8_fp8(af_, bl_, acc[j_], 0, 0, 0); } } } while (0)
    for (int pk = 0; pk < 8; ++pk) {
        const int part = (xcc + pk) & 7; const unsigned char* Tp = p.ws + WS_V8 + (size_t)part * (16384 * 128);
        __syncthreads();
        for (int e = tid; e < 5 * 128; e += NTHR) GT[e] = mod[(size_t)(e >> 7) * 6144 + 5 * D + part * 128 + (e & 127)];
        asm volatile("s_waitcnt vmcnt(0) lgkmcnt(0)" ::: "memory");
        __syncthreads();
        if (nv > 0) {
            PV_SMALL(0); PV_SMALL(1);
            asm volatile("s_waitcnt vmcnt(0)" ::: "memory");
            PV_HALF(0, 0);
            for (int v = 0; v < nv; ++v) {
                f32x4 acc[8];
#pragma unroll
                for (int j = 0; j < 8; ++j) acc[j] = (f32x4){0.f, 0.f, 0.f, 0.f};
                PV_HALF(v, 1);
                if (v == 0) asm volatile("s_waitcnt vmcnt(8)" ::: "memory"); else asm volatile("s_waitcnt vmcnt(16)" ::: "memory");
                PV_COMP(v, 0);
                asm volatile("s_waitcnt lgkmcnt(0)" ::: "memory");
                PV_SMALL(v + 2);
                PV_HALF(v + 1, 0);
                asm volatile("s_waitcnt vmcnt(12)" ::: "memory");
                PV_COMP(v, 1);
                {
                    const int r = PV_ROW(v); const int b = r / RPB, jr = r - b * RPB;
                    const LAS float* xs = (const LAS float*)(ST + (v % 3) * 1024 + 512); const LAS float* gt = GT + (jr < LC ? 4 : b) * 128;
                    float* orow = (layer == 0) ? (float*)(p.ws + WS_X) + (size_t)r * D + part * 128 + m16 : p.out + ((size_t)b * L + (jr - LC)) * D + part * 128 + m16;
                    float ov[8];
#pragma unroll
                    for (int j = 0; j < 8; ++j) ov[j] = xs[16 * j + m16] + gt[16 * j + m16] * ((acc[j][0] + acc[j][1]) * (1.f / 64.f));
                    asm volatile("s_waitcnt lgkmcnt(0)" ::: "memory");
                    if (lane < 16) {
#pragma unroll
                        for (int j = 0; j < 8; ++j) asm volatile("global_store_dword %0, %1, off" :: "v"(orow + 16 * j), "v"(ov[j]) : "memory");
                    }
                }
            }
            asm volatile("s_waitcnt vmcnt(0)" ::: "memory");
        }
    }
#undef PV_ROW
#undef PV_SMALL
#undef PV_HALF
#undef PV_COMP
}
constexpr int NPH = 2 + 2 * 11;
__global__ void __launch_bounds__(NTHR, 2) mk_fwd(Params p) {
    extern __shared__ __attribute__((aligned(16))) unsigned char lds_raw[];
    LAS unsigned char* lds = (LAS unsigned char*)lds_raw;
    volatile LAS unsigned* misc = (volatile LAS unsigned*)(lds + LDS_BYTES - 64);
    if (threadIdx.x < 16) misc[threadIdx.x] = 0u;
    __syncthreads();
    const int lo = p.ph_lo, hi = p.ph_hi;
    XcdBarrier bar; bar.bar = (unsigned*)(p.ws + WS_CTL) + 1024; bar.x = 0; bar.st = nullptr;
    if (hi - lo > 1) bar = xcd_barrier_post((unsigned*)(p.ws + WS_CTL) + 1024, misc);
#define IN(k) (lo <= (k) && (k) < hi)
#define SEAM(k) do { if (IN(k) && IN((k) + 1)) xcd_barrier(bar); } while (0)
    if (IN(0)) { phase_pro_a(p, lds); phase_pro_w(p, lds); } SEAM(0);
    if (IN(1)) { phase_pro_b(p); } SEAM(1);
#define LAYER_BODY(l) do { constexpr int k0 = 2 + 11 * (l); \
        if (IN(k0 + 0)) { phase_norm(p, (l), 0); } SEAM(k0 + 0); \
        if (IN(k0 + 1)) { phase_gemm<0>(p, (l), lds); } SEAM(k0 + 1); \
        if (IN(k0 + 2)) { phase_qkrope_s5a(p, (l), lds); } SEAM(k0 + 2); \
        if (IN(k0 + 3)) { phase_attn_s5b(p, (l), lds); } SEAM(k0 + 3); \
        if (IN(k0 + 4)) { phase_s5c(p, (l), lds); } SEAM(k0 + 4); \
        if (IN(k0 + 5)) { phase_glu(p, (l), lds); } SEAM(k0 + 5); \
        if (IN(k0 + 6)) { phase_gemm<1>(p, (l), lds); } SEAM(k0 + 6); \
        if (IN(k0 + 7)) { phase_norm(p, (l), 1); phase_peer_conv(p, (l)); } SEAM(k0 + 7); \
        if (IN(k0 + 8)) { phase_gemm<2>(p, (l), lds); } SEAM(k0 + 8); \
        if (IN(k0 + 9)) { phase_peer_sel(p, (l), lds); } SEAM(k0 + 9); \
          \
        if (IN(k0 + 10)) { phase_peer_slice<0>(p, (l), lds); asm volatile("s_waitcnt vmcnt(0) lgkmcnt(0)" ::: "memory"); phase_peer_v_mfma(p, (l), lds); } SEAM(k0 + 10); } while (0)
    LAYER_BODY(0);
    LAYER_BODY(1);
#undef LAYER_BODY
#undef IN
#undef SEAM
}

extern "C" void kernel_launch(void* const* d_in, const int* in_sizes, int n_in, void* d_out, int out_size, void* d_ws, size_t ws_size, hipStream_t stream) {
    static int grid = 0;
    if (grid == 0) {
        if (n_in != 32 || ws_size < WS_END) { fprintf(stderr, "kernel_launch: unexpected n_in %d / ws %zu\n", n_in, ws_size); grid = -1; return; }
        int dev = 0, cus = 0;
        if (hipGetDevice(&dev) != hipSuccess || hipDeviceGetAttribute(&cus, hipDeviceAttributeMultiprocessorCount, dev) != hipSuccess) { grid = -1; return; }
        if (hipFuncSetAttribute((const void*)mk_fwd, hipFuncAttributeMaxDynamicSharedMemorySize, LDS_BYTES) != hipSuccess) { fprintf(stderr, "kernel_launch: hipFuncSetAttribute failed\n"); grid = -1; return; }
        int per_cu = 0;
        (void)hipOccupancyMaxActiveBlocksPerMultiprocessor(&per_cu, (const void*)mk_fwd, NTHR, LDS_BYTES);
        (void)hipGetLastError();
        grid = cus > 0 ? cus : 256;
    }
    if (grid < 0) return;
    (void)hipMemsetAsync((char*)d_ws + WS_CTL, 0, CTL_ZERO_BYTES, stream);
    Params p{};
    for (int i = 0; i < 32; ++i) p.in[i] = (const float*)d_in[i];
    p.out = (float*)d_out; p.ws = (unsigned char*)d_ws;
#if MK_ONE_LAUNCH
    p.ph_lo = 0; p.ph_hi = NPH;
    hipLaunchKernelGGL(mk_fwd, dim3(grid), dim3(NTHR), LDS_BYTES, stream, p);
#else
    for (int k = 0; k < NPH; ++k) { p.ph_lo = k; p.ph_hi = k + 1; hipLaunchKernelGGL(mk_fwd, dim3(grid), dim3(NTHR), LDS_BYTES, stream, p); }
#endif
}
```

```cpp
#include <hip/hip_runtime.h>
#include <stdint.h>
#include <cstdio>

#ifndef MK_ONE_LAUNCH
#define MK_ONE_LAUNCH 1
#endif

#define GAS __attribute__((address_space(1)))
#define LAS __attribute__((address_space(3)))
typedef unsigned short bf16_t;
typedef float f32x4 __attribute__((ext_vector_type(4)));
typedef unsigned u32x4 __attribute__((ext_vector_type(4)));
typedef unsigned u32x2 __attribute__((ext_vector_type(2)));
typedef float f32x2 __attribute__((ext_vector_type(2)));
typedef short bf16x8_t __attribute__((ext_vector_type(8)));
typedef float f32x16_t __attribute__((ext_vector_type(16)));

constexpr int D = 1024, NB = 4, L = 8192, LC = 256, RPB = L + LC, ROWS = NB * RPB;
constexpr int INW = 2048;
constexpr int C_QA = 0, C_KA = 384, C_VA = 512, C_QB = 640, C_KB = 1024, C_VB = 1408, C_US = 1792;
constexpr int NCH = ROWS / 32, CPB = RPB / 32;
constexpr float EPS = 1e-6f;
constexpr float LOG2E = 1.4426950408889634f;
constexpr int NTHR = 512, NWAVE = 8;
constexpr int LDS_BYTES = 163840;

constexpr size_t MiB = 1u << 20;
constexpr size_t WS_CTL = 0, CTL_ZERO_BYTES = 65536;
constexpr size_t WS_MODP = 1 * MiB;
constexpr size_t WS_MOD = 3 * MiB;
constexpr size_t WS_TABA = 3 * MiB + 512 * 1024;
constexpr size_t WS_TABB = WS_TABA + 32768;
constexpr size_t WS_SCAL = WS_TABB + 32768;
constexpr size_t WS_BBAR = 4 * MiB;
constexpr size_t WS_APOW = 4 * MiB + 512 * 1024;
constexpr size_t WS_B2CAT = 6 * MiB;
constexpr size_t WS_KT = 14 * MiB;
constexpr size_t WS_WGLU_T = 15 * MiB;
constexpr size_t WS_G2CAT = 501 * MiB;
constexpr size_t WS_S5S = 148 * MiB;
constexpr size_t WS_HCAT = 165 * MiB;
constexpr size_t WS_G = 174 * MiB;
constexpr size_t WS_X = 16 * MiB;
constexpr size_t WS_H = 148 * MiB;
constexpr size_t WS_P = 214 * MiB;
constexpr size_t WS_MIX = 346 * MiB;
constexpr size_t WS_WIN_T = 412 * MiB;
constexpr size_t WS_WOUT_T = 420 * MiB;
constexpr size_t WS_WQ_T = 424 * MiB;
constexpr size_t WS_OB = 432 * MiB;
constexpr size_t WS_KEYS16 = 482 * MiB;
constexpr size_t WS_SEL = 484 * MiB;
constexpr size_t WS_U8 = WS_MIX;
constexpr size_t WS_V8 = WS_MIX + 16 * MiB;
constexpr size_t WS_END = 509 * MiB;

struct Params { const float* in[32]; float* out; unsigned char* ws; int ph_lo, ph_hi; };

__device__ __forceinline__ int otid() { int t = threadIdx.x; asm volatile("" : "+v"(t)); return t; }
__device__ __forceinline__ int obid() { int b = blockIdx.x; asm volatile("" : "+s"(b)); return b; }
__device__ __forceinline__ float bf2f(unsigned u) { return __uint_as_float(u << 16); }
__device__ __forceinline__ unsigned f2bf(float f) { unsigned u = __float_as_uint(f); return (u + 0x7fffu + ((u >> 16) & 1u)) >> 16; }
__device__ __forceinline__ unsigned pk2(float lo, float hi) { return f2bf(lo) | (f2bf(hi) << 16); }
__device__ __forceinline__ float gelu_tanh(float x) { const float u = 0.7978845608028654f * (x + 0.044715f * x * x * x); return 0.5f * x * (1.f + tanhf(u)); }
__device__ __forceinline__ float wave_sum(float v) {
#pragma unroll
    for (int o = 1; o < 64; o <<= 1) v += __shfl_xor(v, o);
    return v;
}
__device__ __forceinline__ void sincos_d(double x, double& s, double& c) {
    const double TWO_PI = 6.283185307179586476925286766559;
    const double k = rint(x / TWO_PI);
    const double r = x - k * TWO_PI;
    const double r2 = r * r;
    double ts = r, tc = 1.0, ss = r, cc = 1.0;
#pragma unroll
    for (int n = 1; n <= 16; ++n) {
        tc = -tc * r2 * (1.0 / (double)((2 * n - 1) * (2 * n)));
        ts = -ts * r2 * (1.0 / (double)((2 * n) * (2 * n + 1)));
        cc += tc; ss += ts;
    }
    s = ss; c = cc;
}
__device__ __forceinline__ const float* src_row(const Params& p, int layer, int r) {
    if (layer == 0) { const int b = r / RPB, j = r - b * RPB; return j < LC ? p.in[2] + ((size_t)b * LC + j) * D : p.in[0] + ((size_t)b * L + (j - LC)) * D; }
    return (const float*)(p.ws + WS_X) + (size_t)r * D;
}

#define XB_TMO      128
#define XB_XCNT(j)  (256  + 64 * (j))
#define XB_XSUB(j)  (1280 + 64 * (j))
#define XB_XGEN(j)  (2304 + 64 * (j))
#define XB_TOP      3328
#define XB_TOPGEN   3392
#define XCD_BAR_WORDS 3456
#define XB_SPIN_CAP (1u << 22)
__device__ __forceinline__ unsigned xb_ld(unsigned* p)              { return __hip_atomic_load(p, __ATOMIC_RELAXED, __HIP_MEMORY_SCOPE_AGENT); }
__device__ __forceinline__ unsigned xb_add(unsigned* p, unsigned v) { return __hip_atomic_fetch_add(p, v, __ATOMIC_RELAXED, __HIP_MEMORY_SCOPE_AGENT); }
__device__ __forceinline__ unsigned xb_xcc_id() { return (unsigned)__builtin_amdgcn_s_getreg((3 << 11) | 20) & 0xFu; }
#define XB_SPIN(cond, bar) do { unsigned _sp = 0; while (cond) { __builtin_amdgcn_s_sleep(1); \
    if ((++_sp & 255u) == 0u) { if (xb_ld(&(bar)[XB_TMO])) break; if (_sp > XB_SPIN_CAP) { atomicAdd(&(bar)[XB_TMO], 1u); break; } } } } while (0)
struct XcdBarrier { unsigned* bar; unsigned x; volatile LAS unsigned* st; };
__device__ __forceinline__ XcdBarrier xcd_barrier_post(unsigned* bar, volatile LAS unsigned* st) {
    XcdBarrier b; b.bar = bar; b.x = xb_xcc_id(); b.st = st;
    if (threadIdx.x == 0) (void)xb_add(&bar[XB_XCNT(b.x)], 1u);
    return b;
}
__device__ __forceinline__ void xcd_barrier_complete(unsigned* bar, unsigned x, unsigned& nloc, unsigned& nx) {
    const unsigned G = gridDim.x * gridDim.y * gridDim.z;
    unsigned sum, cnt, mine, sp = 0u;
    for (;;) {
        sum = 0u; cnt = 0u; mine = 0u;
#pragma unroll
        for (unsigned j = 0; j < 16; ++j) { const unsigned c = xb_ld(&bar[XB_XCNT(j)]); sum += c; cnt += (c > 0u) ? 1u : 0u; mine = (j == x) ? c : mine; }
        if (sum == G) break;
        __builtin_amdgcn_s_sleep(1);
        if ((++sp & 255u) == 0u) { if (xb_ld(&bar[XB_TMO])) break; if (sp > XB_SPIN_CAP) { atomicAdd(&bar[XB_TMO], 1u); break; } }
    }
    nloc = mine > 0u ? mine : 1u; nx = cnt > 0u ? cnt : 1u;
}
__device__ __forceinline__ void xcd_barrier(const XcdBarrier& b) {
    asm volatile("s_waitcnt vmcnt(0)" ::: "memory");
    __syncthreads();
    if (threadIdx.x == 0) {
        unsigned* bar = b.bar;
        __builtin_amdgcn_s_waitcnt(0);
        unsigned nloc = b.st[0], nx = b.st[1];
        if (nloc == 0u) { xcd_barrier_complete(bar, b.x, nloc, nx); b.st[0] = nloc; b.st[1] = nx; }
        const unsigned old = xb_add(&bar[XB_XSUB(b.x)], 1u);
        const unsigned gen = old / nloc;
        if (old + 1u == (gen + 1u) * nloc) {
            __builtin_amdgcn_fence(__ATOMIC_RELEASE, "agent");
            asm volatile("s_waitcnt vmcnt(0)" ::: "memory");
            const unsigned og = xb_add(&bar[XB_TOP], 1u);
            const unsigned tg = og / nx;
            if (og + 1u == (tg + 1u) * nx) xb_add(&bar[XB_TOPGEN], 1u);
            else XB_SPIN(xb_ld(&bar[XB_TOPGEN]) == tg, bar);
            __builtin_amdgcn_fence(__ATOMIC_ACQUIRE, "agent");
            xb_add(&bar[XB_XGEN(b.x)], 1u);
            asm volatile("s_waitcnt vmcnt(0)" ::: "memory");
        } else {
            XB_SPIN(xb_ld(&bar[XB_XGEN(b.x)]) == gen, bar);
            __builtin_amdgcn_fence(__ATOMIC_ACQUIRE, "agent");
            asm volatile("s_waitcnt vmcnt(0)" ::: "memory");
        }
    }
    __syncthreads();
}

namespace pg8 {
#define PG8_LAS __attribute__((address_space(3)))
typedef unsigned short bf16_t;
typedef short bf16x8 __attribute__((ext_vector_type(8)));
typedef float f32x4 __attribute__((ext_vector_type(4)));
typedef unsigned u32x4 __attribute__((ext_vector_type(4)));
constexpr int BM = 256, BK = 64, HALF = 128, HTB = HALF * BK * 2  , STAGE_BYTES = 8 * HTB, NXCD = 8, WGM = 8;

__host__ __device__ __forceinline__ int lds_byte(int r, int c) { const int st = (r >> 4) * 2 + (c >> 5), rr = r & 15, cc = c & 31, ob = rr * 64 + cc * 2; return st * 1024 + (ob ^ (((ob >> 9) & 1) << 5)); }
__host__ __device__ __forceinline__ void stage_rc(int b, int& R, int& C) { const int st = b / 1024, sb = b % 1024, swz = sb ^ (((sb >> 9) & 1) << 5); R = (st >> 1) * 16 + swz / 64; C = (st & 1) * 32 + (swz % 64) / 2; }
__host__ __device__ __forceinline__ int perm32(int rho) { const int n = rho >> 4, i = rho & 15; return 8 * (i >> 2) + 4 * n + (i & 3); }

struct Unit { int pm, pn; };
struct Gemm { const bf16_t* A; const bf16_t* Bt; int M, N, K; };
__device__ __forceinline__ unsigned cvt_pk_bf16(float lo, float hi) { unsigned r; asm volatile("v_cvt_pk_bf16_f32 %0, %1, %2" : "=v"(r) : "v"(lo), "v"(hi)); return r; }
template <class Epi, class Sched, bool ALIGN_EPI = false, bool SP2 = false>
__device__ __forceinline__ void gemm_phase(PG8_LAS unsigned char* lds, const Gemm g, const Sched& S, const Epi& E) {
    const int tid = threadIdx.x, wid = __builtin_amdgcn_readfirstlane(tid >> 6), lane = tid & 63, wr = wid >> 2, wc = wid & 3, fr = lane & 15, fq = lane >> 4;
    const int K = g.K, nt = K / BK;
    unsigned voffA[2], voffB[2];
#pragma unroll
    for (int i = 0; i < 2; ++i) { int R, C; stage_rc(tid * 16 + i * 8192, R, C); const int Rb = Epi::PERM ? ((R & ~31) + perm32(R & 31)) : R;
        voffA[i] = (unsigned)(R * K + C) * 2u; voffB[i] = (unsigned)(Rb * K + C) * 2u; }
    const size_t kstep = (size_t)(BK * 2);
    const size_t hstep = (size_t)HALF * K * 2;
    const size_t tstep = 2 * hstep;
    const unsigned ldsw = (unsigned)wid * 1024u;
    const int aoff = lds_byte(wr * 64 + fr, fq * 8), boff = lds_byte(wc * 32 + fr, fq * 8);
#define PG8_SA(b, h) (((b) * 2 + (h)) * HTB)
#define PG8_SB(b, h) ((4 + (b) * 2 + (h)) * HTB)
#define PG8_STAGE(bufoff, gbase, voff) do { _Pragma("unroll") for (int _i = 0; _i < 2; ++_i) \
        __builtin_amdgcn_global_load_lds((const unsigned*)((const char*)(gbase) + (voff)[_i]), (PG8_LAS unsigned*)(lds + (bufoff) + ldsw + _i * 8192), 16, 0, 0); } while (0)
#define PG8_LDA(dst, b, h) do { _Pragma("unroll") for (int m = 0; m < 4; ++m) _Pragma("unroll") for (int k = 0; k < 2; ++k) dst[m][k] = *(const PG8_LAS bf16x8*)(lds + PG8_SA(b, h) + aoff + m * 2048 + k * 1024); } while (0)
#define PG8_LDB(dst, b, h) do { _Pragma("unroll") for (int n = 0; n < 2; ++n) _Pragma("unroll") for (int k = 0; k < 2; ++k) dst[n][k] = *(const PG8_LAS bf16x8*)(lds + PG8_SB(b, h) + boff + n * 2048 + k * 1024); } while (0)
#define PG8_MMA(ai, bj, At, Bt) do { __builtin_amdgcn_s_setprio(1); _Pragma("unroll") for (int m = 0; m < 4; ++m) _Pragma("unroll") for (int n = 0; n < 2; ++n) _Pragma("unroll") for (int k = 0; k < 2; ++k) \
        acc[ai][bj][m][n] = __builtin_amdgcn_mfma_f32_16x16x32_bf16(Bt[n][k], At[m][k], acc[ai][bj][m][n], 0, 0, 0); __builtin_amdgcn_s_setprio(0); } while (0)
#define PG8_WAIT_V(n) asm volatile("s_waitcnt vmcnt(" #n ")" ::: "memory")
#define PG8_WAIT_L(n) asm volatile("s_waitcnt lgkmcnt(" #n ")" ::: "memory")
#define PG8_BAR __builtin_amdgcn_s_barrier()
#define PG8_SCHED __builtin_amdgcn_sched_barrier(0)
    Unit cur, nxt; int ui = 0;
    if (!S.next(0, cur)) return;
    f32x4 acc[2][2][4][2];
#pragma unroll
    for (int a = 0; a < 2; ++a)
#pragma unroll
        for (int b = 0; b < 2; ++b)
#pragma unroll
            for (int m = 0; m < 4; ++m)
#pragma unroll
                for (int n = 0; n < 2; ++n) acc[a][b][m][n] = (f32x4){0.f, 0.f, 0.f, 0.f};
    bf16x8 At[4][2], B0[2][2], B1[2][2];
    const char* cA = (const char*)g.A + (size_t)cur.pm * tstep; const char* cB = (const char*)g.Bt + (size_t)cur.pn * tstep;
    S.a_ready(cur);
    if constexpr (SP2) {
        PG8_STAGE(PG8_SB(0, 0), cB, voffB); PG8_STAGE(PG8_SB(0, 1), cB + hstep, voffB); PG8_STAGE(PG8_SA(0, 0), cA, voffA); PG8_STAGE(PG8_SA(0, 1), cA + hstep, voffA);
        if (wr == 1) PG8_BAR;
        PG8_WAIT_V(2); PG8_BAR;
        PG8_STAGE(PG8_SB(1, 0), cB + kstep, voffB); PG8_STAGE(PG8_SA(1, 0), cA + kstep, voffA); PG8_STAGE(PG8_SB(1, 1), cB + hstep + kstep, voffB);
        PG8_WAIT_V(6); PG8_BAR;
    } else {
        PG8_STAGE(PG8_SB(0, 0), cB, voffB); PG8_STAGE(PG8_SA(0, 0), cA, voffA); PG8_STAGE(PG8_SB(0, 1), cB + hstep, voffB); PG8_STAGE(PG8_SA(0, 1), cA + hstep, voffA);
        if (wr == 1) PG8_BAR;
        PG8_WAIT_V(4); PG8_BAR;
        PG8_STAGE(PG8_SB(1, 0), cB + kstep, voffB); PG8_STAGE(PG8_SA(1, 0), cA + kstep, voffA); PG8_STAGE(PG8_SB(1, 1), cB + hstep + kstep, voffB);
        PG8_WAIT_V(6); PG8_BAR;
    }
    for (;;) {
        const bool has_next = S.next(ui + 1, nxt);
        const char* nA = has_next ? (const char*)g.A + (size_t)nxt.pm * tstep : cA; const char* nB = has_next ? (const char*)g.Bt + (size_t)nxt.pn * tstep : cB;
        for (int t = 0; t < nt; t += 2) {
            const bool last = (t == nt - 2);
            const char* a1 = cA + (size_t)(t + 1) * kstep;
            const char* a2 = last ? nA : cA + (size_t)(t + 2) * kstep; const char* b2 = last ? nB : cB + (size_t)(t + 2) * kstep;
            const char* a3 = a2 + kstep; const char* b3 = b2 + kstep;
            if (last && has_next) S.a_ready(nxt);
            if constexpr (SP2) {
            PG8_LDB(B0, 0, 0); PG8_LDB(B1, 0, 1); PG8_SCHED; PG8_LDA(At, 0, 0); PG8_STAGE(PG8_SA(1, 1), a1 + hstep, voffA);
            PG8_WAIT_V(8); PG8_WAIT_L(0); PG8_BAR; PG8_MMA(0, 0, At, B0); PG8_MMA(0, 1, At, B1); PG8_BAR; PG8_SCHED;
            PG8_LDA(At, 0, 1); PG8_STAGE(PG8_SB(0, 0), b2, voffB); PG8_STAGE(PG8_SB(0, 1), b2 + hstep, voffB); PG8_STAGE(PG8_SA(0, 0), a2, voffA);
            PG8_WAIT_V(8); PG8_WAIT_L(0); PG8_BAR; PG8_MMA(1, 0, At, B0); PG8_MMA(1, 1, At, B1); PG8_BAR; PG8_SCHED;
            PG8_LDB(B0, 1, 0); PG8_LDB(B1, 1, 1); PG8_SCHED; PG8_LDA(At, 1, 0); PG8_STAGE(PG8_SA(0, 1), a2 + hstep, voffA);
            PG8_WAIT_V(8); PG8_WAIT_L(0); PG8_BAR; PG8_MMA(0, 0, At, B0); PG8_MMA(0, 1, At, B1); PG8_BAR; PG8_SCHED;
            PG8_LDA(At, 1, 1); PG8_STAGE(PG8_SB(1, 0), b3, voffB); PG8_STAGE(PG8_SB(1, 1), b3 + hstep, voffB); PG8_STAGE(PG8_SA(1, 0), a3, voffA);
            PG8_WAIT_V(8); PG8_WAIT_L(0); PG8_BAR; PG8_MMA(1, 0, At, B0); PG8_MMA(1, 1, At, B1); PG8_BAR; PG8_SCHED;
            } else {
            PG8_LDB(B0, 0, 0); PG8_SCHED; PG8_LDA(At, 0, 0); PG8_STAGE(PG8_SA(1, 1), a1 + hstep, voffA);
            PG8_WAIT_L(8); PG8_BAR; PG8_WAIT_L(0); PG8_MMA(0, 0, At, B0); PG8_BAR; PG8_SCHED;
            PG8_LDB(B1, 0, 1); PG8_STAGE(PG8_SB(0, 0), b2, voffB);
            PG8_BAR; PG8_WAIT_L(0); PG8_MMA(0, 1, At, B1); PG8_BAR;
            PG8_LDA(At, 0, 1); PG8_STAGE(PG8_SA(0, 0), a2, voffA);
            PG8_BAR; PG8_WAIT_L(0); PG8_MMA(1, 0, At, B0); PG8_BAR; PG8_SCHED;
            PG8_STAGE(PG8_SB(0, 1), b2 + hstep, voffB);
            PG8_WAIT_V(6); PG8_BAR; PG8_MMA(1, 1, At, B1); PG8_BAR;
            PG8_LDB(B0, 1, 0); PG8_SCHED; PG8_LDA(At, 1, 0); PG8_STAGE(PG8_SA(0, 1), a2 + hstep, voffA);
            PG8_WAIT_L(8); PG8_BAR; PG8_WAIT_L(0); PG8_MMA(0, 0, At, B0); PG8_BAR; PG8_SCHED;
            PG8_LDB(B1, 1, 1); PG8_STAGE(PG8_SB(1, 0), b3, voffB);
            PG8_BAR; PG8_WAIT_L(0); PG8_MMA(0, 1, At, B1); PG8_BAR;
            PG8_LDA(At, 1, 1); PG8_STAGE(PG8_SA(1, 0), a3, voffA);
            PG8_BAR; PG8_WAIT_L(0); PG8_MMA(1, 0, At, B0); PG8_BAR; PG8_SCHED;
            PG8_STAGE(PG8_SB(1, 1), b3 + hstep, voffB);
            PG8_WAIT_V(6); PG8_BAR; PG8_MMA(1, 1, At, B1); PG8_BAR;
            }
        }
        if constexpr (ALIGN_EPI) { if (wr == 0) PG8_BAR; }
        if constexpr (!Epi::AFTER_DRAIN) { E(acc, cur, wr, wc, fr, fq); S.done(cur); }
        if (!has_next) break;
#pragma unroll
        for (int a = 0; a < 2; ++a)
#pragma unroll
            for (int b = 0; b < 2; ++b)
#pragma unroll
                for (int m = 0; m < 4; ++m)
#pragma unroll
                    for (int n = 0; n < 2; ++n) acc[a][b][m][n] = (f32x4){0.f, 0.f, 0.f, 0.f};
        cur = nxt; cA = nA; cB = nB; ++ui;
        if constexpr (ALIGN_EPI) { if (wr == 1) PG8_BAR; }
    }
    PG8_WAIT_V(0);
    if constexpr (!ALIGN_EPI) { if (wr == 0) PG8_BAR; }
    PG8_BAR;
    if constexpr (Epi::AFTER_DRAIN) { E.fused(acc, cur, wr, wc, fr, fq, lds, wid, lane); S.done(cur); }
#undef PG8_SA
#undef PG8_SB
#undef PG8_STAGE
#undef PG8_LDA
#undef PG8_LDB
#undef PG8_MMA
#undef PG8_WAIT_V
#undef PG8_WAIT_L
#undef PG8_BAR
#undef PG8_SCHED
}
}

struct RowOrder {
    int nM, nN, nwg, G, c; bool lat_only;
    __device__ __forceinline__ void init(int nM_, int nN_, int G_, int c_, bool lat) { nM = nM_; nN = nN_; nwg = nM * nN; G = G_; c = c_; lat_only = lat; }
    __device__ __forceinline__ bool next(int i, pg8::Unit& u) const {
        const long Lx = (long)i * G + c; if (Lx >= nwg) return false;
        int wgid = (int)Lx; { const int q = nwg / pg8::NXCD, r = nwg % pg8::NXCD, xcd = wgid % pg8::NXCD, off = wgid / pg8::NXCD; wgid = (xcd < r ? xcd * (q + 1) : r * (q + 1) + (xcd - r) * q) + off; }
        const int nig = pg8::WGM * nN, gid = wgid / nig, fm = gid * pg8::WGM, gsz = (nM - fm) < pg8::WGM ? (nM - fm) : pg8::WGM;
        const int pm = fm + ((wgid % nig) % gsz); u.pn = (wgid % nig) / gsz;
        u.pm = lat_only ? (pm / 32) * 33 + 1 + (pm % 32) : pm; return true;
    }
    __device__ __forceinline__ void a_ready(const pg8::Unit&) const {}
    __device__ __forceinline__ void done(const pg8::Unit&) const {}
};
struct EpiBf {
    static constexpr bool PERM = true, AFTER_DRAIN = false;
    bf16_t* O; int ldc;
    __device__ __forceinline__ void operator()(const pg8::f32x4 (&acc)[2][2][4][2], const pg8::Unit& u, int wr, int wc, int fr, int fq) const {
        const int row0 = u.pm * 256 + wr * 64 + fr, col0 = u.pn * 256 + wc * 32 + 8 * fq;
#pragma unroll
        for (int ai = 0; ai < 2; ++ai)
#pragma unroll
            for (int m = 0; m < 4; ++m) { bf16_t* rowp = O + (size_t)(row0 + ai * 128 + m * 16) * ldc + col0;
#pragma unroll
                for (int bj = 0; bj < 2; ++bj) { const pg8::f32x4 v0 = acc[ai][bj][m][0], v1 = acc[ai][bj][m][1];
                    u32x4 w; w.x = pg8::cvt_pk_bf16(v0[0], v0[1]); w.y = pg8::cvt_pk_bf16(v0[2], v0[3]); w.z = pg8::cvt_pk_bf16(v1[0], v1[1]); w.w = pg8::cvt_pk_bf16(v1[2], v1[3]);
                    *(u32x4*)(rowp + bj * 128) = w; } }
    }
};
struct EpiRes {
    static constexpr bool PERM = true, AFTER_DRAIN = false;
    const float* x_in; const float* ctx_in; float* X; const float* mod; int layer; int gate_chunk;
    __device__ __forceinline__ void operator()(const pg8::f32x4 (&acc)[2][2][4][2], const pg8::Unit& u, int wr, int wc, int fr, int fq) const {
        const int b = u.pm / 33, jt = u.pm - b * 33;
        const float* src = layer == 0 ? (jt == 0 ? ctx_in + (size_t)b * LC * D : x_in + ((size_t)b * L + (size_t)(jt - 1) * 256) * D) : X + (size_t)u.pm * 256 * D;
        float* dst = X + (size_t)u.pm * 256 * D;
        const float* g = mod + (size_t)(jt == 0 ? 4 : b) * 6144 + gate_chunk * D;
        const int rl0 = wr * 64 + fr, col0 = u.pn * 256 + wc * 32 + 8 * fq;
        pg8::f32x4 gv[2][2];
#pragma unroll
        for (int bj = 0; bj < 2; ++bj)
#pragma unroll
            for (int n = 0; n < 2; ++n) gv[bj][n] = *(const pg8::f32x4*)(g + col0 + bj * 128 + 4 * n);
#pragma unroll
        for (int ai = 0; ai < 2; ++ai)
#pragma unroll
            for (int m = 0; m < 4; ++m) { const size_t ro = (size_t)(rl0 + ai * 128 + m * 16) * D + col0;
#pragma unroll
                for (int bj = 0; bj < 2; ++bj)
#pragma unroll
                    for (int n = 0; n < 2; ++n) { const size_t off = ro + bj * 128 + 4 * n; const pg8::f32x4 xi = *(const pg8::f32x4*)(src + off);
                        *(pg8::f32x4*)(dst + off) = xi + gv[bj][n] * acc[ai][bj][m][n]; } }
    }
};
struct TrItem { const float* W; bf16_t* WT; int K, N, k0, n0; };
__device__ __forceinline__ TrItem transpose_decode(const Params& p, int it) {
    constexpr int I_IN = 16 * 64, I_OUT = 16 * 32, I_Q = 16 * 64, I_G = 4 * 8, PER_L = I_IN + I_OUT + I_Q + I_G;
    const int l = it / PER_L; int r = it - l * PER_L; TrItem t;
    if (r < I_IN) { t.W = p.in[8] + (size_t)l * 1024 * 2048; t.K = 1024; t.N = 2048; t.WT = (bf16_t*)(p.ws + WS_WIN_T) + (size_t)l * 2048 * 1024; }
    else if ((r -= I_IN) < I_OUT) { t.W = p.in[9] + (size_t)l * 1024 * 1024; t.K = 1024; t.N = 1024; t.WT = (bf16_t*)(p.ws + WS_WOUT_T) + (size_t)l * 1024 * 1024; }
    else if ((r -= I_OUT) < I_G) { t.W = p.in[27] + (size_t)l * 256 * 256; t.K = 256; t.N = 256; t.WT = (bf16_t*)(p.ws + WS_WGLU_T) + (size_t)l * 256 * 256; }
    else { r -= I_G; t.W = p.in[28] + (size_t)l * 1024 * 2048; t.K = 1024; t.N = 2048; t.WT = (bf16_t*)(p.ws + WS_WQ_T) + (size_t)l * 2048 * 1024; }
    const int nblk = t.N / 32; t.k0 = 64 * (r / nblk); t.n0 = 32 * (r % nblk); return t;
}
__device__ __forceinline__ void phase_pro_w(const Params& p, LAS unsigned char* lds) {
    const int tid = otid(), wave = tid >> 6, lane = tid & 63;
    LAS float* scr = (LAS float*)lds + wave * (64 * 33);
    constexpr int PER_L = 16 * 64 + 16 * 32 + 16 * 64 + 4 * 8, NIT = 2 * PER_L;
    const int step = gridDim.x * NWAVE;
    for (int it0 = obid() * NWAVE + wave; it0 < NIT; it0 += 3 * step) {
        f32x4 wv[3][8];
#pragma unroll
        for (int u = 0; u < 3; ++u) { const int it = it0 + u * step; const TrItem t = transpose_decode(p, it < NIT ? it : it0);
#pragma unroll
            for (int i = 0; i < 8; ++i) wv[u][i] = *(const f32x4*)(t.W + (size_t)(t.k0 + 8 * i + (lane >> 3)) * t.N + t.n0 + 4 * (lane & 7)); }
#pragma unroll
        for (int u = 0; u < 3; ++u) { const int it = it0 + u * step; if (it >= NIT) continue; const TrItem t = transpose_decode(p, it);
#pragma unroll
            for (int i = 0; i < 8; ++i) { LAS float* sp = scr + (8 * i + (lane >> 3)) * 33 + 4 * (lane & 7); sp[0] = wv[u][i].x; sp[1] = wv[u][i].y; sp[2] = wv[u][i].z; sp[3] = wv[u][i].w; }
            asm volatile("s_waitcnt lgkmcnt(0)" ::: "memory");
            const int c = lane & 7;
#pragma unroll
            for (int j = 0; j < 4; ++j) { const int n = (lane >> 3) + 8 * j; const LAS float* sp = scr + (8 * c) * 33 + n;
                u32x4 o; o.x = pk2(sp[0 * 33], sp[1 * 33]); o.y = pk2(sp[2 * 33], sp[3 * 33]); o.z = pk2(sp[4 * 33], sp[5 * 33]); o.w = pk2(sp[6 * 33], sp[7 * 33]);
                *(u32x4*)(t.WT + (size_t)(t.n0 + n) * t.K + t.k0 + 8 * c) = o; }
            asm volatile("s_waitcnt lgkmcnt(0)" ::: "memory"); }
    }
}
template <int MODE>
__device__ __forceinline__ void phase_gemm(const Params& p, int layer, LAS unsigned char* lds) {
    const bool lat_only = (MODE != 0) && (layer == 1);
    RowOrder S; S.init(lat_only ? 128 : 132, MODE == 1 ? 4 : 8, (int)gridDim.x, obid(), lat_only);
    if (MODE == 1) {
        pg8::Gemm g{(const bf16_t*)(p.ws + WS_MIX), (const bf16_t*)(p.ws + WS_WOUT_T) + (size_t)layer * 1024 * 1024, ROWS, 1024, 1024};
        EpiRes E{p.in[0], p.in[2], (float*)(p.ws + WS_X), (const float*)(p.ws + WS_MOD) + (size_t)layer * 5 * 6144, layer, 2};
        pg8::gemm_phase<EpiRes, RowOrder, true, true>(lds, g, S, E);
    } else {
        pg8::Gemm g{(const bf16_t*)(p.ws + WS_H), (const bf16_t*)(p.ws + (MODE == 0 ? WS_WIN_T : WS_WQ_T)) + (size_t)layer * 2048 * 1024, ROWS, 2048, 1024};
        EpiBf E{(bf16_t*)(p.ws + WS_P), INW};
        pg8::gemm_phase<EpiBf, RowOrder, true, true>(lds, g, S, E);
    }
}
#include <hip/hip_bf16.h>
namespace attn_body {
using bf16=__hip_bfloat16;
using bf16x8=__attribute__((ext_vector_type(8)))short;
using s16x4=__attribute__((ext_vector_type(4)))short;
using f32x16=__attribute__((ext_vector_type(16)))float;
using u32x4=__attribute__((ext_vector_type(4)))unsigned;
constexpr int D=64,PQ=2048;
constexpr int NW=8,QBLK=32,QB=QBLK*NW,KVBLK=64;
__device__ __forceinline__ int crow(int r,int hi){return (r&3)+8*(r>>2)+4*hi;}
#define SBAR() __builtin_amdgcn_sched_barrier(0)
__device__ __forceinline__ void cmask(f32x16&p0,f32x16&p1,int jb,int qrel,int hi){
  const float NEG=-INFINITY; int kb=64*jb+4*hi;
  #pragma unroll
  for(int r=0;r<16;++r){int kv=kb+(r&3)+8*(r>>2); if(kv>qrel)p0[r]=NEG; if(kv+32>qrel)p1[r]=NEG;}
}

constexpr int NSLOT=3, SLOTB=8192;
constexpr int LDS_K=0, LDS_V=NSLOT*SLOTB, LDS_WS=2*NSLOT*SLOTB, LDS_OST=LDS_WS+NW*64*4, LDS_BYTES=LDS_OST+NW*4096;
constexpr float C2=0.125f*1.4426950408889634f;
__device__ __forceinline__ void glds16(const void*gsrc,unsigned lds_dst){unsigned keep;
  asm volatile("s_mov_b32 %0, m0\n\ts_mov_b32 m0, %2\n\ts_nop 0\n\tglobal_load_lds_dwordx4 %1, off\n\ts_mov_b32 m0, %0":"=&s"(keep):"v"(gsrc),"s"(lds_dst):"memory");}
__device__ __forceinline__ float max3f(float a,float b,float c){float r;asm("v_max3_f32 %0, %1, %2, %3":"=v"(r):"v"(a),"v"(b),"v"(c));return r;}
__device__ __forceinline__ float max2f(float a,float b){float r;asm("v_max_f32_e32 %0, %1, %2":"=v"(r):"v"(a),"v"(b));return r;}
__device__ __forceinline__ float fadd_s(float a,float b){float r;asm("v_add_f32_e32 %0, %1, %2":"=v"(r):"v"(a),"v"(b));return r;}
__device__ __forceinline__ float fsub_s(float a,float b){float r;asm("v_sub_f32_e32 %0, %1, %2":"=v"(r):"v"(a),"v"(b));return r;}
typedef float f32x2_t __attribute__((ext_vector_type(2))); typedef __bf16 bf16x2_t __attribute__((ext_vector_type(2)));
__device__ __forceinline__ unsigned cvtpk_s(float lo,float hi){f32x2_t v={lo,hi};bf16x2_t b=__builtin_convertvector(v,bf16x2_t);return __builtin_bit_cast(unsigned,b);}
#define WAIT_BAR(N) asm volatile("s_waitcnt vmcnt(" #N ") lgkmcnt(0)\n\ts_barrier":::"memory")

template<int DQK> __device__ __forceinline__ void qkt(f32x16&p0,f32x16&p1,const char*Kslot,const bf16x8*qr,const f32x16&negm,int r32,int hi){
  const char*kb=Kslot+hi*1024+r32*16;
  #pragma unroll
  for(int d0=0;d0<DQK/16;++d0){
    const bf16x8 b0=*reinterpret_cast<const bf16x8*>(kb+d0*2048);
    const bf16x8 b1=*reinterpret_cast<const bf16x8*>(kb+d0*2048+512);
    if(d0==0){p0=__builtin_amdgcn_mfma_f32_32x32x16_bf16(b0,qr[0],negm,0,0,0);p1=__builtin_amdgcn_mfma_f32_32x32x16_bf16(b1,qr[0],negm,0,0,0);}
    else{p0=__builtin_amdgcn_mfma_f32_32x32x16_bf16(b0,qr[d0],p0,0,0,0);p1=__builtin_amdgcn_mfma_f32_32x32x16_bf16(b1,qr[d0],p1,0,0,0);}}
}
typedef __attribute__((address_space(3))) const char* lds_cptr;
typedef short v4i16_t __attribute__((ext_vector_type(4)));
template<int DQK> __device__ __forceinline__ void kload8(bf16x8*kf,lds_cptr kp){
  kf[0]=*(const __attribute__((address_space(3))) bf16x8*)(kp);      kf[1]=*(const __attribute__((address_space(3))) bf16x8*)(kp+512);
  kf[2]=*(const __attribute__((address_space(3))) bf16x8*)(kp+2048); kf[3]=*(const __attribute__((address_space(3))) bf16x8*)(kp+2560);
  if constexpr(DQK==64){
  kf[4]=*(const __attribute__((address_space(3))) bf16x8*)(kp+4096); kf[5]=*(const __attribute__((address_space(3))) bf16x8*)(kp+4608);
  kf[6]=*(const __attribute__((address_space(3))) bf16x8*)(kp+6144); kf[7]=*(const __attribute__((address_space(3))) bf16x8*)(kp+6656);}
}
__device__ __forceinline__ void kload2(bf16x8*kf,lds_cptr kp,int j){ kf[2*j]=*(const __attribute__((address_space(3))) bf16x8*)(kp+j*2048); kf[2*j+1]=*(const __attribute__((address_space(3))) bf16x8*)(kp+j*2048+512); }
__device__ __forceinline__ s16x4 vtr(lds_cptr p){ return __builtin_bit_cast(s16x4,__builtin_amdgcn_ds_read_tr16_b64_v4i16((__attribute__((address_space(3))) v4i16_t*)p)); }
__device__ __forceinline__ float rowmax(const f32x16&p0,const f32x16&p1){
  float a=max3f(p0[0],p0[1],p1[0]),b=max3f(p0[2],p0[3],p1[1]);a=max3f(a,p1[2],p1[3]);
  #pragma unroll
  for(int r=4;r<16;r+=4){a=max3f(a,p0[r],p0[r+1]);b=max3f(b,p0[r+2],p0[r+3]);a=max3f(a,p1[r],p1[r+1]);b=max3f(b,p1[r+2],p1[r+3]);}
  const float m=max2f(a,b);
  auto rr=__builtin_amdgcn_permlane32_swap(__float_as_uint(m),__float_as_uint(m),false,false);
  return max2f(__uint_as_float(rr[0]),__uint_as_float(rr[1]));
}
__device__ __forceinline__ void pv(f32x16*o,int vb,bf16x8 pa0,bf16x8 pa1,bf16x8 pa2,bf16x8 pa3){
  #pragma unroll
  for(int d0=0;d0<2;++d0){s16x4 lo[4],hi[4];
    #pragma unroll
    for(int ks=0;ks<4;++ks){
      asm volatile("ds_read_b64_tr_b16 %0,%1 offset:%c2":"=&v"(lo[ks]):"v"(vb),"i"(d0*4096+ks*1024):"memory");
      asm volatile("ds_read_b64_tr_b16 %0,%1 offset:%c2":"=&v"(hi[ks]):"v"(vb),"i"(d0*4096+ks*1024+512):"memory");}
    asm volatile("s_waitcnt lgkmcnt(0)":::"memory");SBAR();
    #define PK(k) (bf16x8){lo[k][0],lo[k][1],lo[k][2],lo[k][3],hi[k][0],hi[k][1],hi[k][2],hi[k][3]}
    o[d0]=__builtin_amdgcn_mfma_f32_32x32x16_bf16(pa0,PK(0),o[d0],0,0,0);
    o[d0]=__builtin_amdgcn_mfma_f32_32x32x16_bf16(pa1,PK(1),o[d0],0,0,0);
    o[d0]=__builtin_amdgcn_mfma_f32_32x32x16_bf16(pa2,PK(2),o[d0],0,0,0);
    o[d0]=__builtin_amdgcn_mfma_f32_32x32x16_bf16(pa3,PK(3),o[d0],0,0,0);
    #undef PK
  }
}

#ifndef ATTN_STORE16
#define ATTN_STORE16(p,v) __builtin_nontemporal_store((v),(u32x4*)(p))
#endif
template<int THRL,int DQK,bool FIXM> __device__ __forceinline__ void attn_unit(const bf16*Qu,const bf16*__restrict__ Kh,const bf16*__restrict__ Vh,bf16*Ou,const int po,const int NT,const float Mfix,char*shm){
  const int tid=threadIdx.x,lane=tid&63,r32=lane&31,hi=lane>>5; const int wid=__builtin_amdgcn_readfirstlane(tid>>6);
  const bf16*Qw=Qu+(long)(wid*QBLK)*PQ;
  const unsigned lds0=(unsigned)(uintptr_t)shm;
  float*wsf=(float*)(shm+LDS_WS)+wid*64;
  const int kch=(DQK==64)?wid:(wid&3);
  const bf16*ksrc=Kh+(long)lane*PQ+kch*8;
  const bf16*vsrc=Vh+(long)(16*(wid&3)+(lane>>2))*PQ+(wid>>2)*32+(lane&3)*8;
  const unsigned kdst=lds0+LDS_K+kch*1024, vdst=lds0+LDS_V+wid*1024;
  #define DMA_K(t,slot) glds16(ksrc+(long)(t)*KVBLK*PQ,(unsigned)__builtin_amdgcn_readfirstlane(kdst+(slot)))
  #define DMA_V(t,slot) glds16(vsrc+(long)(t)*KVBLK*PQ,(unsigned)__builtin_amdgcn_readfirstlane(vdst+(slot)))
  const int vb0=(int)(lds0+LDS_V)+((lane>>4)&1)*32+(lane&3)*8+(4*hi+((lane&15)>>2))*64;
  const char*Kbase=shm+LDS_K; bf16x8 kf[8];
  const lds_cptr shm3=(lds_cptr)shm; const lds_cptr kp0=shm3+LDS_K+hi*1024+r32*16; const lds_cptr vp0=shm3+LDS_V+((lane>>4)&1)*32+(lane&3)*8+(4*hi+((lane&15)>>2))*64;
  DMA_K(0,0);DMA_V(0,0);DMA_K(1,SLOTB);
  bf16x8 qr[4];
  #pragma unroll
  for(int d0=0;d0<DQK/16;++d0)qr[d0]=*reinterpret_cast<const bf16x8*>(&Qw[(long)r32*PQ+d0*16+hi*8]);
  float mhat=0.f,l_reg=0.f;f32x16 o[2];o[0]=f32x16{};o[1]=f32x16{};f32x16 negm=f32x16{};asm volatile("":"+v"(negm));
  #define CMASK(P0,P1,t) do{}while(0)
  bool resc=false;
  #define START(P0,P1) do{ const float rm=FIXM?Mfix:rowmax(P0,P1); resc=false; \
    { const float dl=rm; mhat=fadd_s(mhat,dl); \
      _Pragma("unroll") for(int r=0;r<16;++r){P0[r]=fsub_s(P0[r],dl);P1[r]=fsub_s(P1[r],dl);} \
      _Pragma("unroll") for(int r=0;r<16;++r)negm[r]=-mhat; asm volatile("":"+v"(negm)); } \
    _Pragma("unroll") for(int r=0;r<16;++r)P0[r]=__builtin_amdgcn_exp2f(P0[r]); }while(0)
  #define RESC() do{ if(resc){ asm volatile("s_waitcnt lgkmcnt(0)":::"memory"); \
      _Pragma("unroll") for(int d_=0;d_<2;++d_) _Pragma("unroll") for(int r=0;r<16;++r)o[d_][r]*=wsf[crow(r,hi)]; } }while(0)
  f32x16 pA0,pA1,pB0,pB1;
  int sl_prev=0,sl_cur=0,sl_next=SLOTB;
  #define ROT() do{sl_prev=sl_cur;sl_cur=sl_next;sl_next=(sl_next==(NSLOT-1)*SLOTB)?0:sl_next+SLOTB;}while(0)
  DMA_K(2,2*SLOTB);
  WAIT_BAR(3);
  qkt<DQK>(pA0,pA1,Kbase,qr,negm,r32,hi);asm volatile("s_nop 15\n\ts_nop 7":"+v"(pA0),"+v"(pA1));CMASK(pA0,pA1,0);
  START(pA0,pA1);
  _Pragma("unroll") for(int r=0;r<16;++r)pA1[r]=__builtin_amdgcn_exp2f(pA1[r]);
  WAIT_BAR(0);
  DMA_K(3,0);DMA_V(1,SLOTB);
  ROT();
  kload8<DQK>(kf,kp0+sl_cur);
  WAIT_BAR(2);
  s16x4 vlo[8],vhi[8]; u32x4 pw0,pw1,pw2,pw3;
  #define PKW(P,B) cvtpk_s(P[B],P[B+1])
  #define PAF(k) __builtin_bit_cast(bf16x8,pw##k)
  #define VFR(i) (bf16x8){vlo[i][0],vlo[i][1],vlo[i][2],vlo[i][3],vhi[i][0],vhi[i][1],vhi[i][2],vhi[i][3]}
  #define PIN(x) asm volatile("":"+v"(x))
  #define MX3(a,b,c) __builtin_fmaxf(__builtin_fmaxf((a),(b)),(c))
  #define GAPA(MF,A0,A1,A2,A3,W0,W1,PW) do{ MF; sacc+=A0; sacc+=A1; sacc+=A2; sacc+=A3; PIN(sacc); W0; W1; PIN(PW); SBAR(); }while(0)
  #define EX(v) __builtin_amdgcn_exp2f(v)
  #define GAPB(MF,X,B) do{ MF; X[B]=EX(X[B]); X[B+1]=EX(X[B+1]); X[B+2]=EX(X[B+2]); X[B+3]=EX(X[B+3]); PIN(X); SBAR(); }while(0)
  #define VRD(i) do{ vlo[i]=vtr(vp_+(((i)>>2)*4096+((i)&3)*1024)); vhi[i]=vtr(vp_+(((i)>>2)*4096+((i)&3)*1024+512)); }while(0)
  #define KRD(G,j) do{ if((G)&&(DQK==64||(j)<2)){ kload2(kf,kp0+sl_next,j); SBAR(); } }while(0)
  #define STEP(C0,C1,P0,P1,t,GK,GV,GL) do{ SBAR(); \
    const lds_cptr vp_=vp0+sl_prev; \
    VRD(0); SBAR(); float sacc=(P0[0]+P0[1]); \
    GAPA(C0=__builtin_amdgcn_mfma_f32_32x32x16_bf16(kf[0],qr[0],negm,0,0,0), P0[2],P0[3],P0[4],P0[5],     pw0[0]=PKW(P0,0), pw0[1]=PKW(P0,2), pw0); \
    VRD(4); SBAR(); GAPA(C1=__builtin_amdgcn_mfma_f32_32x32x16_bf16(kf[1],qr[0],negm,0,0,0), P0[6],P0[7],P0[8],P0[9],     pw0[2]=PKW(P0,4), pw0[3]=PKW(P0,6), pw0); \
    VRD(1); SBAR(); GAPA(C0=__builtin_amdgcn_mfma_f32_32x32x16_bf16(kf[2],qr[1],C0,0,0,0),   P0[10],P0[11],P0[12],P0[13], pw1[0]=PKW(P0,8), pw1[1]=PKW(P0,10), pw1); \
    VRD(5); SBAR(); GAPA(C1=__builtin_amdgcn_mfma_f32_32x32x16_bf16(kf[3],qr[1],C1,0,0,0),   P0[14],P0[15],P1[0],P1[1],   pw1[2]=PKW(P0,12),pw1[3]=PKW(P0,14), pw1); \
    VRD(2); SBAR(); GAPA(if constexpr(DQK==64){C0=__builtin_amdgcn_mfma_f32_32x32x16_bf16(kf[4],qr[2],C0,0,0,0);},   P1[2],P1[3],P1[4],P1[5],     pw2[0]=PKW(P1,0), pw2[1]=PKW(P1,2), pw2); \
    VRD(6); SBAR(); GAPA(if constexpr(DQK==64){C1=__builtin_amdgcn_mfma_f32_32x32x16_bf16(kf[5],qr[2],C1,0,0,0);},   P1[6],P1[7],P1[8],P1[9],     pw2[2]=PKW(P1,4), pw2[3]=PKW(P1,6), pw2); \
    VRD(3); SBAR(); GAPA(if constexpr(DQK==64){C0=__builtin_amdgcn_mfma_f32_32x32x16_bf16(kf[6],qr[3],C0,0,0,0);},   P1[10],P1[11],P1[12],P1[13], pw3[0]=PKW(P1,8), pw3[1]=PKW(P1,10), pw3); \
    VRD(7); SBAR(); GAPA(if constexpr(DQK==64){C1=__builtin_amdgcn_mfma_f32_32x32x16_bf16(kf[7],qr[3],C1,0,0,0);},   P1[14],P1[15],0.f,0.f,       pw3[2]=PKW(P1,12),pw3[3]=PKW(P1,14), pw3); \
    l_reg+=sacc; \
    if(GK){DMA_K((t)+3,sl_cur);} if(GV){DMA_V((t)+1,sl_next);} \
    CMASK(C0,C1,t); \
    if constexpr(!FIXM){ float a=MX3(C0[0],C0[1],C1[0]),b=MX3(C0[2],C0[3],C1[1]); a=MX3(a,C1[2],C1[3]); \
      _Pragma("unroll") for(int r=4;r<16;r+=4){a=MX3(a,C0[r],C0[r+1]);b=MX3(b,C0[r+2],C0[r+3]);a=MX3(a,C1[r],C1[r+1]);b=MX3(b,C1[r+2],C1[r+3]);} \
      float rm=__builtin_fmaxf(a,b); { auto rr=__builtin_amdgcn_permlane32_swap(__float_as_uint(rm),__float_as_uint(rm),false,false); rm=__builtin_fmaxf(__uint_as_float(rr[0]),__uint_as_float(rr[1])); } \
      resc=false; \
      if(__builtin_expect(__any(rm>(float)THRL),0)){ const float dl=__builtin_fmaxf(rm,0.f); mhat+=dl; \
        _Pragma("unroll") for(int r=0;r<16;++r){C0[r]-=dl;C1[r]-=dl;} \
        _Pragma("unroll") for(int r=0;r<16;++r)negm[r]=-mhat; asm volatile("":"+v"(negm)); \
        const float f=__builtin_amdgcn_exp2f(-dl); l_reg*=f; if(hi==0)wsf[r32]=f; resc=true; } } \
    SBAR(); \
    GAPB(o[0]=__builtin_amdgcn_mfma_f32_32x32x16_bf16(PAF(0),VFR(0),o[0],0,0,0), C0,0); \
    GAPB(o[1]=__builtin_amdgcn_mfma_f32_32x32x16_bf16(PAF(0),VFR(4),o[1],0,0,0), C0,4); \
    KRD(GL,0); GAPB(o[0]=__builtin_amdgcn_mfma_f32_32x32x16_bf16(PAF(1),VFR(1),o[0],0,0,0), C0,8); \
    KRD(GL,1); GAPB(o[1]=__builtin_amdgcn_mfma_f32_32x32x16_bf16(PAF(1),VFR(5),o[1],0,0,0), C0,12); \
    KRD(GL,2); GAPB(o[0]=__builtin_amdgcn_mfma_f32_32x32x16_bf16(PAF(2),VFR(2),o[0],0,0,0), C1,0); \
    KRD(GL,3); GAPB(o[1]=__builtin_amdgcn_mfma_f32_32x32x16_bf16(PAF(2),VFR(6),o[1],0,0,0), C1,4); \
    GAPB(o[0]=__builtin_amdgcn_mfma_f32_32x32x16_bf16(PAF(3),VFR(3),o[0],0,0,0), C1,8); \
    GAPB(o[1]=__builtin_amdgcn_mfma_f32_32x32x16_bf16(PAF(3),VFR(7),o[1],0,0,0), C1,12); \
    }while(0)
  int t=1;
  #undef CMASK
  #define CMASK(P0,P1,t) do{}while(0)
  for(;t+5<NT;t+=2){
    STEP(pB0,pB1,pA0,pA1,t,true,true,true);     WAIT_BAR(2); RESC(); ROT();
    STEP(pA0,pA1,pB0,pB1,t+1,true,true,true);   WAIT_BAR(2); RESC(); ROT();
  }
  #undef CMASK
  #define CMASK(P0,P1,t) do{}while(0)
  #define ENDW(tt) do{ if((tt)+3<NT){WAIT_BAR(2);} else if((tt)+2<NT){WAIT_BAR(1);} else {WAIT_BAR(0);} }while(0)
  for(;t+1<NT;t+=2){
    STEP(pB0,pB1,pA0,pA1,t,(t+3<NT),(t+1<NT),(t+1<NT));       ENDW(t);   RESC(); ROT();
    STEP(pA0,pA1,pB0,pB1,t+1,(t+4<NT),(t+2<NT),(t+2<NT));     ENDW(t+1); RESC(); ROT();
  }
  STEP(pB0,pB1,pA0,pA1,NT-1,false,false,false); RESC();
  { float sacc=pB0[0]+pB0[1]; _Pragma("unroll") for(int r=2;r<16;++r)sacc+=pB0[r]; _Pragma("unroll") for(int r=0;r<16;++r)sacc+=pB1[r]; l_reg+=sacc;
    pw0=(u32x4){PKW(pB0,0),PKW(pB0,2),PKW(pB0,4),PKW(pB0,6)};pw1=(u32x4){PKW(pB0,8),PKW(pB0,10),PKW(pB0,12),PKW(pB0,14)};pw2=(u32x4){PKW(pB1,0),PKW(pB1,2),PKW(pB1,4),PKW(pB1,6)};pw3=(u32x4){PKW(pB1,8),PKW(pB1,10),PKW(pB1,12),PKW(pB1,14)};
    SBAR(); pv(o,vb0+sl_cur,PAF(0),PAF(1),PAF(2),PAF(3)); }
  #undef PKW
  #undef PAF
  #undef VFR
  #undef PIN
  #undef MX3
  #undef GAPA
  #undef GAPB
  #undef EX
  #undef VRD
  #undef KRD
  #undef STEP
  #undef ENDW
  {auto rr=__builtin_amdgcn_permlane32_swap(__float_as_uint(l_reg),__float_as_uint(l_reg),false,false);l_reg=__uint_as_float(rr[0])+__uint_as_float(rr[1]);}
  if(hi==0)wsf[32+r32]=l_reg;asm volatile("s_waitcnt lgkmcnt(0)":::"memory");
  float rli[16];
  #pragma unroll
  for(int r=0;r<16;++r)rli[r]=__builtin_amdgcn_rcpf(wsf[32+crow(r,hi)]);
  bf16*Ow=Ou+(long)(wid*QBLK)*po;
  { bf16*stg=(bf16*)(shm+LDS_OST)+wid*2048;
    #pragma unroll
    for(int r=0;r<16;++r){const int orow=crow(r,hi);
      #pragma unroll
      for(int d0=0;d0<2;++d0)stg[orow*64+d0*32+r32]=__float2bfloat16(o[d0][r]*rli[r]);}
    asm volatile("s_waitcnt lgkmcnt(0)":::"memory");
    #pragma unroll
    for(int i=0;i<4;++i){const int row=i*8+(lane>>3),ch=lane&7; const u32x4 v=*(const u32x4*)(stg+row*64+ch*8); ATTN_STORE16(Ow+(long)row*po+ch*8,v);} }
  asm volatile("s_waitcnt lgkmcnt(0)\n\ts_barrier":::"memory");
  #undef DMA_K
  #undef DMA_V
  #undef CMASK
  #undef START
  #undef RESC
  #undef ROT
}
constexpr int ATTN_LDS_BYTES=LDS_BYTES;
#undef SBAR
#undef WAIT_BAR
}

__device__ __forceinline__ void phase_pro_a(const Params& p, LAS unsigned char* lds) {
    const int gtid = obid() * NTHR + otid(), GT = gridDim.x * NTHR;
    {
        LAS float* sl = (LAS float*)lds; const int tid = otid();
        for (int bi = obid(); bi < 2 * 8 * 16; bi += gridDim.x) {
            const int l = bi >> 7, kq = (bi >> 4) & 7, n = (bi & 15) * 384 + tid;
            __syncthreads();
            for (int e = tid; e < 5 * 128; e += NTHR) { const int v = e >> 7, k = kq * 128 + (e & 127); const float cv = v < 4 ? p.in[1][v * D + k] : p.in[3][k]; sl[e] = cv / (1.f + expf(-cv)); }
            __syncthreads();
            if (tid < 384) {
                const float* W = p.in[4] + (size_t)l * D * 6144 + (size_t)(kq * 128) * 6144 + n;
                float acc[5] = {0.f, 0.f, 0.f, 0.f, 0.f};
#pragma unroll 32
                for (int k = 0; k < 128; ++k) { const float w = W[(size_t)k * 6144];
#pragma unroll
                    for (int v = 0; v < 5; ++v) acc[v] += sl[v * 128 + k] * w; }
                float* modp = (float*)(p.ws + WS_MODP);
#pragma unroll
                for (int v = 0; v < 5; ++v) modp[((size_t)(kq * 2 + l) * 5 + v) * 6144 + n] = acc[v];
            }
        }
        __syncthreads();
    }
    constexpr int N_A = 0, N_B = 192 * 16, N_C = 192 * 8, N_D = 2 * 2 * 16 * 64 * 34, N_E = 2, N_K = 2 * 16 * 128 * 128 / 2;
    float2* tabA = (float2*)(p.ws + WS_TABA); float2* tabB = (float2*)(p.ws + WS_TABB);
    float* scal = (float*)(p.ws + WS_SCAL);
    float2* apow = (float2*)(p.ws + WS_APOW); float2* bbar = (float2*)(p.ws + WS_BBAR);
    for (int it = gtid; it < N_A + N_B + N_C + N_D + N_E + N_K; it += GT) {
        int r = it;
        if (r >= N_A + N_B + N_C + N_D + N_E) { r -= N_A + N_B + N_C + N_D + N_E; ((unsigned*)(p.ws + WS_KEYS16))[r] = pk2(p.in[29][2 * r], p.in[29][2 * r + 1]); continue; }
        r -= N_A;
        if (r < N_B) {
            const int e = r / 16, j = r % 16; const int pos = e < 128 ? e : e - 128;
            const float inv = (float)exp(-((double)(2 * j) / 32.0) * 9.210340371976184);
            const float ang = (float)pos * inv; double s, c; sincos_d((double)ang, s, c);
            tabA[r] = make_float2((float)c, (float)s); continue;
        }
        r -= N_B;
        if (r < N_C) {
            const int e = r / 8, j = r % 8; const int pos = e < 128 ? e : e - 128;
            const float inv = (float)exp(-((double)(2 * j) / 16.0) * 9.210340371976184);
            const float ang = (float)pos * inv; double s, c; sincos_d((double)ang, s, c);
            tabB[r] = make_float2((float)c, (float)s); continue;
        }
        r -= N_C;
        if (r < N_D) {
            const int m = r % 34; r /= 34;
            const int ldg = r / 64;
            const double are = p.in[19][r], aim = p.in[20][r], dt = exp((double)p.in[21][ldg]);
            if (m <= 32) { const double em = exp(are * dt * (double)m); double sm, cm; sincos_d(aim * dt * (double)m, sm, cm); apow[(size_t)r * 33 + m] = make_float2((float)(em * cm), (float)(em * sm)); continue; }
            const double er = exp(are * dt); double sn, cs; sincos_d(aim * dt, sn, cs);
            const double abr = er * cs, abi = er * sn;
            const double nr = abr - 1.0, ni = abi, den = are * are + aim * aim;
            const double cr = (nr * are + ni * aim) / den, ci = (ni * are - nr * aim) / den;
#pragma unroll 1
            for (int q = 0; q < 16; ++q) { const double br = p.in[22][(size_t)r * 16 + q], bi = p.in[23][(size_t)r * 16 + q];
                bbar[(size_t)r * 16 + q] = make_float2((float)(cr * br - ci * bi), (float)(cr * bi + ci * br)); }
            continue;
        }
        r -= N_D;
        {
            const int l = r; float s1 = 0.f, s2 = 0.f;
            for (int i = 0; i < 32; ++i) { s1 += p.in[14][l * 32 + i] * p.in[15][l * 32 + i]; s2 += p.in[16][l * 32 + i] * p.in[17][l * 32 + i]; }
            const float lam_init = 0.8f - 0.6f * expf(-0.3f * (float)l);
            scal[l] = expf(s1) - expf(s2) + lam_init;
            float mqa = 0.f, mka = 0.f, mqb = 0.f, mkb = 0.f;
            for (int i = 0; i < 64; ++i) { mqa = fmaxf(mqa, fabsf(p.in[10][l * 64 + i])); mka = fmaxf(mka, fabsf(p.in[11][l * 64 + i])); }
            for (int i = 0; i < 32; ++i) { mqb = fmaxf(mqb, fabsf(p.in[12][l * 32 + i])); mkb = fmaxf(mkb, fabsf(p.in[13][l * 32 + i])); }
            scal[2 + l] = fminf(LOG2E * 8.f * mqa * mka * 1.02f, 60.f);
            scal[4 + l] = fminf(LOG2E * 5.656854249f * mqb * mkb * 1.02f, 60.f);
        }
    }
}
__device__ __forceinline__ void phase_pro_b(const Params& p, LAS unsigned char* lds) {
    const int gtid = obid() * NTHR + otid(), GT = gridDim.x * NTHR;
    const float* modp = (const float*)(p.ws + WS_MODP); float* mod = (float*)(p.ws + WS_MOD);
    for (int it = gtid; it < 2 * 5 * 6144; it += GT) {
        const int l = it / (5 * 6144), v = (it / 6144) % 5, n = it % 6144;
        float a = p.in[5][l * 6144 + n];
        for (int kq = 0; kq < 8; ++kq) a += modp[((size_t)(kq * 2 + l) * 5 + v) * 6144 + n];
        mod[it] = a;
    }
    const float2* apow = (const float2*)(p.ws + WS_APOW); const float2* bbar = (const float2*)(p.ws + WS_BBAR);
    bf16_t* KT = (bf16_t*)(p.ws + WS_KT); bf16_t* B2 = (bf16_t*)(p.ws + WS_B2CAT); bf16_t* G2 = (bf16_t*)(p.ws + WS_G2CAT);
    {
        const int tid = otid(), G_ = (int)gridDim.x, NBCk = G_ >= 32 ? G_ / 32 : 1;
        LAS float* lb = (LAS float*)lds;
        LAS float* la = lb + 2 * 64 * 32;
        LAS float* lcr = la + 2 * 64 * 66;
        LAS float* lci = lcr + 2 * 16 * 64;
        for (int combo = obid() / NBCk; combo < 32; combo += G_ / NBCk) {
            const int l = combo >> 4, g = combo & 15, sb = obid() % NBCk;
            __syncthreads();
#pragma unroll 1
            for (int dir = 0; dir < 2; ++dir) { const int pb = (l * 2 + dir) * 16 + g;
                const f32x4* sb4 = (const f32x4*)((const float*)bbar + (size_t)pb * 64 * 32); const f32x4* sa4 = (const f32x4*)((const float*)apow + (size_t)pb * 64 * 66);
                const f32x4* sr4 = (const f32x4*)(p.in[24] + (size_t)pb * 16 * 64); const f32x4* si4 = (const f32x4*)(p.in[25] + (size_t)pb * 16 * 64);
                *(LAS f32x4*)(lb + dir * 2048 + 4 * tid) = sb4[tid];
                for (int e = tid; e < 1056; e += NTHR) *(LAS f32x4*)(la + dir * 4224 + 4 * e) = sa4[e];
                if (tid < 256) *(LAS f32x4*)(lcr + dir * 1024 + 4 * tid) = sr4[tid]; else *(LAS f32x4*)(lci + dir * 1024 + 4 * (tid - 256)) = si4[tid - 256]; }
            __syncthreads();
            for (int t = sb * NTHR + tid; t < 63 * 16 * 4; t += NBCk * NTHR) {
                const int itl = t >> 2, nq = t & 3, pp = itl & 15, idx = itl >> 4;
                const int lam = idx - 31; float val[16];
#pragma unroll
                for (int q = 0; q < 16; ++q) val[q] = 0.f;
#pragma unroll 1
                for (int dir = 0; dir < 2; ++dir) {
                    if (dir == 0 ? lam < 0 : lam > 0) continue;
                    const int m = lam < 0 ? -lam : lam;
#pragma unroll 4
                    for (int jn = 0; jn < 16; ++jn) { const int n = 4 * jn + nq; const f32x2 A = *(const LAS f32x2*)(la + ((dir * 64 + n) * 33 + m) * 2);
                        const float cr = lcr[(dir * 16 + pp) * 64 + n], ci = lci[(dir * 16 + pp) * 64 + n];
                        const float zr = cr * A.x - ci * A.y, zi = cr * A.y + ci * A.x;
                        const LAS f32x4* bq = (const LAS f32x4*)(lb + (dir * 64 + n) * 32);
#pragma unroll
                        for (int q2 = 0; q2 < 8; ++q2) { const f32x4 bb = bq[q2]; val[2 * q2] += zr * bb.x - zi * bb.y; val[2 * q2 + 1] += zr * bb.z - zi * bb.w; } }
                }
#pragma unroll
                for (int q = 0; q < 16; ++q) { val[q] += __shfl_xor(val[q], 1); val[q] += __shfl_xor(val[q], 2); }
                if (lam == 0) {
#pragma unroll
                    for (int q = 0; q < 16; ++q) if (q == pp) val[q] += p.in[26][l * 256 + g * 16 + pp];
                }
                if (nq == 0) {
                    u32x4 o0, o1;
                    o0.x = pk2(val[0], val[1]); o0.y = pk2(val[2], val[3]); o0.z = pk2(val[4], val[5]); o0.w = pk2(val[6], val[7]);
                    o1.x = pk2(val[8], val[9]); o1.y = pk2(val[10], val[11]); o1.z = pk2(val[12], val[13]); o1.w = pk2(val[14], val[15]);
                    bf16_t* kd = KT + ((size_t)(l * 16 + g) * (63 * 16) + itl) * 16;
                    *(u32x4*)kd = o0; *(u32x4*)(kd + 8) = o1;
                }
            }
            for (int t = sb * NTHR + tid; t < 256 * 64; t += NBCk * NTHR) {
                const int col8 = t & 63, k = t >> 6;
                const int dir = k >> 7, part = (k >> 6) & 1, n = k & 63, i = col8 >> 1, q0 = (col8 & 1) * 8; const int e = dir == 0 ? 31 - i : i;
                const f32x2 A = *(const LAS f32x2*)(la + ((dir * 64 + n) * 33 + e) * 2); const LAS f32x4* bq = (const LAS f32x4*)(lb + (dir * 64 + n) * 32 + q0 * 2);
                float v[8];
#pragma unroll
                for (int q2 = 0; q2 < 4; ++q2) { const f32x4 bb = bq[q2];
                    v[2 * q2] = part == 0 ? A.x * bb.x - A.y * bb.y : A.x * bb.y + A.y * bb.x; v[2 * q2 + 1] = part == 0 ? A.x * bb.z - A.y * bb.w : A.x * bb.w + A.y * bb.z; }
                u32x4 o; o.x = pk2(v[0], v[1]); o.y = pk2(v[2], v[3]); o.z = pk2(v[4], v[5]); o.w = pk2(v[6], v[7]);
                *(u32x4*)(B2 + ((size_t)(l * 16 + g) * (256 * 64) + t) * 8) = o;
            }
            for (int t = sb * NTHR + tid; t < 512 * 32; t += NBCk * NTHR) {
                const int k8 = t & 31, row = t >> 5;
                const int k = k8 * 8, dir = k >> 7, part = (k >> 6) & 1, n0 = k & 63, i = row >> 4, pp = row & 15; const int e = dir == 0 ? i + 1 : 32 - i;
                float v[8];
#pragma unroll
                for (int jn = 0; jn < 8; ++jn) { const f32x2 A = *(const LAS f32x2*)(la + ((dir * 64 + n0 + jn) * 33 + e) * 2); const float cr = lcr[(dir * 16 + pp) * 64 + n0 + jn], ci = lci[(dir * 16 + pp) * 64 + n0 + jn];
                    v[jn] = part == 0 ? cr * A.x - ci * A.y : -(cr * A.y + ci * A.x); }
                u32x4 o; o.x = pk2(v[0], v[1]); o.y = pk2(v[2], v[3]); o.z = pk2(v[4], v[5]); o.w = pk2(v[6], v[7]);
                *(u32x4*)(G2 + ((size_t)(l * 16 + g) * (512 * 32) + t) * 8) = o;
            }
        }
        __syncthreads();
    }
}
__device__ __forceinline__ void phase_norm(const Params& p, int layer, int which) {
    const int wave = otid() >> 6, lane = otid() & 63;
    const float* mod = (const float*)(p.ws + WS_MOD) + (size_t)layer * 5 * 6144;
    const float* gain = (which ? p.in[7] : p.in[6]) + layer * D;
    bf16_t* H = (bf16_t*)(p.ws + WS_H);
    const bool xin_ws = (which == 1) || (layer == 1);
    const bool lat = (which == 1 && layer == 1);
    const int nrows = lat ? NB * L : ROWS, rstart = (obid() * NWAVE + wave) * 4, rstep = gridDim.x * NWAVE * 4;
    f32x4 gs[4], shv[4]; int mcur = -1;
#pragma unroll
    for (int q = 0; q < 4; ++q) { gs[q] = (f32x4){0.f, 0.f, 0.f, 0.f}; shv[q] = gs[q]; }
    const int nfull = (nrows / rstep) * rstep;
    for (int li = rstart; li < nfull; li += rstep) {
        const int r0 = lat ? (li >> 13) * RPB + LC + (li & 8191) : li; const int b = r0 / RPB, j = r0 - b * RPB;
        const float* xr = xin_ws ? (const float*)(p.ws + WS_X) + (size_t)r0 * D : src_row(p, 0, r0);
        f32x4 v[16];
#pragma unroll
        for (int q = 0; q < 16; ++q) v[q] = *(const f32x4*)(xr + (size_t)(q >> 2) * D + 4 * lane + 256 * (q & 3));
        const int mrow = j < LC ? 4 : b;
        if (mrow != mcur) { mcur = mrow; const float* mv = mod + (size_t)mrow * 6144;
#pragma unroll
            for (int q = 0; q < 4; ++q) { const int c = 4 * lane + 256 * q;
                const f32x4 g = *(const f32x4*)(gain + c); const f32x4 sc = *(const f32x4*)(mv + (which ? 4 : 1) * D + c);
                shv[q] = *(const f32x4*)(mv + (which ? 3 : 0) * D + c);
                gs[q].x = g.x * (1.f + sc.x); gs[q].y = g.y * (1.f + sc.y); gs[q].z = g.z * (1.f + sc.z); gs[q].w = g.w * (1.f + sc.w); } }
        float ss[4];
#pragma unroll
        for (int k = 0; k < 4; ++k) { ss[k] = 0.f;
#pragma unroll
            for (int q = 0; q < 4; ++q) { const f32x4 t = v[4 * k + q]; ss[k] += t.x * t.x + t.y * t.y + t.z * t.z + t.w * t.w; } }
#pragma unroll
        for (int o = 1; o < 64; o <<= 1) {
#pragma unroll
            for (int k = 0; k < 4; ++k) ss[k] += __shfl_xor(ss[k], o); }
#pragma unroll
        for (int k = 0; k < 4; ++k) {
            const float rinv = 1.f / sqrtf(ss[k] * (1.f / D) + EPS);
#pragma unroll
            for (int q = 0; q < 4; ++q) { const int c = 4 * lane + 256 * q; const f32x4 t = v[4 * k + q];
                const float y0 = t.x * rinv * gs[q].x + shv[q].x, y1 = t.y * rinv * gs[q].y + shv[q].y;
                const float y2 = t.z * rinv * gs[q].z + shv[q].z, y3 = t.w * rinv * gs[q].w + shv[q].w;
                u32x2 o; o.x = pk2(y0, y1); o.y = pk2(y2, y3);
                *(u32x2*)(H + (size_t)(r0 + k) * D + c) = o; }
        }
    }
    for (int li = nfull + obid() * NWAVE + wave; li < nrows; li += gridDim.x * NWAVE) {
        const int r0 = lat ? (li >> 13) * RPB + LC + (li & 8191) : li; const int b = r0 / RPB, j = r0 - b * RPB;
        const float* xr = xin_ws ? (const float*)(p.ws + WS_X) + (size_t)r0 * D : src_row(p, 0, r0);
        f32x4 v[4];
#pragma unroll
        for (int q = 0; q < 4; ++q) v[q] = *(const f32x4*)(xr + 4 * lane + 256 * q);
        const int mrow = j < LC ? 4 : b;
        if (mrow != mcur) { mcur = mrow; const float* mv = mod + (size_t)mrow * 6144;
#pragma unroll
            for (int q = 0; q < 4; ++q) { const int c = 4 * lane + 256 * q;
                const f32x4 g = *(const f32x4*)(gain + c); const f32x4 sc = *(const f32x4*)(mv + (which ? 4 : 1) * D + c);
                shv[q] = *(const f32x4*)(mv + (which ? 3 : 0) * D + c);
                gs[q].x = g.x * (1.f + sc.x); gs[q].y = g.y * (1.f + sc.y); gs[q].z = g.z * (1.f + sc.z); gs[q].w = g.w * (1.f + sc.w); } }
        float ss = 0.f;
#pragma unroll
        for (int q = 0; q < 4; ++q) { const f32x4 t = v[q]; ss += t.x * t.x + t.y * t.y + t.z * t.z + t.w * t.w; }
        const float rinv = 1.f / sqrtf(wave_sum(ss) * (1.f / D) + EPS);
#pragma unroll
        for (int q = 0; q < 4; ++q) { const int c = 4 * lane + 256 * q; const f32x4 t = v[q];
            const float y0 = t.x * rinv * gs[q].x + shv[q].x, y1 = t.y * rinv * gs[q].y + shv[q].y;
            const float y2 = t.z * rinv * gs[q].z + shv[q].z, y3 = t.w * rinv * gs[q].w + shv[q].w;
            u32x2 o; o.x = pk2(y0, y1); o.y = pk2(y2, y3);
            *(u32x2*)(H + (size_t)r0 * D + c) = o; }
    }
}
template <int GL>
__device__ __forceinline__ void norm_rope_pass(bf16_t* prow, int colbase, const float* gain, const float2* tab, int tok, float scale, int lane) {
    const int pi = lane & (GL - 1), hsel = lane / GL;
    bf16_t* ptr = prow + colbase + hsel * (2 * GL) + 2 * pi;
    const unsigned raw = *(const unsigned*)ptr;
    const float x0 = bf2f(raw & 0xffffu), x1 = bf2f(raw >> 16);
    float ss = x0 * x0 + x1 * x1;
#pragma unroll
    for (int o = 1; o < GL; o <<= 1) ss += __shfl_xor(ss, o);
    const float rinv = 1.f / sqrtf(ss * (1.f / (2 * GL)) + EPS);
    float y0 = x0 * rinv * gain[2 * pi], y1 = x1 * rinv * gain[2 * pi + 1];
    if (tok >= 0) {
        constexpr int Q = GL / 2;
        const int e = pi < Q ? (tok >> 6) : 128 + (tok & 63);
        const float2 cs = tab[e * Q + (pi & (Q - 1))];
        const float o0 = y0 * cs.x - y1 * cs.y, o1 = y0 * cs.y + y1 * cs.x; y0 = o0; y1 = o1;
    }
    *(unsigned*)ptr = pk2(y0 * scale, y1 * scale);
}
__device__ __forceinline__ void phase_qkrope_s5a(const Params& p, int layer, LAS unsigned char* lds) {
    const int wave = otid() >> 6, lane = otid() & 63;
    bf16_t* P = (bf16_t*)(p.ws + WS_P);
    const float2* tabA = (const float2*)(p.ws + WS_TABA); const float2* tabB = (const float2*)(p.ws + WS_TABB);
    const float* qna = p.in[10] + layer * 64; const float* kna = p.in[11] + layer * 64;
    const float* qnb = p.in[12] + layer * 32; const float* knb = p.in[13] + layer * 32;
    const float scA = 0.125f * LOG2E, scB = 0.17677669529663687f * LOG2E;
    float gA[8], gB[8], gBk[8];
    {   const int hA = lane >> 3, dA = (lane & 7) * 8, dB = (lane & 3) * 8;
#pragma unroll
        for (int i = 0; i < 8; ++i) { gA[i] = (hA < 6 ? qna : kna)[dA + i] * (hA < 6 ? scA : 1.f); gB[i] = lane < 48 ? qnb[dB + i] * scB : knb[dB + i]; gBk[i] = knb[dB + i]; } }
#define QKR_PASS(colbase, NL, gsel, LSEL, DOST, WIN, T0, T1) do { \
        bf16_t* ptr_ = prow + (colbase) + (LSEL) * 8; const u32x4 w_ = (WIN); const unsigned ww_[4] = {w_.x, w_.y, w_.z, w_.w}; \
        float x_[8]; float ss_ = 0.f; \
        _Pragma("unroll") for (int q_ = 0; q_ < 4; ++q_) { x_[2 * q_] = bf2f(ww_[q_] & 0xffffu); x_[2 * q_ + 1] = bf2f(ww_[q_] >> 16); ss_ += x_[2 * q_] * x_[2 * q_] + x_[2 * q_ + 1] * x_[2 * q_ + 1]; } \
        ss_ += __int_as_float(__builtin_amdgcn_update_dpp(0, __float_as_int(ss_), 0xB1, 0xf, 0xf, true)); \
        ss_ += __int_as_float(__builtin_amdgcn_update_dpp(0, __float_as_int(ss_), 0x4E, 0xf, 0xf, true)); \
        if ((NL) == 8) { const float t7_ = __int_as_float(__builtin_amdgcn_update_dpp(0, __float_as_int(ss_), 0x141, 0xf, 0xf, true)); ss_ += __int_as_float(__builtin_amdgcn_update_dpp(0, __float_as_int(t7_), 0x1B, 0xf, 0xf, true)); } \
        const float rinv_ = 1.f / sqrtf(ss_ * (1.f / ((NL) * 8)) + EPS); \
        const f32x4 t0_ = (T0), t1_ = (T1); const float cs_[8] = {t0_.x, t0_.y, t0_.z, t0_.w, t1_.x, t1_.y, t1_.z, t1_.w}; \
        unsigned o_[4]; \
        _Pragma("unroll") for (int q_ = 0; q_ < 4; ++q_) { const float y0_ = x_[2 * q_] * rinv_ * gsel[2 * q_], y1_ = x_[2 * q_ + 1] * rinv_ * gsel[2 * q_ + 1]; \
            o_[q_] = pk2(y0_ * cs_[2 * q_] - y1_ * cs_[2 * q_ + 1], y0_ * cs_[2 * q_ + 1] + y1_ * cs_[2 * q_]); } \
        u32x4 ov_; ov_.x = o_[0]; ov_.y = o_[1]; ov_.z = o_[2]; ov_.w = o_[3]; if (DOST) *(u32x4*)ptr_ = ov_; } while (0)
#define QKR_LOAD(S, rr) do { const int r_ = (rr); const int b_ = r_ / RPB, j_ = r_ - b_ * RPB; const int tk_ = j_ < LC ? 0 : j_ - LC; const bf16_t* pr_ = P + (size_t)r_ * INW; \
        S##d0 = *(const u32x4*)(pr_ + lane * 8); S##d1 = *(const u32x4*)(pr_ + C_QB + lane * 8); S##d2 = *(const u32x4*)(pr_ + C_QB + 512 + (lane & 31) * 8); \
        {   const int pl_ = lane & 7; const int e_ = pl_ < 4 ? (tk_ >> 6) : 128 + (tk_ & 63); const float* tp_ = (const float*)tabA + ((size_t)e_ * 16 + (pl_ & 3) * 4) * 2; S##a0 = *(const f32x4*)tp_; S##a1 = *(const f32x4*)(tp_ + 4); } \
        {   const int pl_ = lane & 3; const int e_ = pl_ < 2 ? (tk_ >> 6) : 128 + (tk_ & 63); const float* tp_ = (const float*)tabB + ((size_t)e_ * 8 + (pl_ & 1) * 4) * 2; S##b0 = *(const f32x4*)tp_; S##b1 = *(const f32x4*)(tp_ + 4); } } while (0)
#define QKR_ROW(S, rr) do { bf16_t* prow = P + (size_t)(rr) * INW; \
        QKR_PASS(0, 8, gA, lane, true, S##d0, S##a0, S##a1);                          \
        QKR_PASS(C_QB, 4, gB, lane, true, S##d1, S##b0, S##b1);                       \
        QKR_PASS(C_QB + 512, 4, gBk, (lane & 31), lane < 32, S##d2, S##b0, S##b1);    } while (0)
    {   const int pstart = obid() * NWAVE + wave, pstep = gridDim.x * NWAVE, npair = ROWS / 2;
        const u32x4 z4 = {0u, 0u, 0u, 0u}; const f32x4 zf = {0.f, 0.f, 0.f, 0.f};
        u32x4 Ad0 = z4, Ad1 = z4, Ad2 = z4, Bd0 = z4, Bd1 = z4, Bd2 = z4; f32x4 Aa0 = zf, Aa1 = zf, Ab0 = zf, Ab1 = zf, Ba0 = zf, Ba1 = zf, Bb0 = zf, Bb1 = zf;
        if (pstart < npair) { QKR_LOAD(A, 2 * pstart); QKR_LOAD(B, 2 * pstart + 1); }
        for (int pi = pstart; pi < npair; pi += pstep) {
            const u32x4 Cd0 = Ad0, Cd1 = Ad1, Cd2 = Ad2, Ed0 = Bd0, Ed1 = Bd1, Ed2 = Bd2; const f32x4 Ca0 = Aa0, Ca1 = Aa1, Cb0 = Ab0, Cb1 = Ab1, Ea0 = Ba0, Ea1 = Ba1, Eb0 = Bb0, Eb1 = Bb1;
            if (pi + pstep < npair) { QKR_LOAD(A, 2 * (pi + pstep)); QKR_LOAD(B, 2 * (pi + pstep) + 1); }
            QKR_ROW(C, 2 * pi);
            QKR_ROW(E, 2 * pi + 1);
        }
    }
#undef QKR_PASS
#undef QKR_LOAD
#undef QKR_ROW
    {
        const int tid = otid(), r32 = lane & 31, hi = lane >> 5;
        const bf16_t* B2 = (const bf16_t*)(p.ws + WS_B2CAT) + (size_t)layer * 16 * 256 * 512;
        float* S = (float*)(p.ws + WS_S5S);
        const int NBC = (int)gridDim.x >= 32 ? (int)gridDim.x / 32 : 1;
        for (int combo = obid() / NBC; combo < 32; combo += (int)gridDim.x / NBC) {
            const int g = combo >> 1, mh = combo & 1, sb = obid() % NBC;
            __syncthreads();
            {   const bf16_t* bsrc = B2 + (size_t)(g * 256 + 128 * mh) * 512;
#pragma unroll 1
                for (int q0 = 0; q0 < 16; q0 += 8) { u32x4 t[8];
#pragma unroll
                    for (int q = 0; q < 8; ++q) { const int e = tid + (q0 + q) * NTHR; t[q] = *(const u32x4*)(bsrc + (size_t)(e >> 6) * 512 + (e & 63) * 8); }
#pragma unroll
                    for (int q = 0; q < 8; ++q) { const int e = tid + (q0 + q) * NTHR; *(LAS u32x4*)(lds + (e >> 6) * 1040 + (e & 63) * 16) = t[q]; } } }
            __syncthreads();
            for (int ct = sb * NWAVE + wave; ct < 33; ct += NBC * NWAVE) {
                f32x16_t acc[4];
#pragma unroll
                for (int mt = 0; mt < 4; ++mt) acc[mt] = (f32x16_t){0.f,0.f,0.f,0.f,0.f,0.f,0.f,0.f,0.f,0.f,0.f,0.f,0.f,0.f,0.f,0.f};
                const bf16_t* up = P + (size_t)((ct * 32 + r32) * 32) * INW + C_US + g * 16 + 8 * hi;
                const LAS unsigned char* al = lds + r32 * 1040 + 16 * hi;
#define S_LOAD(buf, k0) do { _Pragma("unroll") for (int i_ = 0; i_ < 8; ++i_) buf[i_] = *(const bf16x8_t*)(up + (size_t)((k0) + i_) * INW); } while (0)
#define S_COMP(buf, k0) do { _Pragma("unroll") for (int i_ = 0; i_ < 8; ++i_) { \
            _Pragma("unroll") for (int mt = 0; mt < 4; ++mt) { const bf16x8_t av = *(const LAS bf16x8_t*)(al + mt * (32 * 1040) + ((k0) + i_) * 32); acc[mt] = __builtin_amdgcn_mfma_f32_32x32x16_bf16(av, buf[i_], acc[mt], 0, 0, 0); } \
            __builtin_amdgcn_sched_barrier(0); } } while (0)
                bf16x8_t ua[8], ub[8];
                S_LOAD(ua, 0); S_LOAD(ub, 8);
                S_COMP(ua, 0); S_LOAD(ua, 16);
                S_COMP(ub, 8); S_LOAD(ub, 24);
                S_COMP(ua, 16); S_COMP(ub, 24);
#undef S_LOAD
#undef S_COMP
                float* sp = S + ((size_t)(ct * 32 + r32) * 16 + g) * 256 + 128 * mh + 4 * hi;
#pragma unroll
                for (int mt = 0; mt < 4; ++mt)
#pragma unroll
                    for (int rq = 0; rq < 4; ++rq) { f32x4 v; v.x = acc[mt][4 * rq]; v.y = acc[mt][4 * rq + 1]; v.z = acc[mt][4 * rq + 2]; v.w = acc[mt][4 * rq + 3]; *(f32x4*)(sp + 32 * mt + 8 * rq) = v; }
            }
        }
    }
}
__device__ __forceinline__ void s5_scan_items(const Params& p, int layer, LAS unsigned char* lds, int blk0) {
    const int tid = otid(), seg = tid >> 6, lane = tid & 63;
    const float* __restrict__ S = (const float*)(p.ws + WS_S5S); bf16_t* __restrict__ HC = (bf16_t*)(p.ws + WS_HCAT);
    const float2* apow = (const float2*)(p.ws + WS_APOW);
    LAS float* tl = (LAS float*)lds;
    for (int blk = blk0; blk < NB * 16 * 2; blk += gridDim.x) { if (blk < 0) continue;
        const int it = blk * 64 + lane; const int dir = (it >> 6) & 1, n = lane, g = (it >> 7) & 15, b = it >> 11;
        const float2 a32 = apow[(size_t)(((layer * 2 + dir) * 16 + g) * 64 + n) * 33 + 32];
        const size_t base = ((size_t)(b * CPB) * 16 + g) * 256 + dir * 128 + n;
#define SCAN_CR(k) ({ const int sidx_ = seg * 33 + (k); dir == 0 ? sidx_ : (sidx_ < 8 ? 7 - sidx_ : (CPB + 7) - sidx_); })
        float sr[33], si[33];
#pragma unroll
        for (int k = 0; k < 33; ++k) { const size_t o = base + (size_t)SCAN_CR(k) * 4096; sr[k] = S[o]; si[k] = S[o + 64]; }
        float hr = 0.f, hi = 0.f;
#pragma unroll
        for (int k = 0; k < 33; ++k) { const float nr = a32.x * hr - a32.y * hi + sr[k], ni = a32.x * hi + a32.y * hr + si[k]; hr = nr; hi = ni; }
        tl[(seg * 64 + lane) * 2] = hr; tl[(seg * 64 + lane) * 2 + 1] = hi;
        float pr = a32.x, pi = a32.y;
#pragma unroll
        for (int q = 0; q < 5; ++q) { const float t = pr * pr - pi * pi; pi = 2.f * pr * pi; pr = t; }
        {   const float t = pr * a32.x - pi * a32.y; pi = pr * a32.y + pi * a32.x; pr = t; }
        __syncthreads();
        float cr_ = 0.f, ci_ = 0.f;
#pragma unroll
        for (int j = 0; j < 7; ++j) if (j < seg) { const float tr = tl[(j * 64 + lane) * 2], ti = tl[(j * 64 + lane) * 2 + 1]; const float nr = pr * cr_ - pi * ci_ + tr, ni = pr * ci_ + pi * cr_ + ti; cr_ = nr; ci_ = ni; }
        hr = cr_; hi = ci_;
#pragma unroll
        for (int k = 0; k < 33; ++k) { const size_t o = base + (size_t)SCAN_CR(k) * 4096;
            HC[o] = (bf16_t)f2bf(hr); HC[o + 64] = (bf16_t)f2bf(hi);
            const float nr = a32.x * hr - a32.y * hi + sr[k], ni = a32.x * hi + a32.y * hr + si[k]; hr = nr; hi = ni; }
#undef SCAN_CR
        __syncthreads();
    }
}
__device__ __forceinline__ void phase_attn_s5b(const Params& p, int layer, LAS unsigned char* lds) {
    const int G = gridDim.x, bid = obid();
    const int vcu = (G % 8 == 0) ? (bid % 8) * (G / 8) + bid / 8 : bid;
    const int NCTX = (layer == 0) ? NB * 6 : 0;
    const float MA = ((const float*)(p.ws + WS_SCAL))[2 + layer], MB = ((const float*)(p.ws + WS_SCAL))[4 + layer];
    {   const int nctx_all = (layer == 0) ? NB * 6 + NB * 12 : 0;
        s5_scan_items(p, layer, (LAS unsigned char*)lds, (G >= nctx_all + NB * 16 * 2) ? vcu - nctx_all : vcu); }
    {
        typedef attn_body::bf16 abf;
        const abf* P = (const abf*)(p.ws + WS_P); abf* MIX = (abf*)(p.ws + WS_MIX);
        for (int s = vcu; s < 256 + NCTX; s += G) {
            const int nk = s < 256 ? 3 : 1;
            for (int k = 0; k < nk; ++k) {
                int b, h, kvh, NT; size_t qrow;
                if (s < 256) { const int x = s >> 5; b = x >> 1; kvh = x & 1; h = 3 * kvh + k; qrow = (size_t)b * RPB + LC + (size_t)(s & 31) * 256; NT = RPB / 64; }
                else { const int f = s - 256; b = f / 6; h = f % 6; kvh = h / 3; qrow = (size_t)b * RPB; NT = LC / 64; }
                const size_t krow = (size_t)b * RPB;
                attn_body::attn_unit<8, 64, true>(P + qrow * INW + C_QA + h * 64, P + krow * INW + C_KA + kvh * 64, P + krow * INW + C_VA + kvh * 64, MIX + qrow * D + h * 64, D, NT, MA, (char*)lds);
            }
        }
    }
    {
        typedef attn_body::bf16 abf;
        const abf* P = (const abf*)(p.ws + WS_P); abf* OB = (abf*)(p.ws + WS_OB);
        const int NCTXB = (layer == 0) ? NB * 12 : 0;
        const int shB = (G >= 256 + NCTX + NCTXB || (G == 256 && NCTX + NCTXB <= G)) ? NCTX : 0;
        for (int s0 = vcu; s0 < 256 + NCTXB + shB; s0 += G) {
            const int s = s0 < 256 ? s0 : s0 - shB; if (s0 >= 256 && s < 256) continue;
            const int nk = s < 256 ? 6 : 1;
            for (int k = 0; k < nk; ++k) {
                int b, sh, NT; size_t qrow;
                if (s < 256) { const int combo = 3 * (s >> 5) + (k >> 1); b = combo / 6; sh = 2 * (combo % 6) + (k & 1); qrow = (size_t)b * RPB + LC + (size_t)(s & 31) * 256; NT = RPB / 64; }
                else { const int f = s - 256; b = f / 12; sh = f % 12; qrow = (size_t)b * RPB; NT = LC / 64; }
                const size_t krow = (size_t)b * RPB;
                attn_body::attn_unit<8, 32, true>(P + qrow * INW + C_QB + sh * 32, P + krow * INW + C_KB + sh * 32, P + krow * INW + C_VB + (sh >> 1) * 64, OB + qrow * 768 + sh * 64, 768, NT, MB, (char*)lds);
            }
        }
    }
}
__device__ __forceinline__ void swap_halves(unsigned& a, unsigned& b) { const auto rr = __builtin_amdgcn_permlane32_swap(a, b, false, false); a = rr[0]; b = rr[1]; }
__device__ __forceinline__ void phase_s5c(const Params& p, int layer, LAS unsigned char* lds) {
    const int tid = otid(), wave = tid >> 6, lane = tid & 63;
    const bf16_t* P = (const bf16_t*)(p.ws + WS_P); bf16_t* MIX = (bf16_t*)(p.ws + WS_MIX);
    {
        const int r32 = lane & 31, hi = lane >> 5;
        const bf16_t* KT = (const bf16_t*)(p.ws + WS_KT) + (size_t)layer * 16 * 63 * 256;
        const bf16_t* G2 = (const bf16_t*)(p.ws + WS_G2CAT) + (size_t)layer * 16 * 512 * 256;
        const bf16_t* HC = (const bf16_t*)(p.ws + WS_HCAT); bf16_t* Gb = (bf16_t*)(p.ws + WS_G);
        const int NBC = (int)gridDim.x >= 64 ? (int)gridDim.x / 64 : 1;
        for (int combo = obid() / NBC; combo < 64; combo += (int)gridDim.x / NBC) {
            const int g = combo >> 2, mq = combo & 3, sb = obid() % NBC;
            __syncthreads();
            {   const u32x4* ksrc = (const u32x4*)(KT + (size_t)(g * 63) * 256); u32x4 t[4];
#pragma unroll
                for (int q = 0; q < 4; ++q) { const int e = tid + q * NTHR; t[q] = e < 2016 ? ksrc[e] : (u32x4){0u, 0u, 0u, 0u}; }
#pragma unroll
                for (int q = 0; q < 4; ++q) { const int e = tid + q * NTHR; if (e < 2016) *(LAS u32x4*)(lds + e * 16) = t[q]; }
                const bf16_t* gsrc = G2 + (size_t)(g * 512 + mq * 128) * 256; u32x4 u[8];
#pragma unroll
                for (int q = 0; q < 8; ++q) { const int e = tid + q * NTHR; u[q] = *(const u32x4*)(gsrc + (size_t)(e >> 5) * 256 + (e & 31) * 8); }
#pragma unroll
                for (int q = 0; q < 8; ++q) { const int e = tid + q * NTHR; *(LAS u32x4*)(lds + 32768 + (e >> 5) * 528 + (e & 31) * 16) = u[q]; } }
            __syncthreads();
            for (int ct = sb * NWAVE + wave; ct < 33; ct += NBC * NWAVE) {
                const int gc = ct * 32 + r32, tok0 = 8 * mq + (r32 >> 4);
                f32x16_t acc[4];
#pragma unroll
                for (int mt = 0; mt < 4; ++mt) acc[mt] = (f32x16_t){0.f,0.f,0.f,0.f,0.f,0.f,0.f,0.f,0.f,0.f,0.f,0.f,0.f,0.f,0.f,0.f};
                const bf16_t* up = P + (size_t)(gc * 32) * INW + C_US + g * 16 + 8 * hi;
                const bf16_t* hp = HC + ((size_t)gc * 16 + g) * 256 + 8 * hi;
                const LAS unsigned char* ktl = lds + (tok0 + 31) * 512 + (r32 & 15) * 32 + 16 * hi;
                const LAS unsigned char* g2l = lds + 32768 + r32 * 528 + 16 * hi;
#define Y_LOAD(buf, k0) do { _Pragma("unroll") for (int i_ = 0; i_ < 12; ++i_) { constexpr int kk_ = (k0); const int k_ = kk_ + i_; \
            buf[i_] = k_ < 32 ? *(const bf16x8_t*)(up + (size_t)k_ * INW) : *(const bf16x8_t*)(hp + (k_ - 32) * 16); } } while (0)
#define Y_COMP(buf, k0) do { _Pragma("unroll") for (int i_ = 0; i_ < 12; ++i_) { constexpr int kk_ = (k0); const int k_ = kk_ + i_; \
            _Pragma("unroll") for (int mt = 0; mt < 4; ++mt) { const bf16x8_t av = k_ < 32 ? *(const LAS bf16x8_t*)(ktl + (2 * mt - k_) * 512) : *(const LAS bf16x8_t*)(g2l + mt * (32 * 528) + (k_ - 32) * 32); \
                acc[mt] = __builtin_amdgcn_mfma_f32_32x32x16_bf16(av, buf[i_], acc[mt], 0, 0, 0); } \
            __builtin_amdgcn_sched_barrier(0); } } while (0)
                bf16x8_t ua[12], ub[12];
                Y_LOAD(ua, 0); Y_LOAD(ub, 12);
                Y_COMP(ua, 0); Y_LOAD(ua, 24);
                Y_COMP(ub, 12); Y_LOAD(ub, 36);
                Y_COMP(ua, 24); Y_COMP(ub, 36);
#undef Y_LOAD
#undef Y_COMP
#pragma unroll
                for (int mt = 0; mt < 4; ++mt)
#pragma unroll
                    for (int io = 0; io < 2; ++io) {
                        bf16_t* gd = Gb + (size_t)(gc * 32 + 8 * mq + 2 * mt + io) * 256 + g * 16 + 4 * hi;
                        u32x2 w0, w1;
                        w0.x = pk2(gelu_tanh(acc[mt][8 * io + 0]), gelu_tanh(acc[mt][8 * io + 1])); w0.y = pk2(gelu_tanh(acc[mt][8 * io + 2]), gelu_tanh(acc[mt][8 * io + 3]));
                        w1.x = pk2(gelu_tanh(acc[mt][8 * io + 4]), gelu_tanh(acc[mt][8 * io + 5])); w1.y = pk2(gelu_tanh(acc[mt][8 * io + 6]), gelu_tanh(acc[mt][8 * io + 7]));
                        { unsigned a0 = w0.x, a1 = w0.y, b0 = w1.x, b1 = w1.y; swap_halves(a0, b0); swap_halves(a1, b1);
                          u32x4 wq; wq.x = a0; wq.y = a1; wq.z = b0; wq.w = b1; *(u32x4*)(gd - 4 * hi + 8 * hi) = wq; }
                    }
            }
        }
    }
    const float lam = ((const float*)(p.ws + WS_SCAL))[layer], lam_init = 0.8f - 0.6f * expf(-0.3f * (float)layer);
    const int hp = (lane >> 3) < 6 ? (lane >> 3) : 5, d0 = (lane & 7) * 8;
    float sg[8];
#pragma unroll
    for (int i = 0; i < 8; ++i) sg[i] = p.in[18][layer * 64 + d0 + i] * (1.f - lam_init);
    const int nq = (layer ? NB * L : ROWS) / 4;
    for (int qi = obid() * NWAVE + wave; qi < nq; qi += gridDim.x * NWAVE) {
        const int r0 = layer ? (qi >> 11) * RPB + LC + (qi & 2047) * 4 : qi * 4;
        const bf16_t* ob = (const bf16_t*)(p.ws + WS_OB) + (size_t)r0 * 768 + hp * 128 + d0;
        u32x4 w1[4], w2[4];
#pragma unroll
        for (int k = 0; k < 4; ++k) { w1[k] = *(const u32x4*)(ob + (size_t)k * 768); w2[k] = *(const u32x4*)(ob + (size_t)k * 768 + 64); }
#pragma unroll
        for (int k = 0; k < 4; ++k) {
            const unsigned a1[4] = {w1[k].x, w1[k].y, w1[k].z, w1[k].w}, a2[4] = {w2[k].x, w2[k].y, w2[k].z, w2[k].w};
            float v[8]; float ss = 0.f;
#pragma unroll
            for (int q = 0; q < 4; ++q) { v[2 * q] = bf2f(a1[q] & 0xffffu) - lam * bf2f(a2[q] & 0xffffu); v[2 * q + 1] = bf2f(a1[q] >> 16) - lam * bf2f(a2[q] >> 16); ss += v[2 * q] * v[2 * q] + v[2 * q + 1] * v[2 * q + 1]; }
            ss += __int_as_float(__builtin_amdgcn_update_dpp(0, __float_as_int(ss), 0xB1, 0xf, 0xf, true));
            ss += __int_as_float(__builtin_amdgcn_update_dpp(0, __float_as_int(ss), 0x4E, 0xf, 0xf, true));
            {   const float t7 = __int_as_float(__builtin_amdgcn_update_dpp(0, __float_as_int(ss), 0x141, 0xf, 0xf, true));
                ss += __int_as_float(__builtin_amdgcn_update_dpp(0, __float_as_int(t7), 0x1B, 0xf, 0xf, true)); }
            const float rinv = 1.f / sqrtf(ss * (1.f / 64.f) + EPS);
            u32x4 o; o.x = pk2(v[0] * rinv * sg[0], v[1] * rinv * sg[1]); o.y = pk2(v[2] * rinv * sg[2], v[3] * rinv * sg[3]); o.z = pk2(v[4] * rinv * sg[4], v[5] * rinv * sg[5]); o.w = pk2(v[6] * rinv * sg[6], v[7] * rinv * sg[7]);
            if (lane < 48) *(u32x4*)(MIX + (size_t)(r0 + k) * D + 384 + hp * 64 + d0) = o;
        }
    }
}
__device__ __forceinline__ void phase_glu(const Params& p, int layer, LAS unsigned char* lds) {
    const int tid = otid(), wave = tid >> 6, lane = tid & 63, r32 = lane & 31, hi = lane >> 5;
    const bf16_t* Gb = (const bf16_t*)(p.ws + WS_G); bf16_t* MIX = (bf16_t*)(p.ws + WS_MIX);
    const bf16_t* WT = (const bf16_t*)(p.ws + WS_WGLU_T) + (size_t)layer * 256 * 256;
    __syncthreads();
#pragma unroll 1
    for (int q0 = 0; q0 < 16; q0 += 8) { u32x4 t[8];
#pragma unroll
        for (int q = 0; q < 8; ++q) { const int e = tid + (q0 + q) * NTHR; t[q] = *(const u32x4*)(WT + (size_t)(e >> 5) * 256 + (e & 31) * 8); }
#pragma unroll
        for (int q = 0; q < 8; ++q) { const int e = tid + (q0 + q) * NTHR; *(LAS u32x4*)(lds + (e >> 5) * 528 + (e & 31) * 16) = t[q]; } }
    __syncthreads();
    const int ntile = layer ? NB * L / 32 : NCH;
    for (int it = obid() * NWAVE + wave; it < ntile * 2; it += gridDim.x * NWAVE) {
        const int jh = it & 1, tq = it >> 1; const int tt = layer ? (tq >> 8) * CPB + (LC / 32) + (tq & 255) : tq;
        const size_t row = (size_t)tt * 32 + r32;
        f32x16_t acc[4];
#pragma unroll
        for (int mt = 0; mt < 4; ++mt) acc[mt] = (f32x16_t){0.f,0.f,0.f,0.f,0.f,0.f,0.f,0.f,0.f,0.f,0.f,0.f,0.f,0.f,0.f,0.f};
        const bf16_t* gp = Gb + row * 256 + 8 * hi;
        bf16x8_t bv[16];
#pragma unroll
        for (int kb = 0; kb < 16; ++kb) bv[kb] = *(const bf16x8_t*)(gp + kb * 16);
        u32x2 gw[16];
#pragma unroll
        for (int mt = 0; mt < 4; ++mt)
#pragma unroll
            for (int rq = 0; rq < 4; ++rq) gw[4 * mt + rq] = *(const u32x2*)(Gb + row * 256 + 128 * jh + 32 * mt + 8 * rq + 4 * hi);
        const LAS unsigned char* wl = lds + (128 * jh + r32) * 528 + 16 * hi;
#pragma unroll
        for (int kb = 0; kb < 16; ++kb) {
#pragma unroll
            for (int mt = 0; mt < 4; ++mt) { const bf16x8_t av = *(const LAS bf16x8_t*)(wl + mt * (32 * 528) + kb * 32); acc[mt] = __builtin_amdgcn_mfma_f32_32x32x16_bf16(av, bv[kb], acc[mt], 0, 0, 0); }
            __builtin_amdgcn_sched_barrier(0);
        }
#pragma unroll
        for (int mt = 0; mt < 4; ++mt)
#pragma unroll
            for (int rp = 0; rp < 2; ++rp) {
                unsigned wx[2], wy[2];
#pragma unroll
                for (int e = 0; e < 2; ++e) { const int rq = 2 * rp + e; const u32x2 g2 = gw[4 * mt + rq];
                    const float o0 = bf2f(g2.x & 0xffffu) * __builtin_amdgcn_rcpf(1.f + __builtin_amdgcn_exp2f(-LOG2E * acc[mt][4 * rq + 0]));
                    const float o1 = bf2f(g2.x >> 16) * __builtin_amdgcn_rcpf(1.f + __builtin_amdgcn_exp2f(-LOG2E * acc[mt][4 * rq + 1]));
                    const float o2 = bf2f(g2.y & 0xffffu) * __builtin_amdgcn_rcpf(1.f + __builtin_amdgcn_exp2f(-LOG2E * acc[mt][4 * rq + 2]));
                    const float o3 = bf2f(g2.y >> 16) * __builtin_amdgcn_rcpf(1.f + __builtin_amdgcn_exp2f(-LOG2E * acc[mt][4 * rq + 3]));
                    wx[e] = pk2(o0, o1); wy[e] = pk2(o2, o3); }
                swap_halves(wx[0], wx[1]); swap_halves(wy[0], wy[1]);
                u32x4 wq; wq.x = wx[0]; wq.y = wy[0]; wq.z = wx[1]; wq.w = wy[1];
                *(u32x4*)(MIX + row * D + 768 + 128 * jh + 32 * mt + 16 * rp + 8 * hi) = wq;
            }
    }
}
__device__ __forceinline__ void phase_peer_conv(const Params& p, int layer) {
    const int gtid = obid() * NTHR + otid(), GT = gridDim.x * NTHR;
    const float* U = p.in[30] + (size_t)layer * 16384 * D; const float* V = p.in[31] + (size_t)layer * 16384 * D;
    u32x4* U8 = (u32x4*)(p.ws + WS_U8); u32x4* V8 = (u32x4*)(p.ws + WS_V8);
    for (int it = gtid; it < 2 * 16384 * 64; it += GT) {
        const bool isv = it >= 16384 * 64; const int e = isv ? it - 16384 * 64 : it;
        const f32x4* src = (const f32x4*)((isv ? V : U) + (size_t)e * 16); const float sc = isv ? 1.f : 256.f;
        u32x4 o; unsigned w[4];
#pragma unroll
        for (int q = 0; q < 4; ++q) { const f32x4 v = src[q]; int t = __builtin_amdgcn_cvt_pk_fp8_f32(v.x * sc, v.y * sc, 0, false); t = __builtin_amdgcn_cvt_pk_fp8_f32(v.z * sc, v.w * sc, t, true); w[q] = (unsigned)t; }
        o.x = w[0]; o.y = w[1]; o.z = w[2]; o.w = w[3];
        (isv ? V8 : U8)[(size_t)((e & 63) >> 3) * (16384 * 8) + (size_t)(e >> 6) * 8 + (e & 7)] = o;
    }
}
__device__ __forceinline__ float vmaxf(float a, float b) { float r; asm("v_max_f32_e32 %0, %1, %2" : "=v"(r) : "v"(a), "v"(b)); return r; }
__device__ __forceinline__ float vminf(float a, float b) { float r; asm("v_min_f32_e32 %0, %1, %2" : "=v"(r) : "v"(a), "v"(b)); return r; }
#define PK_INSERT(tv, v_) do { float _v = (v_); _Pragma("unroll") for (int _k = 0; _k < 16; ++_k) { const float _h = vmaxf(tv[_k], _v); _v = vminf(tv[_k], _v); tv[_k] = _h; } } while (0)
#define SN_CE(a, b) do { const float _h = vmaxf(a, b); b = vminf(a, b); a = _h; } while (0)
__device__ __forceinline__ void sort16_desc(float (&x)[16]) { SN_CE(x[0], x[1]); SN_CE(x[2], x[3]); SN_CE(x[0], x[2]); SN_CE(x[1], x[3]); SN_CE(x[1], x[2]); SN_CE(x[4], x[5]); SN_CE(x[6], x[7]); SN_CE(x[4], x[6]); SN_CE(x[5], x[7]); SN_CE(x[5], x[6]); SN_CE(x[0], x[4]); SN_CE(x[2], x[6]); SN_CE(x[2], x[4]); SN_CE(x[1], x[5]); SN_CE(x[3], x[7]); SN_CE(x[3], x[5]); SN_CE(x[1], x[2]); SN_CE(x[3], x[4]); SN_CE(x[5], x[6]); SN_CE(x[8], x[9]); SN_CE(x[10], x[11]); SN_CE(x[8], x[10]); SN_CE(x[9], x[11]); SN_CE(x[9], x[10]); SN_CE(x[12], x[13]); SN_CE(x[14], x[15]); SN_CE(x[12], x[14]); SN_CE(x[13], x[15]); SN_CE(x[13], x[14]); SN_CE(x[8], x[12]); SN_CE(x[10], x[14]); SN_CE(x[10], x[12]); SN_CE(x[9], x[13]); SN_CE(x[11], x[15]); SN_CE(x[11], x[13]); SN_CE(x[9], x[10]); SN_CE(x[11], x[12]); SN_CE(x[13], x[14]); SN_CE(x[0], x[8]); SN_CE(x[4], x[12]); SN_CE(x[4], x[8]); SN_CE(x[2], x[10]); SN_CE(x[6], x[14]); SN_CE(x[6], x[10]); SN_CE(x[2], x[4]); SN_CE(x[6], x[8]); SN_CE(x[10], x[12]); SN_CE(x[1], x[9]); SN_CE(x[5], x[13]); SN_CE(x[5], x[9]); SN_CE(x[3], x[11]); SN_CE(x[7], x[15]); SN_CE(x[7], x[11]); SN_CE(x[3], x[5]); SN_CE(x[7], x[9]); SN_CE(x[11], x[13]); SN_CE(x[1], x[2]); SN_CE(x[3], x[4]); SN_CE(x[5], x[6]); SN_CE(x[7], x[8]); SN_CE(x[9], x[10]); SN_CE(x[11], x[12]); SN_CE(x[13], x[14]); }
__device__ __forceinline__ void merge16_desc(float (&a)[16], const float (&b)[16]) {
#pragma unroll
    for (int i = 0; i < 16; ++i) a[i] = vmaxf(a[i], b[15 - i]);
#pragma unroll
    for (int i = 0; i < 8; ++i) SN_CE(a[i], a[i + 8]);
#pragma unroll
    for (int i = 0; i < 16; ++i) if ((i & 4) == 0) SN_CE(a[i], a[i + 4]);
#pragma unroll
    for (int i = 0; i < 16; ++i) if ((i & 2) == 0) SN_CE(a[i], a[i + 2]);
#pragma unroll
    for (int i = 0; i < 16; i += 2) SN_CE(a[i], a[i + 1]);
}
__device__ __forceinline__ void phase_peer_sel(const Params& p, int layer, LAS unsigned char* lds) {
    const int tid = otid(), wave = tid >> 6, lane = tid & 63, r32 = lane & 31, hi = lane >> 5;
    const bf16_t* Qp = (const bf16_t*)(p.ws + WS_P);
    const bf16_t* K16 = (const bf16_t*)(p.ws + WS_KEYS16) + (size_t)layer * 16 * 128 * 128;
    unsigned* SEL = (unsigned*)(p.ws + WS_SEL);
    const int hd = obid() & 7, bsub = obid() >> 3, nbs = ((int)gridDim.x + 7 - hd) >> 3;
    LAS unsigned char* lrow = lds + 2 * 34816 + wave * 1024 + r32 * 32;
    __syncthreads();
    {   u32x4 t[8];
#pragma unroll
        for (int q = 0; q < 8; ++q) { const int e = tid + q * NTHR; t[q] = *(const u32x4*)(K16 + (size_t)(2 * hd) * 128 * 128 + (size_t)e * 8); }
#pragma unroll
        for (int q = 0; q < 8; ++q) { const int e = tid + q * NTHR; *(LAS u32x4*)(lds + (e >> 11) * 34816 + ((e >> 4) & 127) * 272 + (e & 15) * 16) = t[q]; } }
    __syncthreads();
    const int nunit = layer ? NB * L / 32 : ROWS / 32;
    constexpr unsigned char PA[50] = {0,0,0,0,0,0,0,0,0,0,0,0,0,0,0,0,1,1,1,1,1,1,1,1,2,2,2,2,2,3,3,3,3,4,4,4,5,5,6,6,7,7,8,9,10,11,12,13,14,15};
    constexpr unsigned char PB[50] = {0,1,2,3,4,5,6,7,8,9,10,11,12,13,14,15,0,1,2,3,4,5,6,7,0,1,2,3,4,0,1,2,3,0,1,2,0,1,0,1,0,1,0,0,0,0,0,0,0,0};
#define SEL_QROW(u_) ((layer ? ((u_) >> 8) * RPB + LC + ((u_) & 255) * 32 : (u_) * 32) + r32)
#define SEL_QLOAD(dst, u_, hs_) do { const bf16_t* qp_ = Qp + (size_t)SEL_QROW(u_) * INW + (2 * hd + (hs_)) * 128 + hi * 8; _Pragma("unroll") for (int ks_ = 0; ks_ < 8; ++ks_) dst[ks_] = *(const bf16x8_t*)(qp_ + ks_ * 16); } while (0)
    bf16x8_t qn[2][8];
#pragma unroll
    for (int ks = 0; ks < 8; ++ks) { qn[0][ks] = (bf16x8_t){0, 0, 0, 0, 0, 0, 0, 0}; qn[1][ks] = qn[0][ks]; }
    const int ustride = nbs * NWAVE, nfu = (nunit / ustride) * ustride, uleft = (wave * nbs + bsub < nunit - nfu) ? nfu + wave * nbs + bsub : nunit;
#define SEL_NEXT(u_) ((u_) < nfu ? ((u_) + ustride < nfu ? (u_) + ustride : uleft) : nunit)
    const int ufirst = (bsub * NWAVE + wave < nfu) ? bsub * NWAVE + wave : uleft;
    if (ufirst < nunit) { SEL_QLOAD(qn[0], ufirst, 0); SEL_QLOAD(qn[1], ufirst, 1); }
    for (int u = ufirst; u < nunit; u = SEL_NEXT(u)) {
        const int row = SEL_QROW(u);
        float L1[16], L2[16];
#pragma unroll
        for (int hs = 0; hs < 2; ++hs) {
            f32x16_t acc[4];
#pragma unroll
            for (int mt = 0; mt < 4; ++mt) {
                acc[mt] = (f32x16_t){0.f,0.f,0.f,0.f,0.f,0.f,0.f,0.f,0.f,0.f,0.f,0.f,0.f,0.f,0.f,0.f};
#pragma unroll
                for (int ks = 0; ks < 8; ++ks) { const bf16x8_t a = *(const LAS bf16x8_t*)(lds + hs * 34816 + (mt * 32 + r32) * 272 + ks * 32 + hi * 16);
                    acc[mt] = __builtin_amdgcn_mfma_f32_32x32x16_bf16(a, qn[hs][ks], acc[mt], 0, 0, 0); }
            }
            if (SEL_NEXT(u) < nunit) SEL_QLOAD(qn[hs], SEL_NEXT(u), hs);
            float c0[16], c1[16], c2[16], c3[16];
#pragma unroll
            for (int r = 0; r < 16; ++r) { const unsigned n = (unsigned)((r & 3) + 8 * (r >> 2)) + 4u * (unsigned)hi;
                c0[r] = __uint_as_float((__float_as_uint(acc[0][r]) & ~127u) | n); c1[r] = __uint_as_float((__float_as_uint(acc[1][r]) & ~127u) | (n + 32u));
                c2[r] = __uint_as_float((__float_as_uint(acc[2][r]) & ~127u) | (n + 64u)); c3[r] = __uint_as_float((__float_as_uint(acc[3][r]) & ~127u) | (n + 96u)); }
            sort16_desc(c0); sort16_desc(c1); sort16_desc(c2); sort16_desc(c3);
            merge16_desc(c0, c1); merge16_desc(c2, c3); merge16_desc(c0, c2);
            float pv[16];
#pragma unroll
            for (int k = 0; k < 16; ++k) pv[k] = __shfl_xor(c0[k], 32);
            merge16_desc(c0, pv);
#pragma unroll
            for (int k = 0; k < 16; ++k) { if (hs == 0) L1[k] = c0[k]; else L2[k] = c0[k]; }
        }
        {   unsigned wa[4], wb[4];
#pragma unroll
            for (int q = 0; q < 4; ++q) { wa[q] = 0u; wb[q] = 0u;
#pragma unroll
                for (int jb = 0; jb < 4; ++jb) { wa[q] |= (__float_as_uint(L1[4 * q + jb]) & 127u) << (8 * jb); wb[q] |= (__float_as_uint(L2[4 * q + jb]) & 127u) << (8 * jb); } }
            u32x4 w4; w4.x = hi ? wb[0] : wa[0]; w4.y = hi ? wb[1] : wa[1]; w4.z = hi ? wb[2] : wa[2]; w4.w = hi ? wb[3] : wa[3];
            *(LAS u32x4*)(lrow + hi * 16) = w4; }
        float cv[16], cw[16];
#pragma unroll
        for (int k = 0; k < 16; ++k) cw[k] = -3.0e38f;
#pragma unroll
        for (int i = 0; i < 25; ++i) {
            const int a0 = PA[2 * i], b0 = PB[2 * i], a1 = PA[2 * i + 1], b1 = PB[2 * i + 1];
            const float s0 = L1[a0] + L2[b0], s1 = L1[a1] + L2[b1];
            const unsigned k0 = (__float_as_uint(s0) & ~255u) | (unsigned)(a0 * 16 + b0), k1 = (__float_as_uint(s1) & ~255u) | (unsigned)(a1 * 16 + b1);
            const float kv = __uint_as_float(hi ? k1 : k0);
            if (i < 16) cv[i] = kv; else cw[i - 16] = kv;
        }
        sort16_desc(cv); sort16_desc(cw); merge16_desc(cv, cw);
        {   float pv[16];
#pragma unroll
            for (int k = 0; k < 16; ++k) pv[k] = __shfl_xor(cv[k], 32);
            merge16_desc(cv, pv); }
        float e[16], den = 0.f;
#pragma unroll
        for (int k = 0; k < 16; ++k) { e[k] = __expf(cv[k] - cv[0]); den += e[k]; }
        const float rd = 1.f / den;
        asm volatile("s_waitcnt lgkmcnt(0)" ::: "memory");
        unsigned wd[8];
#pragma unroll
        for (int k = 0; k < 8; ++k) {
            float cv_lo = cv[k], cv_hi = cv[8 + k], e_lo = e[k], e_hi = e[8 + k]; asm volatile("" : "+v"(cv_lo), "+v"(cv_hi), "+v"(e_lo), "+v"(e_hi));
            const unsigned code = __float_as_uint(hi ? cv_hi : cv_lo) & 255u; const float gk = (hi ? e_hi : e_lo) * rd;
            const unsigned i1 = lrow[code >> 4], i2 = lrow[16 + (code & 15u)];
            wd[k] = (i1 * 128u + i2) | (f2bf(gk) << 16);
        }
        u32x4 o0, o1; o0.x = wd[0]; o0.y = wd[1]; o0.z = wd[2]; o0.w = wd[3]; o1.x = wd[4]; o1.y = wd[5]; o1.z = wd[6]; o1.w = wd[7];
        unsigned* dst = SEL + (size_t)row * 128 + hd * 16 + hi * 8;
        *(u32x4*)dst = o0; *(u32x4*)(dst + 4) = o1;
    }
}
__device__ __forceinline__ float red16(const float (&x)[16], int lane) {
    float y[8], z[4], w2[2];
    {   const bool bt = (lane >> 3) & 1;
#pragma unroll
        for (int j = 0; j < 8; ++j) { const float keep = bt ? x[j + 8] : x[j], send = bt ? x[j] : x[j + 8]; y[j] = keep + __shfl_xor(send, 8); } }
    {   const bool bt = (lane >> 2) & 1;
#pragma unroll
        for (int j = 0; j < 4; ++j) { const float keep = bt ? y[j + 4] : y[j], send = bt ? y[j] : y[j + 4]; z[j] = keep + __shfl_xor(send, 4); } }
    {   const bool bt = (lane >> 1) & 1;
#pragma unroll
        for (int j = 0; j < 2; ++j) { const float keep = bt ? z[j + 2] : z[j], send = bt ? z[j] : z[j + 2]; w2[j] = keep + __shfl_xor(send, 2); } }
    const bool bt = lane & 1;
    float v = (bt ? w2[1] : w2[0]) + __shfl_xor(bt ? w2[0] : w2[1], 1);
    v += __shfl_xor(v, 16); v += __shfl_xor(v, 32);
    return v;
}

__device__ __forceinline__ int peer_row(int layer, int li) { return layer == 0 ? li : (li >> 13) * RPB + LC + (li & 8191); }
template <int CTRL> __device__ __forceinline__ float dppx(float x) { return __int_as_float(__builtin_amdgcn_update_dpp(0, __float_as_int(x), CTRL, 0xf, 0xf, true)); }
template <int WHICH> __device__ __forceinline__ void phase_peer_slice(const Params& p, int layer, LAS unsigned char* lds) {
    const int tid = otid(), wave = tid >> 6, lane = tid & 63, G = gridDim.x, bid = obid();
    const int sub = lane >> 3, c8 = lane & 7, cb = c8 * 16;
    const int rstart = bid * NWAVE + wave, rstep = G * NWAVE, nrows = layer ? NB * L : ROWS;
    const unsigned* SEL = (const unsigned*)(p.ws + WS_SEL);
    const bf16_t* H = (const bf16_t*)(p.ws + WS_H);
    LAS float* AC = (LAS float*)lds + wave * (24 * 128);
    float* W = (float*)(p.ws + WS_OB);
    const float* X = (const float*)(p.ws + WS_X);
    const float* mod = (const float*)(p.ws + WS_MOD) + (size_t)layer * 5 * 6144;
    const unsigned char* T8 = p.ws + (WHICH ? WS_V8 : WS_U8);
    const int xcc = (int)(xb_xcc_id() & 7u);
    const int colo = cb + ((lane >> 5) & 1) * 8 + ((lane >> 4) & 1) * 4 + ((lane >> 3) & 1) * 2;
    for (int pk = 0; pk < 8; ++pk) {
        const int part = (xcc + pk) & 7; const unsigned char* Tp = T8 + (size_t)part * (16384 * 128); const int col = part * 128 + colo;
        u32x4 sn[4]; u32x4 an[4]; f32x2 xn = {0.f, 0.f}, gn = {0.f, 0.f};
#pragma unroll
        for (int q = 0; q < 4; ++q) { sn[q] = (u32x4){0u, 0u, 0u, 0u}; an[q] = sn[q]; }
        if (rstart < nrows) { const int r = peer_row(layer, rstart);
#pragma unroll
            for (int q = 0; q < 4; ++q) sn[q] = *(const u32x4*)(SEL + (size_t)r * 128 + sub * 16 + 4 * q);
            if (WHICH == 0) { an[0] = *(const u32x4*)(H + (size_t)r * D + part * 128 + cb); an[1] = *(const u32x4*)(H + (size_t)r * D + part * 128 + cb + 8); }
            else {
#pragma unroll
                for (int q = 0; q < 4; ++q) an[q] = *(const u32x4*)(W + (size_t)r * 128 + sub * 16 + 4 * q);
                const int b = r / RPB, jr = r - b * RPB; xn = *(const f32x2*)(X + (size_t)r * D + col); gn = *(const f32x2*)(mod + (size_t)(jr < LC ? 4 : b) * 6144 + 5 * D + col); } }
        for (int li = rstart; li < nrows; li += rstep) {
            const int r = peer_row(layer, li);
            u32x4 sc[4], ac[4]; const f32x2 xv = xn, gv = gn;
#pragma unroll
            for (int q = 0; q < 4; ++q) { sc[q] = sn[q]; ac[q] = an[q]; }
            u32x4 buf[16];
#pragma unroll
            for (int t = 0; t < 16; ++t) buf[t] = *(const u32x4*)(Tp + (((sc[t >> 2][t & 3] & 0x3fffu) << 7) | (unsigned)cb));
            if (li + rstep < nrows) { const int rn = peer_row(layer, li + rstep);
#pragma unroll
                for (int q = 0; q < 4; ++q) sn[q] = *(const u32x4*)(SEL + (size_t)rn * 128 + sub * 16 + 4 * q);
                if (WHICH == 0) { an[0] = *(const u32x4*)(H + (size_t)rn * D + part * 128 + cb); an[1] = *(const u32x4*)(H + (size_t)rn * D + part * 128 + cb + 8); }
                else {
#pragma unroll
                    for (int q = 0; q < 4; ++q) an[q] = *(const u32x4*)(W + (size_t)rn * 128 + sub * 16 + 4 * q);
                    const int b = rn / RPB, jr = rn - b * RPB; xn = *(const f32x2*)(X + (size_t)rn * D + col); gn = *(const f32x2*)(mod + (size_t)(jr < LC ? 4 : b) * 6144 + 5 * D + col); } }
            if (WHICH == 0) {
                f32x2 hp[8];
                {   const unsigned hw[8] = {ac[0].x, ac[0].y, ac[0].z, ac[0].w, ac[1].x, ac[1].y, ac[1].z, ac[1].w};
#pragma unroll
                    for (int q = 0; q < 8; ++q) hp[q] = (f32x2){bf2f(hw[q] & 0xffffu), bf2f(hw[q] >> 16)}; }
                float pv[16];
#pragma unroll
                for (int t = 0; t < 16; ++t) {
                    const unsigned ww[4] = {buf[t].x, buf[t].y, buf[t].z, buf[t].w}; f32x2 a2 = {0.f, 0.f};
#pragma unroll
                    for (int q = 0; q < 4; ++q) { a2 += __builtin_amdgcn_cvt_pk_f32_fp8((int)ww[q], false) * hp[2 * q]; a2 += __builtin_amdgcn_cvt_pk_f32_fp8((int)ww[q], true) * hp[2 * q + 1]; }
                    pv[t] = a2.x + a2.y;
                }
#pragma unroll
                for (int t = 0; t < 16; ++t) pv[t] += dppx<0xB1>(pv[t]);
#pragma unroll
                for (int t = 0; t < 16; ++t) pv[t] += dppx<0x4E>(pv[t]);
#pragma unroll
                for (int t = 0; t < 16; ++t) pv[t] += dppx<0x1B>(dppx<0x141>(pv[t]));
                float k0 = 0.f, k1 = 0.f;
#pragma unroll
                for (int t = 0; t < 8; ++t) { k0 = (c8 == t) ? pv[t] : k0; k1 = (c8 == t) ? pv[t + 8] : k1; }
                LAS float* ac = AC + ((li - rstart) / rstep) * 128 + sub * 16 + c8;
                if (pk == 0) { ac[0] = k0; ac[8] = k1; } else { ac[0] += k0; ac[8] += k1; }
            } else {
                f32x2 acc[8];
#pragma unroll
                for (int q = 0; q < 8; ++q) acc[q] = (f32x2){0.f, 0.f};
#pragma unroll
                for (int t = 0; t < 16; ++t) { const float we = __uint_as_float(ac[t >> 2][t & 3]); const f32x2 w2 = {we, we};
                    const unsigned ww[4] = {buf[t].x, buf[t].y, buf[t].z, buf[t].w};
#pragma unroll
                    for (int q = 0; q < 4; ++q) { acc[2 * q] += w2 * __builtin_amdgcn_cvt_pk_f32_fp8((int)ww[q], false); acc[2 * q + 1] += w2 * __builtin_amdgcn_cvt_pk_f32_fp8((int)ww[q], true); } }
                float a8[8], a4[4], a2[2];
                {   const bool bt = (lane >> 5) & 1;
#pragma unroll
                    for (int k = 0; k < 8; ++k) { const float lo = acc[k >> 1][k & 1], hi = acc[4 + (k >> 1)][k & 1]; const float keep = bt ? hi : lo, send = bt ? lo : hi;
                        const auto rr = __builtin_amdgcn_permlane32_swap(__float_as_uint(send), __float_as_uint(send), false, false); a8[k] = keep + __uint_as_float(bt ? rr[0] : rr[1]); } }
                {   const bool bt = (lane >> 4) & 1;
#pragma unroll
                    for (int k = 0; k < 4; ++k) { const float keep = bt ? a8[k + 4] : a8[k], send = bt ? a8[k] : a8[k + 4];
                        const auto rr = __builtin_amdgcn_permlane16_swap(__float_as_uint(send), __float_as_uint(send), false, false); a4[k] = keep + __uint_as_float(bt ? rr[0] : rr[1]); } }
                {   const bool bt = (lane >> 3) & 1;
#pragma unroll
                    for (int k = 0; k < 2; ++k) { const float keep = bt ? a4[k + 2] : a4[k], send = bt ? a4[k] : a4[k + 2]; a2[k] = keep + dppx<0x128>(send); } }
                const int b = r / RPB, jr = r - b * RPB;
                f32x2 o; o.x = xv.x + gv.x * a2[0]; o.y = xv.y + gv.y * a2[1];
                float* orow = (layer == 0) ? (float*)(p.ws + WS_X) + (size_t)r * D + col : p.out + ((size_t)b * L + (jr - LC)) * D + col;
                *(f32x2*)orow = o;
            }
        }
    }
    if (WHICH == 0) {
        asm volatile("s_waitcnt lgkmcnt(0)" ::: "memory");
        const int nvis = rstart < nrows ? (nrows - rstart + rstep - 1) / rstep : 0;
        for (int v0 = 0; v0 < nvis; v0 += 6) {
            unsigned sw[6][2];
#pragma unroll
            for (int k = 0; k < 6; ++k) { const int v = v0 + k < nvis ? v0 + k : nvis - 1; const int r = peer_row(layer, rstart + v * rstep); sw[k][0] = SEL[(size_t)r * 128 + lane]; sw[k][1] = SEL[(size_t)r * 128 + 64 + lane]; }
#pragma unroll
            for (int k = 0; k < 6; ++k) { if (v0 + k >= nvis) continue; const int r = peer_row(layer, rstart + (v0 + k) * rstep); const LAS float* ac = AC + (v0 + k) * 128;
#pragma unroll
                for (int hf = 0; hf < 2; ++hf) { const int pos = hf * 64 + lane; const float wv = bf2f(sw[k][hf] >> 16) * gelu_tanh(ac[pos] * (1.f / 256.f));
                    const float ws = wv * 64.f; const int hi8 = __builtin_amdgcn_cvt_pk_fp8_f32(ws, 0.f, 0, false) & 0xff; const f32x2 fh = __builtin_amdgcn_cvt_pk_f32_fp8(hi8, false);
                    const int lo8 = __builtin_amdgcn_cvt_pk_fp8_f32(ws - fh.x, 0.f, 0, false) & 0xff;
                    unsigned char* rec = (unsigned char*)(p.ws + WS_OB) + 20 * MiB + (size_t)r * 512;
                    ((unsigned short*)rec)[pos] = (unsigned short)(sw[k][hf] & 0x3fffu); rec[256 + pos] = (unsigned char)hi8; rec[384 + pos] = (unsigned char)lo8; } }
        }
    }
}

typedef int v2i_t __attribute__((ext_vector_type(2)));
__device__ __forceinline__ void dma16(const void* gsrc, LAS void* dst) { unsigned keep; const unsigned d = (unsigned)__builtin_amdgcn_readfirstlane((int)(unsigned)(uintptr_t)dst);
    asm volatile("s_mov_b32 %0, m0\n\ts_mov_b32 m0, %2\n\ts_nop 0\n\tglobal_load_lds_dwordx4 %1, off\n\ts_mov_b32 m0, %0" : "=&s"(keep) : "v"(gsrc), "s"(d) : "memory"); }
__device__ __forceinline__ void dma4nt(const void* gsrc, LAS void* dst) { unsigned keep; const unsigned d = (unsigned)__builtin_amdgcn_readfirstlane((int)(unsigned)(uintptr_t)dst);
    asm volatile("s_mov_b32 %0, m0\n\ts_mov_b32 m0, %2\n\ts_nop 0\n\tglobal_load_lds_dword %1, off nt\n\ts_mov_b32 m0, %0" : "=&s"(keep) : "v"(gsrc), "s"(d) : "memory"); }
__device__ __forceinline__ void dma4(const void* gsrc, LAS void* dst) { unsigned keep; const unsigned d = (unsigned)__builtin_amdgcn_readfirstlane((int)(unsigned)(uintptr_t)dst);
    asm volatile("s_mov_b32 %0, m0\n\ts_mov_b32 m0, %2\n\ts_nop 0\n\tglobal_load_lds_dword %1, off\n\ts_mov_b32 m0, %0" : "=&s"(keep) : "v"(gsrc), "s"(d) : "memory"); }
__device__ __forceinline__ void phase_peer_v_mfma(const Params& p, int layer, LAS unsigned char* lds) {
    const int tid = otid(), wave = tid >> 6, lane = tid & 63, G = gridDim.x, bid = obid();
    const int m16 = lane & 15, g = lane >> 4, sub = lane >> 3, c8 = lane & 7, q = m16 >> 1, pp = m16 & 1;
    const int rstart = bid * NWAVE + wave, rstep = G * NWAVE, nrows = layer ? NB * L : ROWS;
    const int nv = rstart < nrows ? (nrows - rstart + rstep - 1) / rstep : 0;
    const unsigned char* REC = p.ws + WS_OB + 20 * MiB;
    const float* X = (const float*)(p.ws + WS_X);
    const float* mod = (const float*)(p.ws + WS_MOD) + (size_t)layer * 5 * 6144;
    LAS unsigned char* HB = lds + wave * 19456;
    LAS unsigned char* ST = HB + 16384;
    LAS float* GT = (LAS float*)(lds + 8 * 19456);
    const int xcc = (int)(xb_xcc_id() & 7u);
#define PV_ROW(v) peer_row(layer, rstart + ((v) < nv ? (v) : nv - 1) * rstep)
#define PV_SMALL(v) do { const int r_ = PV_ROW(v); LAS unsigned char* st_ = ST + ((v) % 3) * 1024; const unsigned char* rc_ = REC + (size_t)r_ * 512; const float* xr_ = X + (size_t)r_ * D + part * 128; \
        dma4(rc_ + 4 * lane, st_); dma4(rc_ + 256 + 4 * lane, st_ + 256); dma4nt(xr_ + lane, st_ + 512); dma4nt(xr_ + 64 + lane, st_ + 768); } while (0)
#define PV_HALF(v, hf) do { const LAS unsigned short* ix_ = (const LAS unsigned short*)(ST + ((v) % 3) * 1024); \
        _Pragma("unroll") for (int t_ = 0; t_ < 8; ++t_) { const unsigned idx_ = ix_[64 * (hf) + 8 * t_ + sub]; \
            dma16(Tp + (size_t)idx_ * 128 + ((c8 ^ sub) * 16), HB + (hf) * 8192 + t_ * 1024); } } while (0)
#define PV_COMP(v, hf) do { const LAS unsigned char* st_ = ST + ((v) % 3) * 1024; const LAS unsigned char* rb_ = HB + (hf) * 8192 + (8 * g + q) * 128 + 8 * pp; \
        _Pragma("unroll") for (int k2_ = 0; k2_ < 2; ++k2_) { const int ks_ = 2 * (hf) + k2_; \
            const long hi_ = *(const LAS long*)(st_ + 256 + 32 * ks_ + 8 * g), lo_ = *(const LAS long*)(st_ + 384 + 32 * ks_ + 8 * g); const long af_ = m16 == 0 ? hi_ : (m16 == 1 ? lo_ : 0l); \
            v2i_t bq_[8]; _Pragma("unroll") for (int j_ = 0; j_ < 8; ++j_) bq_[j_] = __builtin_amdgcn_ds_read_tr8_b64_v2i32((LAS v2i_t*)(rb_ + k2_ * 4096 + ((j_ ^ q) * 16))); \
            _Pragma("unroll") for (int j_ = 0; j_ < 8; ++j_) { const long bl_ = (long)(((unsigned long long)(unsigned)bq_[j_].y << 32) | (unsigned long long)(unsigned)bq_[j_].x); \
                acc[j_] = __builtin_amdgcn_mfma_f32_16x16x32_fp8_fp8(af_, bl_, acc[j_], 0, 0, 0); } } } while (0)
    for (int pk = 0; pk < 8; ++pk) {
        const int part = (xcc + pk) & 7; const unsigned char* Tp = p.ws + WS_V8 + (size_t)part * (16384 * 128);
        __syncthreads();
        for (int e = tid; e < 5 * 128; e += NTHR) GT[e] = mod[(size_t)(e >> 7) * 6144 + 5 * D + part * 128 + (e & 127)];
        asm volatile("s_waitcnt vmcnt(0) lgkmcnt(0)" ::: "memory");
        __syncthreads();
        if (nv > 0) {
            PV_SMALL(0); PV_SMALL(1);
            asm volatile("s_waitcnt vmcnt(0)" ::: "memory");
            PV_HALF(0, 0);
            for (int v = 0; v < nv; ++v) {
                f32x4 acc[8];
#pragma unroll
                for (int j = 0; j < 8; ++j) acc[j] = (f32x4){0.f, 0.f, 0.f, 0.f};
                PV_HALF(v, 1);
                if (v == 0) asm volatile("s_waitcnt vmcnt(8)" ::: "memory"); else asm volatile("s_waitcnt vmcnt(16)" ::: "memory");
                PV_COMP(v, 0);
                asm volatile("s_waitcnt lgkmcnt(0)" ::: "memory");
                PV_SMALL(v + 2);
                PV_HALF(v + 1, 0);
                asm volatile("s_waitcnt vmcnt(12)" ::: "memory");
                PV_COMP(v, 1);
                {
                    const int r = PV_ROW(v); const int b = r / RPB, jr = r - b * RPB;
                    const LAS float* xs = (const LAS float*)(ST + (v % 3) * 1024 + 512); const LAS float* gt = GT + (jr < LC ? 4 : b) * 128;
                    float* orow = (layer == 0) ? (float*)(p.ws + WS_X) + (size_t)r * D + part * 128 + m16 : p.out + ((size_t)b * L + (jr - LC)) * D + part * 128 + m16;
                    float ov[8];
#pragma unroll
                    for (int j = 0; j < 8; ++j) ov[j] = xs[16 * j + m16] + gt[16 * j + m16] * ((acc[j][0] + acc[j][1]) * (1.f / 64.f));
                    asm volatile("s_waitcnt lgkmcnt(0)" ::: "memory");
                    if (lane < 16) {
#pragma unroll
                        for (int j = 0; j < 8; ++j) asm volatile("global_store_dword %0, %1, off nt" :: "v"(orow + 16 * j), "v"(ov[j]) : "memory");
                    }
                }
            }
            asm volatile("s_waitcnt vmcnt(0)" ::: "memory");
        }
    }
#undef PV_ROW
#undef PV_SMALL
#undef PV_HALF
#undef PV_COMP
}
constexpr int NPH = 2 + 2 * 11;
__global__ void __launch_bounds__(NTHR, 2) mk_fwd(Params p) {
    extern __shared__ __attribute__((aligned(16))) unsigned char lds_raw[];
    LAS unsigned char* lds = (LAS unsigned char*)lds_raw;
    volatile LAS unsigned* misc = (volatile LAS unsigned*)(lds + LDS_BYTES - 64);
    if (threadIdx.x < 16) misc[threadIdx.x] = 0u;
    __syncthreads();
    const int lo = p.ph_lo, hi = p.ph_hi;
    XcdBarrier bar; bar.bar = (unsigned*)(p.ws + WS_CTL) + 1024; bar.x = 0; bar.st = nullptr;
    if (hi - lo > 1) bar = xcd_barrier_post((unsigned*)(p.ws + WS_CTL) + 1024, misc);
#define IN(k) (lo <= (k) && (k) < hi)
#define SEAM(k) do { if (IN(k) && IN((k) + 1)) xcd_barrier(bar); } while (0)
    if (IN(0)) { phase_pro_a(p, lds); phase_pro_w(p, lds); } SEAM(0);
    if (IN(1)) { phase_pro_b(p, lds); } SEAM(1);
#define LAYER_BODY(l) do { constexpr int k0 = 2 + 11 * (l); \
        if (IN(k0 + 0)) { phase_norm(p, (l), 0); } SEAM(k0 + 0); \
        if (IN(k0 + 1)) { phase_gemm<0>(p, (l), lds); } SEAM(k0 + 1); \
        if (IN(k0 + 2)) { phase_qkrope_s5a(p, (l), lds); } SEAM(k0 + 2); \
        if (IN(k0 + 3)) { phase_attn_s5b(p, (l), lds); } SEAM(k0 + 3); \
        if (IN(k0 + 4)) { phase_s5c(p, (l), lds); } SEAM(k0 + 4); \
        if (IN(k0 + 5)) { phase_glu(p, (l), lds); } SEAM(k0 + 5); \
        if (IN(k0 + 6)) { phase_gemm<1>(p, (l), lds); } SEAM(k0 + 6); \
        if (IN(k0 + 7)) { phase_norm(p, (l), 1); phase_peer_conv(p, (l)); } SEAM(k0 + 7); \
        if (IN(k0 + 8)) { phase_gemm<2>(p, (l), lds); } SEAM(k0 + 8); \
        if (IN(k0 + 9)) { phase_peer_sel(p, (l), lds); } SEAM(k0 + 9); \
          \
        if (IN(k0 + 10)) { phase_peer_slice<0>(p, (l), lds); asm volatile("s_waitcnt vmcnt(0) lgkmcnt(0)" ::: "memory"); phase_peer_v_mfma(p, (l), lds); } SEAM(k0 + 10); } while (0)
    LAYER_BODY(0);
    LAYER_BODY(1);
#undef LAYER_BODY
#undef IN
#undef SEAM
}

extern "C" void kernel_launch(void* const* d_in, const int* in_sizes, int n_in, void* d_out, int out_size, void* d_ws, size_t ws_size, hipStream_t stream) {
    static int grid = 0;
    if (grid == 0) {
        if (n_in != 32 || ws_size < WS_END) { fprintf(stderr, "kernel_launch: unexpected n_in %d / ws %zu\n", n_in, ws_size); grid = -1; return; }
        int dev = 0, cus = 0;
        if (hipGetDevice(&dev) != hipSuccess || hipDeviceGetAttribute(&cus, hipDeviceAttributeMultiprocessorCount, dev) != hipSuccess) { grid = -1; return; }
        if (hipFuncSetAttribute((const void*)mk_fwd, hipFuncAttributeMaxDynamicSharedMemorySize, LDS_BYTES) != hipSuccess) { fprintf(stderr, "kernel_launch: hipFuncSetAttribute failed\n"); grid = -1; return; }
        int per_cu = 0;
        (void)hipOccupancyMaxActiveBlocksPerMultiprocessor(&per_cu, (const void*)mk_fwd, NTHR, LDS_BYTES);
        (void)hipGetLastError();
        grid = cus > 0 ? cus : 256;
    }
    if (grid < 0) return;
    (void)hipMemsetAsync((char*)d_ws + WS_CTL, 0, CTL_ZERO_BYTES, stream);
    Params p{};
    for (int i = 0; i < 32; ++i) p.in[i] = (const float*)d_in[i];
    p.out = (float*)d_out; p.ws = (unsigned char*)d_ws;
#if MK_ONE_LAUNCH
    p.ph_lo = 0; p.ph_hi = NPH;
    hipLaunchKernelGGL(mk_fwd, dim3(grid), dim3(NTHR), LDS_BYTES, stream, p);
#else
    for (int k = 0; k < NPH; ++k) { p.ph_lo = k; p.ph_hi = k + 1; hipLaunchKernelGGL(mk_fwd, dim3(grid), dim3(NTHR), LDS_BYTES, stream, p); }
#endif
}
```
